# Optimizing an MI355X kernel written in HIP

```python
import jax, jax.numpy as jnp
from jax import lax
import numpy as np

D_MODEL = 1024
BATCH = 16
SEQ = 2048
DEPTH = 4

N_MIXERS = 2
N_MLA = (DEPTH + 1) // 2
N_HGRN = DEPTH // 2

MLA_HEADS = 16
QK_NOPE = 64
QK_ROPE = 32
V_HEAD = 64
Q_LORA = 768
KV_LORA = 256
ROPE_THETA = 10000.0
Q_BLOCK = 128

HGRN_EXPAND = 128
HGRN_HEADS = D_MODEL // HGRN_EXPAND
HGRN_V = D_MODEL // HGRN_HEADS
HGRN_CHUNK = 64

D_FF = -(-8 * D_MODEL // (3 * 256)) * 256

ALPHA = (2.0 * DEPTH) ** 0.25
BETA = (8.0 * DEPTH) ** -0.25
LN_EPS = 1e-5
RMS_EPS = 1e-6

kernel_name = 'hybrid_mla_hgrn2_deepnorm_adaln'


def layer_norm(x, g, b):
    xf = x.astype(jnp.float32)
    mu = jnp.mean(xf, -1, keepdims=True)
    var = jnp.mean(jnp.square(xf - mu), -1, keepdims=True)
    return ((xf - mu) * lax.rsqrt(var + LN_EPS) * g + b).astype(x.dtype)


def rms_norm(x, g):
    xf = x.astype(jnp.float32)
    ms = jnp.mean(jnp.square(xf), -1, keepdims=True)
    return (xf * lax.rsqrt(ms + RMS_EPS) * g).astype(x.dtype)


def rope_cos_sin(positions):
    inv_freq = ROPE_THETA ** (-jnp.arange(0, QK_ROPE, 2, dtype=jnp.float32) / QK_ROPE)
    ang = positions.astype(jnp.float32)[..., None] * inv_freq
    return jnp.cos(ang), jnp.sin(ang)


def apply_rope(x, cos, sin):
    x1, x2 = jnp.split(x.astype(jnp.float32), 2, axis=-1)
    return jnp.concatenate([x1 * cos - x2 * sin, x1 * sin + x2 * cos], -1).astype(x.dtype)


def causal_mla_attention(q_nope, q_rope, k_nope, k_rope, v):
    S = q_nope.shape[1]
    scale = (QK_NOPE + QK_ROPE) ** -0.5
    neg = jnp.finfo(jnp.float32).min
    outs = []
    for blk in range(S // Q_BLOCK):
        q0 = blk * Q_BLOCK
        kend = q0 + Q_BLOCK
        s = (jnp.einsum('bqhd,bkhd->bhqk', q_nope[:, q0:kend], k_nope[:, :kend])
             + jnp.einsum('bqhr,bkr->bhqk', q_rope[:, q0:kend], k_rope[:, :kend]))
        s = s.astype(jnp.float32) * scale
        mask = (q0 + jnp.arange(Q_BLOCK))[:, None] >= jnp.arange(kend)[None, :]
        p = jax.nn.softmax(jnp.where(mask, s, neg), axis=-1).astype(v.dtype)
        outs.append(jnp.einsum('bhqk,bkhd->bqhd', p, v[:, :kend]))
    return jnp.concatenate(outs, axis=1)


def mla(h, cos, sin, w_in, q_norm_g, w_qb, kv_norm_g, w_kvb, w_o):
    B, S, _ = h.shape
    proj = h @ w_in
    q_lat, kv_lat, k_rope = jnp.split(proj, [Q_LORA, Q_LORA + KV_LORA], axis=-1)
    q = (rms_norm(q_lat, q_norm_g) @ w_qb).reshape(B, S, MLA_HEADS, QK_NOPE + QK_ROPE)
    kv = (rms_norm(kv_lat, kv_norm_g) @ w_kvb).reshape(B, S, MLA_HEADS, QK_NOPE + V_HEAD)
    q_nope, q_rope = jnp.split(q, [QK_NOPE], axis=-1)
    k_nope, v = jnp.split(kv, [QK_NOPE], axis=-1)
    q_rope = apply_rope(q_rope, cos[:, :, None, :], sin[:, :, None, :])
    k_rope = apply_rope(k_rope, cos, sin)
    o = causal_mla_attention(q_nope, q_rope, k_nope, k_rope, v)
    return o.reshape(B, S, MLA_HEADS * V_HEAD) @ w_o


def chunk_gated_recurrence(q, k, v, log_f):
    B, S, H, K = q.shape
    V = v.shape[-1]
    C = HGRN_CHUNK
    N = S // C

    def to_chunks(t):
        return t.reshape(B, N, C, H, t.shape[-1]).transpose(1, 0, 3, 2, 4)

    causal = jnp.tril(jnp.ones((C, C), dtype=bool))[:, :, None]

    def step(state, inp):
        q_c, k_c, v_c, g_c = inp
        b = jnp.cumsum(g_c, axis=-2)
        diff = b[..., :, None, :] - b[..., None, :, :]
        decay = jnp.where(causal, jnp.exp(jnp.where(causal, diff, 0.0)), 0.0)
        attn = jnp.einsum('bhtk,bhsk,bhtsk->bhts', q_c, k_c, decay)
        o = (jnp.einsum('bhts,bhsv->bhtv', attn, v_c)
             + jnp.einsum('bhtk,bhkv->bhtv', q_c * jnp.exp(b), state))
        b_last = b[..., -1:, :]
        state = (jnp.exp(b_last[..., 0, :])[..., None] * state
                 + jnp.einsum('bhsk,bhsv->bhkv', k_c * jnp.exp(b_last - b), v_c))
        return state, o

    state0 = jnp.zeros((B, H, K, V), jnp.float32)
    _, o = lax.scan(step, state0, (to_chunks(q), to_chunks(k), to_chunks(v), to_chunks(log_f)))
    return o.transpose(1, 0, 3, 2, 4).reshape(B, S, H, V)


def hgrn2(h, lb, w_in, g_norm_g, w_o):
    B, S, _ = h.shape
    HK = HGRN_HEADS * HGRN_EXPAND
    HV = HGRN_HEADS * HGRN_V
    q, fx, i, g = jnp.split(h @ w_in, [HK, 2 * HK, 2 * HK + HV], axis=-1)
    q = jax.nn.silu(q.astype(jnp.float32)).reshape(B, S, HGRN_HEADS, HGRN_EXPAND)
    fx = fx.astype(jnp.float32).reshape(B, S, HGRN_HEADS, HGRN_EXPAND)
    lb = lb.astype(jnp.float32).reshape(HGRN_HEADS, HGRN_EXPAND)
    sig = jax.nn.sigmoid(fx)
    f = lb + (1.0 - lb) * sig
    log_f = jnp.log(f)
    k = 1.0 - f
    v = i.astype(jnp.float32).reshape(B, S, HGRN_HEADS, HGRN_V)
    o = chunk_gated_recurrence(q, k, v, log_f)
    o = rms_norm(o, g_norm_g).reshape(B, S, HV).astype(h.dtype)
    return (o * jax.nn.silu(g)) @ w_o


def swiglu(h, w_in, w_out):
    gate, up = jnp.split(h @ w_in, 2, axis=-1)
    return (jax.nn.silu(gate) * up) @ w_out


def ada_mod(c, w, b):
    mod = (jax.nn.silu(c) @ w + b)[:, None, :]
    shift, scale, gate = jnp.split(mod, 3, axis=-1)
    return shift, scale, gate


def _w(k, shape, fan_in, scale=1.0):
    return jax.random.normal(k, shape, jnp.float32) * (scale * fan_in ** -0.5)


def setup_inputs(seed: int = 0) -> dict:
    key = jax.random.key(seed)
    ks = jax.random.split(key, 24)
    D = D_MODEL
    x = jax.random.normal(ks[0], (BATCH, SEQ, D), jnp.float32)
    c = jax.random.normal(ks[1], (BATCH, D), jnp.float32)
    offsets = jax.random.randint(ks[2], (BATCH, 1), 0, 4096, dtype=jnp.int32)
    positions = offsets + jnp.arange(SEQ, dtype=jnp.int32)[None, :]
    mla_w_in = _w(ks[3], (N_MLA, D, Q_LORA + KV_LORA + QK_ROPE), D)
    mla_q_norm = 1.0 + 0.02 * jax.random.normal(ks[4], (N_MLA, Q_LORA), jnp.float32)
    mla_w_qb = _w(ks[5], (N_MLA, Q_LORA, MLA_HEADS * (QK_NOPE + QK_ROPE)), Q_LORA)
    mla_kv_norm = 1.0 + 0.02 * jax.random.normal(ks[6], (N_MLA, KV_LORA), jnp.float32)
    mla_w_kvb = _w(ks[7], (N_MLA, KV_LORA, MLA_HEADS * (QK_NOPE + V_HEAD)), KV_LORA)
    mla_w_o = _w(ks[8], (N_MLA, MLA_HEADS * V_HEAD, D), MLA_HEADS * V_HEAD, BETA)
    hgrn_lb = 0.5 * jax.random.normal(ks[9], (N_HGRN, HGRN_HEADS * HGRN_EXPAND), jnp.float32)
    hgrn_w_in = _w(ks[10], (N_HGRN, D, 2 * HGRN_HEADS * HGRN_EXPAND + HGRN_HEADS * HGRN_V + D), D)
    hgrn_g_norm = 1.0 + 0.02 * jax.random.normal(ks[11], (N_HGRN, HGRN_V), jnp.float32)
    hgrn_w_o = _w(ks[12], (N_HGRN, HGRN_HEADS * HGRN_V, D), HGRN_HEADS * HGRN_V, BETA)
    ffn_w_in = _w(ks[13], (DEPTH, D, 2 * D_FF), D)
    ffn_w_out = _w(ks[14], (DEPTH, D_FF, D), D_FF, BETA)
    ada_w = _w(ks[15], (DEPTH, 2, D, 3 * D), D, 0.1)
    ada_b = 0.01 * jax.random.normal(ks[16], (DEPTH, 2, 3 * D), jnp.float32)
    ln_g = 1.0 + 0.02 * jax.random.normal(ks[17], (DEPTH, 2, D), jnp.float32)
    ln_b = 0.01 * jax.random.normal(ks[18], (DEPTH, 2, D), jnp.float32)
    return {'x': x, 'c': c, 'positions': positions,
            'mla_w_in': mla_w_in, 'mla_q_norm': mla_q_norm, 'mla_w_qb': mla_w_qb,
            'mla_kv_norm': mla_kv_norm, 'mla_w_kvb': mla_w_kvb, 'mla_w_o': mla_w_o,
            'hgrn_lb': hgrn_lb, 'hgrn_w_in': hgrn_w_in, 'hgrn_g_norm': hgrn_g_norm, 'hgrn_w_o': hgrn_w_o,
            'ffn_w_in': ffn_w_in, 'ffn_w_out': ffn_w_out,
            'ada_w': ada_w, 'ada_b': ada_b, 'ln_g': ln_g, 'ln_b': ln_b}


def reference(x, c, positions, mla_w_in, mla_q_norm, mla_w_qb, mla_kv_norm, mla_w_kvb, mla_w_o,
              hgrn_lb, hgrn_w_in, hgrn_g_norm, hgrn_w_o, ffn_w_in, ffn_w_out,
              ada_w, ada_b, ln_g, ln_b):
    cos, sin = rope_cos_sin(positions)
    lb_soft = jax.nn.softmax(hgrn_lb.astype(jnp.float32), axis=0)
    lower_bounds = jnp.cumsum(lb_soft, axis=0) - lb_soft[0]
    for layer in range(DEPTH):
        j = layer // N_MIXERS
        shift, scale, gate = ada_mod(c, ada_w[layer, 0], ada_b[layer, 0])
        h = x * (1.0 + scale) + shift
        if layer % N_MIXERS == 0:
            y = mla(h, cos, sin, mla_w_in[j], mla_q_norm[j], mla_w_qb[j],
                    mla_kv_norm[j], mla_w_kvb[j], mla_w_o[j])
        else:
            y = hgrn2(h, lower_bounds[j], hgrn_w_in[j], hgrn_g_norm[j], hgrn_w_o[j])
        x = layer_norm(ALPHA * x + (1.0 + gate) * y, ln_g[layer, 0], ln_b[layer, 0])
        shift, scale, gate = ada_mod(c, ada_w[layer, 1], ada_b[layer, 1])
        h = x * (1.0 + scale) + shift
        y = swiglu(h, ffn_w_in[layer], ffn_w_out[layer])
        x = layer_norm(ALPHA * x + (1.0 + gate) * y, ln_g[layer, 1], ln_b[layer, 1])
    return x
```

```cpp
#include <hip/hip_runtime.h>
#include <hip/hip_cooperative_groups.h>
#include <cstdio>
#include <cstdint>
#include <cmath>
namespace cg = cooperative_groups;

__device__ __forceinline__ int mk_tid() { int t = (int)threadIdx.x; asm volatile("" : "+v"(t)); return t; }
__device__ __forceinline__ int mk_bid() { int t = (int)blockIdx.x; asm volatile("" : "+s"(t)); return t; }
__device__ __forceinline__ int mk_grid() { int t = (int)gridDim.x; asm volatile("" : "+s"(t)); return t; }
namespace pg8 {
#define PG8_LAS __attribute__((address_space(3)))
typedef unsigned short bf16_t;
typedef short bf16x8 __attribute__((ext_vector_type(8)));
typedef float f32x4 __attribute__((ext_vector_type(4)));
typedef unsigned u32x4 __attribute__((ext_vector_type(4)));
constexpr int BM = 256, BK = 64, HALF = 128, HTB = HALF * BK * 2  , STAGE_BYTES = 8 * HTB, NXCD = 8, WGM = 8;

__host__ __device__ __forceinline__ int lds_byte(int r, int c) { const int st = (r >> 4) * 2 + (c >> 5), rr = r & 15, cc = c & 31, ob = rr * 64 + cc * 2; return st * 1024 + (ob ^ (((ob >> 9) & 1) << 5)); }
__host__ __device__ __forceinline__ void stage_rc(int b, int& R, int& C) { const int st = b / 1024, sb = b % 1024, swz = sb ^ (((sb >> 9) & 1) << 5); R = (st >> 1) * 16 + swz / 64; C = (st & 1) * 32 + (swz % 64) / 2; }
__host__ __device__ __forceinline__ int perm32(int rho) { const int n = rho >> 4, i = rho & 15; return 8 * (i >> 2) + 4 * n + (i & 3); }

struct Unit { int pm, pn; };
struct Gemm { const bf16_t* A; const bf16_t* Bt; int M, N, K; };

struct StaticOrder {
    int nM, nN, nwg, G, c;
    __host__ __device__ void init(int M, int N, int G_, int c_) { nM = M / BM; nN = N / BM; nwg = nM * nN; G = G_; c = c_; }
    __host__ __device__ bool next(int i, Unit& u) const {
        const long L = (long)i * G + c; if (L >= nwg) return false;
        int wgid = (int)L; { const int q = nwg / NXCD, r = nwg % NXCD, xcd = wgid % NXCD, off = wgid / NXCD; wgid = (xcd < r ? xcd * (q + 1) : r * (q + 1) + (xcd - r) * q) + off; }
        const int nig = WGM * nN, gid = wgid / nig, fm = gid * WGM, gsz = (nM - fm) < WGM ? (nM - fm) : WGM;
        u.pm = fm + ((wgid % nig) % gsz); u.pn = (wgid % nig) / gsz; return true;
    }
    __device__ __forceinline__ void a_ready(const Unit&) const {}
    __device__ __forceinline__ void done(const Unit&) const {}
};

__device__ __forceinline__ unsigned cvt_pk_bf16(float lo, float hi) { unsigned r; asm volatile("v_cvt_pk_bf16_f32 %0, %1, %2" : "=v"(r) : "v"(lo), "v"(hi)); return r; }
template <class Epi, class Sched, bool ALIGN_EPI = false, bool SP2 = false>
__device__ __forceinline__ void gemm_phase(PG8_LAS unsigned char* lds, const Gemm g, const Sched& S, const Epi& E) {
    const int tid = mk_tid(), wid = __builtin_amdgcn_readfirstlane(tid >> 6), lane = tid & 63, wr = wid >> 2, wc = wid & 3, fr = lane & 15, fq = lane >> 4;
    const int K = g.K, nt = K / BK;
    unsigned voffA[2], voffB[2];
#pragma unroll
    for (int i = 0; i < 2; ++i) { int R, C; stage_rc(tid * 16 + i * 8192, R, C); const int Rb = Epi::PERM ? ((R & ~31) + perm32(R & 31)) : R;
        voffA[i] = (unsigned)(R * K + C) * 2u; voffB[i] = (unsigned)(Rb * K + C) * 2u; }
    const size_t kstep = (size_t)(BK * 2);
    const size_t hstep = (size_t)HALF * K * 2;
    const size_t tstep = 2 * hstep;
    const unsigned ldsw = (unsigned)wid * 1024u;
    const int aoff = lds_byte(wr * 64 + fr, fq * 8), boff = lds_byte(wc * 32 + fr, fq * 8);
#define PG8_SA(b, h) (((b) * 2 + (h)) * HTB)
#define PG8_SB(b, h) ((4 + (b) * 2 + (h)) * HTB)
#define PG8_STAGE(bufoff, gbase, voff) do { _Pragma("unroll") for (int _i = 0; _i < 2; ++_i) \
        __builtin_amdgcn_global_load_lds((const unsigned*)((const char*)(gbase) + (voff)[_i]), (PG8_LAS unsigned*)(lds + (bufoff) + ldsw + _i * 8192), 16, 0, 0); } while (0)
#define PG8_LDA(dst, b, h) do { _Pragma("unroll") for (int m = 0; m < 4; ++m) _Pragma("unroll") for (int k = 0; k < 2; ++k) dst[m][k] = *(const PG8_LAS bf16x8*)(lds + PG8_SA(b, h) + aoff + m * 2048 + k * 1024); } while (0)
#define PG8_LDB(dst, b, h) do { _Pragma("unroll") for (int n = 0; n < 2; ++n) _Pragma("unroll") for (int k = 0; k < 2; ++k) dst[n][k] = *(const PG8_LAS bf16x8*)(lds + PG8_SB(b, h) + boff + n * 2048 + k * 1024); } while (0)
#define PG8_MMA(ai, bj, At, Bt) do { __builtin_amdgcn_s_setprio(1); _Pragma("unroll") for (int m = 0; m < 4; ++m) _Pragma("unroll") for (int n = 0; n < 2; ++n) _Pragma("unroll") for (int k = 0; k < 2; ++k) \
        acc[ai][bj][m][n] = __builtin_amdgcn_mfma_f32_16x16x32_bf16(Bt[n][k], At[m][k], acc[ai][bj][m][n], 0, 0, 0); __builtin_amdgcn_s_setprio(0); } while (0)
#define PG8_WAIT_V(n) asm volatile("s_waitcnt vmcnt(" #n ")" ::: "memory")
#define PG8_WAIT_L(n) asm volatile("s_waitcnt lgkmcnt(" #n ")" ::: "memory")
#define PG8_BAR __builtin_amdgcn_s_barrier()
#define PG8_SCHED __builtin_amdgcn_sched_barrier(0)
    Unit cur, nxt; int ui = 0;
    if (!S.next(0, cur)) return;
    f32x4 acc[2][2][4][2];
#pragma unroll
    for (int a = 0; a < 2; ++a)
#pragma unroll
        for (int b = 0; b < 2; ++b)
#pragma unroll
            for (int m = 0; m < 4; ++m)
#pragma unroll
                for (int n = 0; n < 2; ++n) acc[a][b][m][n] = (f32x4){0.f, 0.f, 0.f, 0.f};
    bf16x8 At[4][2], B0[2][2], B1[2][2];
    const char* cA = (const char*)g.A + (size_t)cur.pm * tstep; const char* cB = (const char*)g.Bt + (size_t)cur.pn * tstep;
    S.a_ready(cur);
    if constexpr (SP2) {
        PG8_STAGE(PG8_SB(0, 0), cB, voffB); PG8_STAGE(PG8_SB(0, 1), cB + hstep, voffB); PG8_STAGE(PG8_SA(0, 0), cA, voffA); PG8_STAGE(PG8_SA(0, 1), cA + hstep, voffA);
        if (wr == 1) PG8_BAR;
        PG8_WAIT_V(2); PG8_BAR;
        PG8_STAGE(PG8_SB(1, 0), cB + kstep, voffB); PG8_STAGE(PG8_SA(1, 0), cA + kstep, voffA); PG8_STAGE(PG8_SB(1, 1), cB + hstep + kstep, voffB);
        PG8_WAIT_V(6); PG8_BAR;
    } else {
        PG8_STAGE(PG8_SB(0, 0), cB, voffB); PG8_STAGE(PG8_SA(0, 0), cA, voffA); PG8_STAGE(PG8_SB(0, 1), cB + hstep, voffB); PG8_STAGE(PG8_SA(0, 1), cA + hstep, voffA);
        if (wr == 1) PG8_BAR;
        PG8_WAIT_V(4); PG8_BAR;
        PG8_STAGE(PG8_SB(1, 0), cB + kstep, voffB); PG8_STAGE(PG8_SA(1, 0), cA + kstep, voffA); PG8_STAGE(PG8_SB(1, 1), cB + hstep + kstep, voffB);
        PG8_WAIT_V(6); PG8_BAR;
    }
    for (;;) {
        const bool has_next = S.next(ui + 1, nxt);
        const char* nA = has_next ? (const char*)g.A + (size_t)nxt.pm * tstep : cA; const char* nB = has_next ? (const char*)g.Bt + (size_t)nxt.pn * tstep : cB;
        for (int t = 0; t < nt; t += 2) {
            const bool last = (t == nt - 2);
            const char* a1 = cA + (size_t)(t + 1) * kstep;
            const char* a2 = last ? nA : cA + (size_t)(t + 2) * kstep; const char* b2 = last ? nB : cB + (size_t)(t + 2) * kstep;
            const char* a3 = a2 + kstep; const char* b3 = b2 + kstep;
            if (last && has_next) S.a_ready(nxt);
            if constexpr (SP2) {
            PG8_LDB(B0, 0, 0); PG8_LDB(B1, 0, 1); PG8_SCHED; PG8_LDA(At, 0, 0); PG8_STAGE(PG8_SA(1, 1), a1 + hstep, voffA);
            PG8_WAIT_V(8); PG8_WAIT_L(0); PG8_BAR; PG8_MMA(0, 0, At, B0); PG8_MMA(0, 1, At, B1); PG8_BAR; PG8_SCHED;
            PG8_LDA(At, 0, 1); PG8_STAGE(PG8_SB(0, 0), b2, voffB); PG8_STAGE(PG8_SB(0, 1), b2 + hstep, voffB); PG8_STAGE(PG8_SA(0, 0), a2, voffA);
            PG8_WAIT_V(8); PG8_WAIT_L(0); PG8_BAR; PG8_MMA(1, 0, At, B0); PG8_MMA(1, 1, At, B1); PG8_BAR; PG8_SCHED;
            PG8_LDB(B0, 1, 0); PG8_LDB(B1, 1, 1); PG8_SCHED; PG8_LDA(At, 1, 0); PG8_STAGE(PG8_SA(0, 1), a2 + hstep, voffA);
            PG8_WAIT_V(8); PG8_WAIT_L(0); PG8_BAR; PG8_MMA(0, 0, At, B0); PG8_MMA(0, 1, At, B1); PG8_BAR; PG8_SCHED;
            PG8_LDA(At, 1, 1); PG8_STAGE(PG8_SB(1, 0), b3, voffB); PG8_STAGE(PG8_SB(1, 1), b3 + hstep, voffB); PG8_STAGE(PG8_SA(1, 0), a3, voffA);
            PG8_WAIT_V(8); PG8_WAIT_L(0); PG8_BAR; PG8_MMA(1, 0, At, B0); PG8_MMA(1, 1, At, B1); PG8_BAR; PG8_SCHED;
            } else {
            PG8_LDB(B0, 0, 0); PG8_SCHED; PG8_LDA(At, 0, 0); PG8_STAGE(PG8_SA(1, 1), a1 + hstep, voffA);
            PG8_WAIT_L(8); PG8_BAR; PG8_WAIT_L(0); PG8_MMA(0, 0, At, B0); PG8_BAR; PG8_SCHED;
            PG8_LDB(B1, 0, 1); PG8_STAGE(PG8_SB(0, 0), b2, voffB);
            PG8_BAR; PG8_WAIT_L(0); PG8_MMA(0, 1, At, B1); PG8_BAR;
            PG8_LDA(At, 0, 1); PG8_STAGE(PG8_SA(0, 0), a2, voffA);
            PG8_BAR; PG8_WAIT_L(0); PG8_MMA(1, 0, At, B0); PG8_BAR; PG8_SCHED;
            PG8_STAGE(PG8_SB(0, 1), b2 + hstep, voffB);
            PG8_WAIT_V(6); PG8_BAR; PG8_MMA(1, 1, At, B1); PG8_BAR;
            PG8_LDB(B0, 1, 0); PG8_SCHED; PG8_LDA(At, 1, 0); PG8_STAGE(PG8_SA(0, 1), a2 + hstep, voffA);
            PG8_WAIT_L(8); PG8_BAR; PG8_WAIT_L(0); PG8_MMA(0, 0, At, B0); PG8_BAR; PG8_SCHED;
            PG8_LDB(B1, 1, 1); PG8_STAGE(PG8_SB(1, 0), b3, voffB);
            PG8_BAR; PG8_WAIT_L(0); PG8_MMA(0, 1, At, B1); PG8_BAR;
            PG8_LDA(At, 1, 1); PG8_STAGE(PG8_SA(1, 0), a3, voffA);
            PG8_BAR; PG8_WAIT_L(0); PG8_MMA(1, 0, At, B0); PG8_BAR; PG8_SCHED;
            PG8_STAGE(PG8_SB(1, 1), b3 + hstep, voffB);
            PG8_WAIT_V(6); PG8_BAR; PG8_MMA(1, 1, At, B1); PG8_BAR;
            }
        }
        if constexpr (ALIGN_EPI) { if (wr == 0) PG8_BAR; }
        if constexpr (!Epi::AFTER_DRAIN) { E(acc, cur, wr, wc, fr, fq); S.done(cur); }
        if (!has_next) break;
#pragma unroll
        for (int a = 0; a < 2; ++a)
#pragma unroll
            for (int b = 0; b < 2; ++b)
#pragma unroll
                for (int m = 0; m < 4; ++m)
#pragma unroll
                    for (int n = 0; n < 2; ++n) acc[a][b][m][n] = (f32x4){0.f, 0.f, 0.f, 0.f};
        cur = nxt; cA = nA; cB = nB; ++ui;
        if constexpr (ALIGN_EPI) { if (wr == 1) PG8_BAR; }
    }
    PG8_WAIT_V(0);
    if constexpr (!ALIGN_EPI) { if (wr == 0) PG8_BAR; }
    PG8_BAR;
    if constexpr (Epi::AFTER_DRAIN) { E.fused(acc, cur, wr, wc, fr, fq, lds, wid, lane); S.done(cur); }
#undef PG8_SA
#undef PG8_SB
#undef PG8_STAGE
#undef PG8_LDA
#undef PG8_LDB
#undef PG8_MMA
#undef PG8_WAIT_V
#undef PG8_WAIT_L
#undef PG8_BAR
#undef PG8_SCHED
}
}

#define LAS __attribute__((address_space(3)))
typedef unsigned short bf16_t;
typedef short bf16x8 __attribute__((ext_vector_type(8)));
typedef short bf16x4 __attribute__((ext_vector_type(4)));
typedef float f32x4 __attribute__((ext_vector_type(4)));
typedef float f32x16 __attribute__((ext_vector_type(16)));
typedef unsigned u32x4 __attribute__((ext_vector_type(4)));
typedef unsigned u32x2 __attribute__((ext_vector_type(2)));

constexpr int M_TOK = 32768, DM = 1024, SEQ = 2048, NB = 16;
constexpr int FF = 2816;
constexpr float ALPHA = 1.681792830507429f;
constexpr float LN_EPS = 1e-5f, RMS_EPS = 1e-6f;
constexpr float QSCALE = 0.10206207261596575f * 1.4426950408889634f;

constexpr size_t MiB = 1u << 20;
constexpr size_t WS_MOD = 0, WS_LB = 3 * MiB / 2, WS_TAB = 2 * MiB;
constexpr size_t W_MWIN = 6 * MiB, W_MWQB = 11 * MiB, W_MWKVB = 31 * MiB / 2, W_MWO = 35 * MiB / 2, W_HWIN = 43 * MiB / 2, W_HWO = 75 * MiB / 2,
                 W_FWIN = 83 * MiB / 2, W_FWOUT = 171 * MiB / 2;
constexpr size_t WS_H = 108 * MiB, WS_R = 172 * MiB;
constexpr size_t R_T = WS_R, R_PROJ = WS_R, R_Q = WS_R, R_LATQ = WS_R + 132 * MiB, R_LATKV = WS_R + 180 * MiB, R_O = WS_R + 132 * MiB,
                 R_KR = WS_R + 196 * MiB, R_KN = WS_R + 198 * MiB, R_VT = WS_R + 262 * MiB;
constexpr size_t R_QS = WS_R, R_LOGF = WS_R + 64 * MiB, R_VV = WS_R + 192 * MiB, R_GS = WS_R + 256 * MiB;
constexpr size_t WS_END = WS_R + 326 * MiB;
constexpr int LDS_BYTES = 131072;

struct Params {
    const float* x; const float* c; const int* pos;
    const float* mla_qn; const float* mla_kvn; const float* hgrn_lb; const float* hgrn_gn;
    const float* ada_w; const float* ada_b; const float* ln_g; const float* ln_b;
    float* X; unsigned char* ws;
    const float* wsrc[8];
    float invf[16];
    int ph_lo, ph_hi;
};
typedef const __attribute__((address_space(4))) Params* ParamsPtr;
struct WType { int K, N, layers, mode; size_t dst; int drows; };
constexpr WType WT[8] = {
    {1024, 1056, 2, 0, W_MWIN, 1280}, {768, 1536, 2, 0, W_MWQB, 1536}, {256, 2048, 2, 2, W_MWKVB, 2048}, {1024, 1024, 2, 0, W_MWO, 1024},
    {1024, 4096, 2, 0, W_HWIN, 4096}, {1024, 1024, 2, 0, W_HWO, 1024}, {1024, 5632, 4, 1, W_FWIN, 5632}, {2816, 1024, 4, 0, W_FWOUT, 1024} };
constexpr int wt_items(int t) { return (WT[t].K / 64) * (WT[t].N / 32); }
constexpr int wt_total() { int s = 0; for (int t = 0; t < 8; ++t) s += wt_items(t) * WT[t].layers; return s; }

__device__ __forceinline__ unsigned pk2(float lo, float hi) { unsigned r; asm volatile("v_cvt_pk_bf16_f32 %0, %1, %2" : "=v"(r) : "v"(lo), "v"(hi)); return r; }
__device__ __forceinline__ float bf2f(unsigned short h) { return __uint_as_float((unsigned)h << 16); }
__device__ __forceinline__ float wave_sum(float v) {
#pragma unroll
    for (int o = 1; o < 64; o <<= 1) v += __shfl_xor(v, o);
    return v;
}
__device__ __forceinline__ float fast_rcp(float x) { return __builtin_amdgcn_rcpf(x); }
__device__ __forceinline__ float sigmoidf_(float x) { return fast_rcp(1.f + __expf(-x)); }
__device__ __forceinline__ float siluf_(float x) { return x * sigmoidf_(x); }
__device__ __forceinline__ int crow(int r, int hi) { return (r & 3) + 8 * (r >> 2) + 4 * hi; }
__device__ __forceinline__ f32x16 mfma32(bf16x8 a, bf16x8 b, f32x16 c) { return __builtin_amdgcn_mfma_f32_32x32x16_bf16(a, b, c, 0, 0, 0); }

struct EpiProj {
    static constexpr bool PERM = false, AFTER_DRAIN = false;
    float* O; int ldc, ncols;
    __device__ __forceinline__ void operator()(const pg8::f32x4 (&acc)[2][2][4][2], const pg8::Unit& u, int wr, int wc, int fr, int fq) const {
        const int row0 = u.pm * 256 + wr * 64 + fr, col0 = u.pn * 256 + wc * 32 + 4 * fq;
#pragma unroll
        for (int ai = 0; ai < 2; ++ai)
#pragma unroll
            for (int m = 0; m < 4; ++m) { float* rp = O + (size_t)(row0 + ai * 128 + m * 16) * ldc;
#pragma unroll
                for (int bj = 0; bj < 2; ++bj)
#pragma unroll
                    for (int n = 0; n < 2; ++n) { const int c = col0 + bj * 128 + n * 16; if (c < ncols) *(f32x4*)(rp + c) = acc[ai][bj][m][n]; } }
    }
};
struct EpiQ {
    static constexpr bool PERM = false, AFTER_DRAIN = false;
    bf16_t* Q; const float* tab;
    __device__ __forceinline__ void operator()(const pg8::f32x4 (&acc)[2][2][4][2], const pg8::Unit& u, int wr, int wc, int fr, int fq) const {
        const int row0 = u.pm * 256 + wr * 64 + fr;
#pragma unroll
        for (int bj = 0; bj < 2; ++bj) {
            const int c0 = u.pn * 256 + bj * 128 + wc * 32; const bool rope = ((c0 >> 5) % 3) == 2;
#pragma unroll
            for (int ai = 0; ai < 2; ++ai)
#pragma unroll
                for (int m = 0; m < 4; ++m) { const int row = row0 + ai * 128 + m * 16;
                    f32x4 v0 = acc[ai][bj][m][0], v1 = acc[ai][bj][m][1];
                    if (rope) { const f32x4 cs = *(const f32x4*)(tab + (size_t)row * 32 + 4 * fq), sn = *(const f32x4*)(tab + (size_t)row * 32 + 16 + 4 * fq);
                        const f32x4 a = v0 * cs - v1 * sn, b = v0 * sn + v1 * cs; v0 = a; v1 = b; }
                    v0 = v0 * QSCALE; v1 = v1 * QSCALE;
                    bf16_t* qp = Q + (size_t)row * 1536 + c0 + 4 * fq;
                    u32x2 w0, w1; w0.x = pk2(v0[0], v0[1]); w0.y = pk2(v0[2], v0[3]); w1.x = pk2(v1[0], v1[1]); w1.y = pk2(v1[2], v1[3]);
                    *(u32x2*)qp = w0; *(u32x2*)(qp + 16) = w1; }
        }
    }
};
struct EpiBf16 {
    static constexpr bool PERM = true, AFTER_DRAIN = false;
    bf16_t* O; int ldc;
    __device__ __forceinline__ void operator()(const pg8::f32x4 (&acc)[2][2][4][2], const pg8::Unit& u, int wr, int wc, int fr, int fq) const {
        const int row0 = u.pm * 256 + wr * 64 + fr, col0 = u.pn * 256 + wc * 32 + 8 * fq;
#pragma unroll
        for (int ai = 0; ai < 2; ++ai)
#pragma unroll
            for (int m = 0; m < 4; ++m) { bf16_t* rp = O + (size_t)(row0 + ai * 128 + m * 16) * ldc + col0;
#pragma unroll
                for (int bj = 0; bj < 2; ++bj) { const f32x4 a0 = acc[ai][bj][m][0], a1 = acc[ai][bj][m][1];
                    u32x4 w; w.x = pk2(a0[0], a0[1]); w.y = pk2(a0[2], a0[3]); w.z = pk2(a1[0], a1[1]); w.w = pk2(a1[2], a1[3]); *(u32x4*)(rp + bj * 128) = w; } }
    }
};
struct EpiVT {
    static constexpr bool PERM = true, AFTER_DRAIN = false;
    bf16_t* VT;
    __device__ __forceinline__ void operator()(const pg8::f32x4 (&acc)[2][2][4][2], const pg8::Unit& u, int wr, int wc, int fr, int fq) const {
        const int row0 = u.pm * 256 + wr * 64 + fr, tok0 = u.pn * 256 + wc * 32 + 8 * fq;
        bf16_t* base = VT + (size_t)(tok0 >> 11) * (1024 * 2048) + (tok0 & 2047);
#pragma unroll
        for (int ai = 0; ai < 2; ++ai)
#pragma unroll
            for (int m = 0; m < 4; ++m) { bf16_t* rp = base + (size_t)(row0 + ai * 128 + m * 16) * 2048;
#pragma unroll
                for (int bj = 0; bj < 2; ++bj) { const f32x4 a0 = acc[ai][bj][m][0], a1 = acc[ai][bj][m][1];
                    u32x4 w; w.x = pk2(a0[0], a0[1]); w.y = pk2(a0[2], a0[3]); w.z = pk2(a1[0], a1[1]); w.w = pk2(a1[2], a1[3]); *(u32x4*)(rp + bj * 128) = w; } }
    }
};
struct EpiResid {
    static constexpr bool PERM = false, AFTER_DRAIN = false;
    float* X; const float* modrow;
    __device__ __forceinline__ void operator()(const pg8::f32x4 (&acc)[2][2][4][2], const pg8::Unit& u, int wr, int wc, int fr, int fq) const {
        const int row0 = u.pm * 256 + wr * 64 + fr, col0 = u.pn * 256 + wc * 32 + 4 * fq;
        const int b = (u.pm * 256) >> 11; const float* gp = modrow + (size_t)b * 3072 + 2048 + col0;
        f32x4 gt[2][2];
#pragma unroll
        for (int bj = 0; bj < 2; ++bj)
#pragma unroll
            for (int n = 0; n < 2; ++n) gt[bj][n] = *(const f32x4*)(gp + bj * 128 + n * 16) + 1.0f;
#pragma unroll
        for (int ai = 0; ai < 2; ++ai)
#pragma unroll
            for (int m = 0; m < 4; ++m) { float* rp = X + (size_t)(row0 + ai * 128 + m * 16) * 1024 + col0;
#pragma unroll
                for (int bj = 0; bj < 2; ++bj)
#pragma unroll
                    for (int n = 0; n < 2; ++n) { f32x4* xp = (f32x4*)(rp + bj * 128 + n * 16); const f32x4 xo = *xp; *xp = xo * ALPHA + gt[bj][n] * acc[ai][bj][m][n]; } }
    }
};
struct EpiSwiGLU {
    static constexpr bool PERM = true, AFTER_DRAIN = false;
    bf16_t* T;
    __device__ __forceinline__ void operator()(const pg8::f32x4 (&acc)[2][2][4][2], const pg8::Unit& u, int wr, int wc, int fr, int fq) const {
        const int row0 = u.pm * 256 + wr * 64 + fr, col0 = u.pn * 128 + wc * 32 + 8 * fq;
#pragma unroll
        for (int ai = 0; ai < 2; ++ai)
#pragma unroll
            for (int m = 0; m < 4; ++m) {
                const f32x4 g0 = acc[ai][0][m][0], g1 = acc[ai][0][m][1], u0 = acc[ai][1][m][0], u1 = acc[ai][1][m][1];
                u32x4 w;
                w.x = pk2(siluf_(g0[0]) * u0[0], siluf_(g0[1]) * u0[1]); w.y = pk2(siluf_(g0[2]) * u0[2], siluf_(g0[3]) * u0[3]);
                w.z = pk2(siluf_(g1[0]) * u1[0], siluf_(g1[1]) * u1[1]); w.w = pk2(siluf_(g1[2]) * u1[2], siluf_(g1[3]) * u1[3]);
                *(u32x4*)(T + (size_t)(row0 + ai * 128 + m * 16) * FF + col0) = w; }
    }
};
struct EpiHgrnIn {
    static constexpr bool PERM = true, AFTER_DRAIN = false;
    bf16_t* QS; float* LOGF; const float* lb;
    __device__ __forceinline__ void operator()(const pg8::f32x4 (&acc)[2][2][4][2], const pg8::Unit& u, int wr, int wc, int fr, int fq) const {
        const int row0 = u.pm * 256 + wr * 64 + fr, region = u.pn >> 2, col0 = (u.pn & 3) * 256 + wc * 32 + 8 * fq;
        if (region == 1) {
#pragma unroll
            for (int bj = 0; bj < 2; ++bj) { const f32x4 l0 = *(const f32x4*)(lb + col0 + bj * 128), l1 = *(const f32x4*)(lb + col0 + bj * 128 + 4);
#pragma unroll
                for (int ai = 0; ai < 2; ++ai)
#pragma unroll
                    for (int m = 0; m < 4; ++m) { float* op = LOGF + (size_t)(row0 + ai * 128 + m * 16) * 1024 + col0 + bj * 128;
                        const f32x4 a0 = acc[ai][bj][m][0], a1 = acc[ai][bj][m][1]; f32x4 r0, r1;
#pragma unroll
                        for (int e = 0; e < 4; ++e) { r0[e] = __logf(l0[e] + (1.f - l0[e]) * sigmoidf_(a0[e])); r1[e] = __logf(l1[e] + (1.f - l1[e]) * sigmoidf_(a1[e])); }
                        *(f32x4*)op = r0; *(f32x4*)(op + 4) = r1; } }
        } else {
            bf16_t* base = QS + (size_t)(region == 0 ? 0 : (region == 2 ? (R_VV - R_QS) / 2 : (R_GS - R_QS) / 2)); const bool act = region != 2;
#pragma unroll
            for (int ai = 0; ai < 2; ++ai)
#pragma unroll
                for (int m = 0; m < 4; ++m)
#pragma unroll
                    for (int bj = 0; bj < 2; ++bj) { f32x4 a0 = acc[ai][bj][m][0], a1 = acc[ai][bj][m][1];
                        if (act) {
#pragma unroll
                            for (int e = 0; e < 4; ++e) { a0[e] = siluf_(a0[e]); a1[e] = siluf_(a1[e]); } }
                        u32x4 w; w.x = pk2(a0[0], a0[1]); w.y = pk2(a0[2], a0[3]); w.z = pk2(a1[0], a1[1]); w.w = pk2(a1[2], a1[3]);
                        *(u32x4*)(base + (size_t)(row0 + ai * 128 + m * 16) * 1024 + col0 + bj * 128) = w; }
        }
    }
};

__device__ __forceinline__ void transpose_item(const float* W, bf16_t* dst, int K, int N, int mode, int item, LAS float* scr, int lane) {
    const int nblk = N / 32, kb = item / nblk, nb = item % nblk, k0 = 64 * kb, n0 = 32 * nb;
    int drow0 = n0;
    if (mode == 1) { const int up = n0 >= FF, j0 = up ? n0 - FF : n0; drow0 = 256 * (j0 >> 7) + (up ? 128 : 0) + (j0 & 127); }
    if (mode == 2) { const int h = n0 >> 7, r = n0 & 127; drow0 = (r < 64) ? h * 64 + r : 1024 + h * 64 + (r - 64); }
#pragma unroll 8
    for (int i = 0; i < 32; ++i) { const int kk = 2 * i + (lane >> 5); scr[kk * 33 + (lane & 31)] = W[(size_t)(k0 + kk) * N + n0 + (lane & 31)]; }
    asm volatile("s_waitcnt lgkmcnt(0)" ::: "memory");
    const int c = lane & 7;
#pragma unroll
    for (int j = 0; j < 4; ++j) { const int n = (lane >> 3) + 8 * j; const LAS float* s = scr + (8 * c) * 33 + n;
        u32x4 o; o.x = pk2(s[0 * 33], s[1 * 33]); o.y = pk2(s[2 * 33], s[3 * 33]); o.z = pk2(s[4 * 33], s[5 * 33]); o.w = pk2(s[6 * 33], s[7 * 33]);
        *(u32x4*)(dst + (size_t)(drow0 + n) * K + k0 + 8 * c) = o; }
    asm volatile("s_waitcnt lgkmcnt(0)" ::: "memory");
}

__device__ __forceinline__ void prologue_phase(ParamsPtr pp, LAS unsigned char* lds) {
    const ParamsPtr p_ = pp;
#define p (*p_)
    const int tid = mk_tid(), lane = tid & 63, wave = __builtin_amdgcn_readfirstlane(tid >> 6);
    const int G = mk_grid();
    {
        LAS float* sc = (LAS float*)lds;
        LAS float* red = (LAS float*)(lds + 65536);
        for (int i = tid; i < NB * DM; i += 512) { const int b = i >> 10, k = i & 1023; const float v = p.c[i]; sc[k * 16 + b] = v / (1.f + __expf(-v)); }
        __syncthreads();
        float* MOD = (float*)(p.ws + WS_MOD);
        for (int it = mk_bid(); it < 8 * 48; it += G) {
            const int ls = it / 48, n0 = (it % 48) * 64, col = tid & 63, kg = tid >> 6;
            const float* W = p.ada_w + (size_t)ls * 1024 * 3072 + (size_t)(kg * 128) * 3072 + n0 + col;
            float acc[16];
#pragma unroll
            for (int b = 0; b < 16; ++b) acc[b] = 0.f;
#pragma unroll 4
            for (int k = 0; k < 128; ++k) { const float w = W[(size_t)k * 3072]; const LAS f32x4* s4 = (const LAS f32x4*)(sc + (kg * 128 + k) * 16);
#pragma unroll
                for (int q = 0; q < 4; ++q) { const f32x4 s = s4[q]; acc[4 * q + 0] += s[0] * w; acc[4 * q + 1] += s[1] * w; acc[4 * q + 2] += s[2] * w; acc[4 * q + 3] += s[3] * w; } }
#pragma unroll
            for (int q = 0; q < 4; ++q) *(LAS f32x4*)(red + (kg * 64 + col) * 16 + 4 * q) = (f32x4){acc[4 * q], acc[4 * q + 1], acc[4 * q + 2], acc[4 * q + 3]};
            __syncthreads();
            { const int b0 = 2 * kg;
#pragma unroll
              for (int bb = 0; bb < 2; ++bb) { float s = 0.f;
#pragma unroll
                  for (int g = 0; g < 8; ++g) s += red[(g * 64 + col) * 16 + b0 + bb];
                  MOD[((size_t)ls * 16 + b0 + bb) * 3072 + n0 + col] = s + p.ada_b[ls * 3072 + n0 + col]; } }
            __syncthreads();
        }
    }
    if (mk_bid() == 0) {
        float* LB = (float*)(p.ws + WS_LB);
        for (int cidx = tid; cidx < 1024; cidx += 512) { const float a0 = p.hgrn_lb[cidx], a1 = p.hgrn_lb[1024 + cidx], mx = fmaxf(a0, a1);
            const float e0 = expf(a0 - mx), e1 = expf(a1 - mx), s0 = e0 / (e0 + e1), s1 = e1 / (e0 + e1);
            LB[cidx] = s0 - s0; LB[1024 + cidx] = (s0 + s1) - s0; }
    }
    {
        float* TAB = (float*)(p.ws + WS_TAB);
        for (int gi = mk_bid() * 512 + tid; gi < M_TOK * 16; gi += G * 512) {
            const int m = gi >> 4, i = gi & 15; const float ang = (float)p.pos[m] * p.invf[i];
            const double r = (double)ang, q = rint(r * 0.63661977236758134308), t = fma(-q, 1.57079632679489661923, r), t2 = t * t;
            const double s = t * (1.0 + t2 * (-1.0 / 6 + t2 * (1.0 / 120 + t2 * (-1.0 / 5040 + t2 * (1.0 / 362880 + t2 * (-1.0 / 39916800 + t2 * (1.0 / 6227020800.0)))))));
            const double c = 1.0 + t2 * (-0.5 + t2 * (1.0 / 24 + t2 * (-1.0 / 720 + t2 * (1.0 / 40320 + t2 * (-1.0 / 3628800 + t2 * (1.0 / 479001600.0))))));
            const int qi = ((int)q) & 3; double cc, ss;
            if (qi == 0) { cc = c; ss = s; } else if (qi == 1) { cc = -s; ss = c; } else if (qi == 2) { cc = -c; ss = -s; } else { cc = s; ss = -c; }
            TAB[(size_t)m * 32 + i] = (float)cc; TAB[(size_t)m * 32 + 16 + i] = (float)ss; }
    }
    {
        for (int gi = mk_bid() * 512 + tid; gi < 2 * 224 * 128; gi += G * 512) { const int l = gi / (224 * 128), r = gi % (224 * 128);
            *(u32x4*)(p.ws + W_MWIN + (size_t)l * 1280 * 1024 * 2 + (size_t)1056 * 1024 * 2 + (size_t)r * 16) = (u32x4){0u, 0u, 0u, 0u}; }
    }
    __syncthreads();
    {
        LAS float* scr = (LAS float*)(lds + wave * 8448);
        const int gw = mk_bid() * 8 + wave, NGW = G * 8;
        for (int it = gw; it < wt_total(); it += NGW) {
            int r = it;
#pragma unroll
            for (int t = 0; t < 8; ++t) {
                const int ni = wt_items(t) * WT[t].layers;
                if (r >= 0 && r < ni) { const int l = r / wt_items(t), item = r % wt_items(t);
                    transpose_item(p.wsrc[t] + (size_t)l * WT[t].K * WT[t].N, (bf16_t*)(p.ws + WT[t].dst) + (size_t)l * WT[t].drows * WT[t].K, WT[t].K, WT[t].N, WT[t].mode, item, scr, lane); }
                r -= ni;
            }
        }
    }
}

#undef p
__device__ __forceinline__ void norm_phase(const float* src, float* dst, bool do_ln, const float* g, const float* bta, bool do_h, const float* modrow, bf16_t* H) {
    const int tid_ = mk_tid(), lane = tid_ & 63, wave = __builtin_amdgcn_readfirstlane(tid_ >> 6); const int gw = mk_bid() * 8 + wave, NGW = mk_grid() * 8;
    for (int m = gw; m < M_TOK; m += NGW) {
        const int b = m >> 11; const f32x4* xr = (const f32x4*)(src + (size_t)m * 1024) + lane;
        f32x4 v[4];
#pragma unroll
        for (int j = 0; j < 4; ++j) v[j] = xr[64 * j];
        if (do_ln) {
            float s = 0.f;
#pragma unroll
            for (int j = 0; j < 4; ++j) s += (v[j][0] + v[j][1]) + (v[j][2] + v[j][3]);
            const float mean = wave_sum(s) * (1.f / 1024.f); float s2 = 0.f;
#pragma unroll
            for (int j = 0; j < 4; ++j) { v[j] = v[j] - mean; s2 += (v[j][0] * v[j][0] + v[j][1] * v[j][1]) + (v[j][2] * v[j][2] + v[j][3] * v[j][3]); }
            const float rstd = 1.0f / sqrtf(wave_sum(s2) * (1.f / 1024.f) + LN_EPS);
#pragma unroll
            for (int j = 0; j < 4; ++j) { const f32x4 gg = *((const f32x4*)g + lane + 64 * j), bb = *((const f32x4*)bta + lane + 64 * j); v[j] = v[j] * rstd * gg + bb; }
        }
        if (do_ln || src != dst) { f32x4* xo = (f32x4*)(dst + (size_t)m * 1024) + lane;
#pragma unroll
            for (int j = 0; j < 4; ++j) xo[64 * j] = v[j]; }
        if (do_h) { const f32x4* sh = (const f32x4*)(modrow + (size_t)b * 3072) + lane; const f32x4* sc = (const f32x4*)(modrow + (size_t)b * 3072 + 1024) + lane;
            u32x2* ho = (u32x2*)(H + (size_t)m * 1024) + lane;
#pragma unroll
            for (int j = 0; j < 4; ++j) { const f32x4 h = v[j] * (sc[64 * j] + 1.0f) + sh[64 * j]; u32x2 w; w.x = pk2(h[0], h[1]); w.y = pk2(h[2], h[3]); ho[64 * j] = w; } }
    }
}

__device__ __forceinline__ void latnorm_phase(const float* PROJ, const float* qn, const float* kvn, const float* tab, bf16_t* LATQ, bf16_t* LATKV, bf16_t* KR) {
    const int tid_ = mk_tid(), lane = tid_ & 63, wave = __builtin_amdgcn_readfirstlane(tid_ >> 6); const int gw = mk_bid() * 8 + wave, NGW = mk_grid() * 8;
    for (int m = gw; m < M_TOK; m += NGW) {
        const float* pr = PROJ + (size_t)m * 1056;
        f32x4 v[3]; float s = 0.f;
#pragma unroll
        for (int j = 0; j < 3; ++j) { v[j] = *((const f32x4*)pr + lane + 64 * j); s += (v[j][0] * v[j][0] + v[j][1] * v[j][1]) + (v[j][2] * v[j][2] + v[j][3] * v[j][3]); }
        const f32x4 kv = *((const f32x4*)(pr + 768) + lane); const float s2 = (kv[0] * kv[0] + kv[1] * kv[1]) + (kv[2] * kv[2] + kv[3] * kv[3]);
        const float rq = 1.0f / sqrtf(wave_sum(s) * (1.f / 768.f) + RMS_EPS), rkv = 1.0f / sqrtf(wave_sum(s2) * (1.f / 256.f) + RMS_EPS);
#pragma unroll
        for (int j = 0; j < 3; ++j) { const f32x4 gg = *((const f32x4*)qn + lane + 64 * j); const f32x4 o = v[j] * rq * gg; u32x2 w; w.x = pk2(o[0], o[1]); w.y = pk2(o[2], o[3]);
            *((u32x2*)(LATQ + (size_t)m * 768) + lane + 64 * j) = w; }
        { const f32x4 gg = *((const f32x4*)kvn + lane); const f32x4 o = kv * rkv * gg; u32x2 w; w.x = pk2(o[0], o[1]); w.y = pk2(o[2], o[3]); *((u32x2*)(LATKV + (size_t)m * 256) + lane) = w; }
        if (lane < 16) { const float x1 = pr[1024 + lane], x2 = pr[1040 + lane], cs = tab[(size_t)m * 32 + lane], sn = tab[(size_t)m * 32 + 16 + lane];
            const unsigned w = pk2(x1 * cs - x2 * sn, x1 * sn + x2 * cs); KR[(size_t)m * 32 + lane] = (bf16_t)(w & 0xffff); KR[(size_t)m * 32 + 16 + lane] = (bf16_t)(w >> 16); }
    }
}

__device__ __forceinline__ void attn_phase(LAS unsigned char* lds, const bf16_t* Q, const bf16_t* KN, const bf16_t* KR, const bf16_t* VT, bf16_t* O) {
    constexpr int KPB = 208, VPB = 144, KSB = 64 * KPB, VSB = 64 * VPB;
    const int tid = mk_tid(), lane = tid & 63, wave = __builtin_amdgcn_readfirstlane(tid >> 6), q = lane & 31, g = lane >> 5;
    const unsigned kn_dst = (tid >> 3) * KPB + (tid & 7) * 16, kr_dst = (tid >> 2) * KPB + 128 + (tid & 3) * 16, vt_dst = 2 * KSB + (tid >> 3) * VPB + (tid & 7) * 16;
    for (int bh = mk_bid(); bh < 256; bh += mk_grid()) {
        const int b = bh >> 4, h = bh & 15;
        const bf16_t* kn_src = KN + (size_t)(b * 2048 + (tid >> 3)) * 1024 + h * 64 + (tid & 7) * 8;
        const bf16_t* kr_src = KR + (size_t)(b * 2048 + (tid >> 2)) * 32 + (tid & 3) * 8;
        const bf16_t* vt_src = VT + (size_t)(bh * 64 + (tid >> 3)) * 2048 + (tid & 7) * 8;
#pragma unroll 1
        for (int qb = 7; qb >= 0; --qb) {
            __syncthreads();
            const int r0 = qb * 256 + wave * 32, ntile = 4 * (qb + 1);
            bf16x8 qf[6];
            { const bf16_t* qp = Q + (size_t)(b * 2048 + r0 + q) * 1536 + h * 96 + g * 8;
#pragma unroll
              for (int ks = 0; ks < 6; ++ks) qf[ks] = *(const bf16x8*)(qp + ks * 16); }
            f32x16 o0, o1;
#pragma unroll
            for (int i = 0; i < 16; ++i) { o0[i] = 0.f; o1[i] = 0.f; }
            float mrow = -INFINITY, lrow = 0.f;
            u32x4 rk, rr, rv;
            rk = *(const u32x4*)kn_src; rv = *(const u32x4*)vt_src; if (tid < 256) rr = *(const u32x4*)kr_src;
            *(LAS u32x4*)(lds + kn_dst) = rk; *(LAS u32x4*)(lds + vt_dst) = rv; if (tid < 256) *(LAS u32x4*)(lds + kr_dst) = rr;
            __syncthreads();
#pragma unroll 1
            for (int j = 0; j < ntile; ++j) {
                const int cur = j & 1; const bool more = (j + 1 < ntile);
                if (more) { rk = *(const u32x4*)(kn_src + (size_t)(j + 1) * 64 * 1024); rv = *(const u32x4*)(vt_src + (j + 1) * 64); if (tid < 256) rr = *(const u32x4*)(kr_src + (size_t)(j + 1) * 64 * 32); }
                if (64 * j <= r0 + 31) {
                    const LAS unsigned char* kb_ = lds + cur * KSB; const LAS unsigned char* vb_ = lds + 2 * KSB + cur * VSB;
                    f32x16 s0, s1;
#pragma unroll
                    for (int i = 0; i < 16; ++i) { s0[i] = 0.f; s1[i] = 0.f; }
#pragma unroll
                    for (int ks = 0; ks < 6; ++ks) {
                        const bf16x8 a0 = *(const LAS bf16x8*)(kb_ + q * KPB + (ks * 16 + g * 8) * 2), a1 = *(const LAS bf16x8*)(kb_ + (32 + q) * KPB + (ks * 16 + g * 8) * 2);
                        s0 = mfma32(a0, qf[ks], s0); s1 = mfma32(a1, qf[ks], s1); }
                    if (64 * j + 63 > r0) { const int qa = r0 + q, k0 = 64 * j + 4 * g;
#pragma unroll
                        for (int i = 0; i < 16; ++i) { const int key = k0 + (i & 3) + 8 * (i >> 2); if (key > qa) s0[i] = -INFINITY; if (key + 32 > qa) s1[i] = -INFINITY; } }
                    float mx = fmaxf(s0[0], s1[0]);
#pragma unroll
                    for (int i = 1; i < 16; ++i) mx = fmaxf(mx, fmaxf(s0[i], s1[i]));
                    mx = fmaxf(mx, __shfl_xor(mx, 32));
                    const float mnew = fmaxf(mrow, mx), alpha = __builtin_amdgcn_exp2f(mrow - mnew); mrow = mnew;
                    float sum = 0.f;
#pragma unroll
                    for (int i = 0; i < 16; ++i) { s0[i] = __builtin_amdgcn_exp2f(s0[i] - mnew); s1[i] = __builtin_amdgcn_exp2f(s1[i] - mnew); sum += s0[i] + s1[i]; }
                    lrow = lrow * alpha + sum;
#pragma unroll
                    for (int i = 0; i < 16; ++i) { o0[i] *= alpha; o1[i] *= alpha; }
#pragma unroll
                    for (int kb = 0; kb < 2; ++kb)
#pragma unroll
                        for (int t2 = 0; t2 < 2; ++t2) {
                            u32x4 pw;
                            if (kb == 0) { pw.x = pk2(s0[8 * t2 + 0], s0[8 * t2 + 1]); pw.y = pk2(s0[8 * t2 + 2], s0[8 * t2 + 3]); pw.z = pk2(s0[8 * t2 + 4], s0[8 * t2 + 5]); pw.w = pk2(s0[8 * t2 + 6], s0[8 * t2 + 7]); }
                            else         { pw.x = pk2(s1[8 * t2 + 0], s1[8 * t2 + 1]); pw.y = pk2(s1[8 * t2 + 2], s1[8 * t2 + 3]); pw.z = pk2(s1[8 * t2 + 4], s1[8 * t2 + 5]); pw.w = pk2(s1[8 * t2 + 6], s1[8 * t2 + 7]); }
                            const bf16x8 pb = __builtin_bit_cast(bf16x8, pw);
                            const int ko = (32 * kb + 16 * t2 + 4 * g) * 2;
                            { const u32x2 lo = *(const LAS u32x2*)(vb_ + q * VPB + ko), hi = *(const LAS u32x2*)(vb_ + q * VPB + ko + 16);
                              const u32x4 av = (u32x4){lo.x, lo.y, hi.x, hi.y}; o0 = mfma32(__builtin_bit_cast(bf16x8, av), pb, o0); }
                            { const u32x2 lo = *(const LAS u32x2*)(vb_ + (32 + q) * VPB + ko), hi = *(const LAS u32x2*)(vb_ + (32 + q) * VPB + ko + 16);
                              const u32x4 av = (u32x4){lo.x, lo.y, hi.x, hi.y}; o1 = mfma32(__builtin_bit_cast(bf16x8, av), pb, o1); }
                        }
                }
                if (more) { const unsigned bo = (cur ^ 1) * KSB, vo = (cur ^ 1) * VSB;
                    *(LAS u32x4*)(lds + bo + kn_dst) = rk; *(LAS u32x4*)(lds + vo + vt_dst) = rv; if (tid < 256) *(LAS u32x4*)(lds + bo + kr_dst) = rr; }
                __syncthreads();
            }
            const float lt = lrow + __shfl_xor(lrow, 32), inv = 1.0f / lt;
            bf16_t* op = O + (size_t)(b * 2048 + r0 + q) * 1024 + h * 64 + 4 * g;
#pragma unroll
            for (int qd = 0; qd < 4; ++qd) {
                u32x2 w0, w1; w0.x = pk2(o0[4 * qd] * inv, o0[4 * qd + 1] * inv); w0.y = pk2(o0[4 * qd + 2] * inv, o0[4 * qd + 3] * inv);
                w1.x = pk2(o1[4 * qd] * inv, o1[4 * qd + 1] * inv); w1.y = pk2(o1[4 * qd + 2] * inv, o1[4 * qd + 3] * inv);
                *(u32x2*)(op + 8 * qd) = w0; *(u32x2*)(op + 32 + 8 * qd) = w1; }
        }
    }
}

__device__ __forceinline__ void hgrn_phase(LAS unsigned char* lds, const bf16_t* QS, const float* LOGF, const bf16_t* VV, const bf16_t* GS, const float* gn, bf16_t* OG) {
    constexpr int QP = 0, KPN = 8704, KPT = 17408, VTT = 27648, SST = 37888, OPART = 72704, GSUM = 106496, ELAST = 108544;
    const int tid = mk_tid(), lane = tid & 63, wave = __builtin_amdgcn_readfirstlane(tid >> 6), q = lane & 31, g = lane >> 5;
    const int ch = tid & 127, tg = tid >> 7, vb = wave & 3, kh = wave >> 2;
    const int dt = tid >> 4, dpart = tid & 15;
    for (int bh = mk_bid(); bh < 128; bh += mk_grid()) {
        const int b = bh >> 3, hh = bh & 7;
        __syncthreads();
        f32x16 st0, st1;
#pragma unroll
        for (int i = 0; i < 16; ++i) { st0[i] = 0.f; st1[i] = 0.f; }
        const size_t ebase = (size_t)(b * 2048 + 8 * tg) * 1024 + hh * 128 + ch;
        const size_t dbase = (size_t)(b * 2048 + dt) * 1024 + hh * 128 + 8 * dpart;
        f32x4 gn0 = *(const f32x4*)(gn + 8 * dpart), gn1 = *(const f32x4*)(gn + 8 * dpart + 4);
        float lf[8]; unsigned short qs[8], vv[8];
#pragma unroll
        for (int i = 0; i < 8; ++i) { lf[i] = LOGF[ebase + (size_t)i * 1024]; qs[i] = QS[ebase + (size_t)i * 1024]; vv[i] = VV[ebase + (size_t)i * 1024]; }
#pragma unroll 1
        for (int c = 0; c < 64; ++c) {
            float cs[8]; cs[0] = lf[0];
#pragma unroll
            for (int i = 1; i < 8; ++i) cs[i] = cs[i - 1] + lf[i];
            *(LAS float*)(lds + GSUM + (tg * 128 + ch) * 4) = cs[7];
            __syncthreads();
            float off = 0.f, tot = 0.f;
#pragma unroll
            for (int t = 0; t < 4; ++t) { const float gs_ = *(const LAS float*)(lds + GSUM + (t * 128 + ch) * 4); if (t < tg) off += gs_; tot += gs_; }
            {
                unsigned kt[4], vt[4];
#pragma unroll
                for (int i = 0; i < 8; i += 2) {
                    const float b0 = off + cs[i], b1 = off + cs[i + 1];
                    const float q0 = bf2f(qs[i]) * __expf(b0), q1 = bf2f(qs[i + 1]) * __expf(b1);
                    const float k0 = (1.f - __expf(lf[i])) * __expf(-b0), k1 = (1.f - __expf(lf[i + 1])) * __expf(-b1);
                    const unsigned qw = pk2(q0, q1), kw = pk2(k0, k1);
                    *(LAS unsigned short*)(lds + QP + (8 * tg + i) * 272 + ch * 2) = (unsigned short)(qw & 0xffff);
                    *(LAS unsigned short*)(lds + QP + (8 * tg + i + 1) * 272 + ch * 2) = (unsigned short)(qw >> 16);
                    *(LAS unsigned short*)(lds + KPN + (8 * tg + i) * 272 + ch * 2) = (unsigned short)(kw & 0xffff);
                    *(LAS unsigned short*)(lds + KPN + (8 * tg + i + 1) * 272 + ch * 2) = (unsigned short)(kw >> 16);
                    kt[i >> 1] = kw; vt[i >> 1] = (unsigned)vv[i] | ((unsigned)vv[i + 1] << 16);
                }
                *(LAS u32x4*)(lds + KPT + ch * 80 + tg * 16) = (u32x4){kt[0], kt[1], kt[2], kt[3]};
                *(LAS u32x4*)(lds + VTT + ch * 80 + tg * 16) = (u32x4){vt[0], vt[1], vt[2], vt[3]};
                if (tg == 3) *(LAS float*)(lds + ELAST + ch * 4) = __expf(tot);
            }
#pragma unroll
            for (int qd = 0; qd < 4; ++qd) {
                u32x2 w0, w1; w0.x = pk2(st0[4 * qd], st0[4 * qd + 1]); w0.y = pk2(st0[4 * qd + 2], st0[4 * qd + 3]); w1.x = pk2(st1[4 * qd], st1[4 * qd + 1]); w1.y = pk2(st1[4 * qd + 2], st1[4 * qd + 3]);
                *(LAS u32x2*)(lds + SST + (32 * vb + q) * 272 + (32 * (2 * kh) + 8 * qd + 4 * g) * 2) = w0;
                *(LAS u32x2*)(lds + SST + (32 * vb + q) * 272 + (32 * (2 * kh + 1) + 8 * qd + 4 * g) * 2) = w1; }
            __syncthreads();
            if (c + 1 < 64) { const size_t e2 = ebase + (size_t)(c + 1) * 32 * 1024;
#pragma unroll
                for (int i = 0; i < 8; ++i) { lf[i] = LOGF[e2 + (size_t)i * 1024]; qs[i] = QS[e2 + (size_t)i * 1024]; vv[i] = VV[e2 + (size_t)i * 1024]; } }
            const u32x4 gsv = *(const u32x4*)(GS + dbase + (size_t)c * 32 * 1024);
            {
                f32x16 oT;
#pragma unroll
                for (int i = 0; i < 16; ++i) oT[i] = 0.f;
#pragma unroll
                for (int ks = 0; ks < 4; ++ks) { const int k0 = (64 * kh + 16 * ks + 8 * g) * 2;
                    oT = mfma32(*(const LAS bf16x8*)(lds + SST + (32 * vb + q) * 272 + k0), *(const LAS bf16x8*)(lds + QP + q * 272 + k0), oT); }
                if (kh == 0) {
                    f32x16 aT;
#pragma unroll
                    for (int i = 0; i < 16; ++i) aT[i] = 0.f;
#pragma unroll
                    for (int ks = 0; ks < 8; ++ks) { const int k0 = (16 * ks + 8 * g) * 2;
                        aT = mfma32(*(const LAS bf16x8*)(lds + KPN + q * 272 + k0), *(const LAS bf16x8*)(lds + QP + q * 272 + k0), aT); }
#pragma unroll
                    for (int i = 0; i < 16; ++i) { const int s = (i & 3) + 8 * (i >> 2) + 4 * g; if (s > q) aT[i] = 0.f; }
#pragma unroll
                    for (int t2 = 0; t2 < 2; ++t2) {
                        u32x4 pw; pw.x = pk2(aT[8 * t2 + 0], aT[8 * t2 + 1]); pw.y = pk2(aT[8 * t2 + 2], aT[8 * t2 + 3]); pw.z = pk2(aT[8 * t2 + 4], aT[8 * t2 + 5]); pw.w = pk2(aT[8 * t2 + 6], aT[8 * t2 + 7]);
                        const int so = (16 * t2 + 4 * g) * 2;
                        const u32x2 lo = *(const LAS u32x2*)(lds + VTT + (32 * vb + q) * 80 + so), hi = *(const LAS u32x2*)(lds + VTT + (32 * vb + q) * 80 + so + 16);
                        const u32x4 av = (u32x4){lo.x, lo.y, hi.x, hi.y};
                        oT = mfma32(__builtin_bit_cast(bf16x8, av), __builtin_bit_cast(bf16x8, pw), oT); }
                }
#pragma unroll
                for (int qd = 0; qd < 4; ++qd) *(LAS f32x4*)(lds + OPART + kh * 16896 + q * 528 + (32 * vb + 8 * qd + 4 * g) * 4) = (f32x4){oT[4 * qd], oT[4 * qd + 1], oT[4 * qd + 2], oT[4 * qd + 3]};
            }
#pragma unroll
            for (int t2 = 0; t2 < 2; ++t2) { const int so = (16 * t2 + 8 * g) * 2; const bf16x8 bv = *(const LAS bf16x8*)(lds + VTT + (32 * vb + q) * 80 + so);
                st0 = mfma32(*(const LAS bf16x8*)(lds + KPT + (32 * (2 * kh) + q) * 80 + so), bv, st0);
                st1 = mfma32(*(const LAS bf16x8*)(lds + KPT + (32 * (2 * kh + 1) + q) * 80 + so), bv, st1); }
#pragma unroll
            for (int qd = 0; qd < 4; ++qd) { const f32x4 e0 = *(const LAS f32x4*)(lds + ELAST + (32 * (2 * kh) + 8 * qd + 4 * g) * 4), e1 = *(const LAS f32x4*)(lds + ELAST + (32 * (2 * kh + 1) + 8 * qd + 4 * g) * 4);
#pragma unroll
                for (int e = 0; e < 4; ++e) { st0[4 * qd + e] *= e0[e]; st1[4 * qd + e] *= e1[e]; } }
            __syncthreads();
            {
                const LAS float* o0p = (const LAS float*)(lds + OPART + dt * 528 + dpart * 32); const LAS float* o1p = (const LAS float*)(lds + OPART + 16896 + dt * 528 + dpart * 32);
                const f32x4 a0 = *(const LAS f32x4*)o0p + *(const LAS f32x4*)o1p, a1 = *(const LAS f32x4*)(o0p + 4) + *(const LAS f32x4*)(o1p + 4);
                float ss = (a0[0] * a0[0] + a0[1] * a0[1]) + (a0[2] * a0[2] + a0[3] * a0[3]) + (a1[0] * a1[0] + a1[1] * a1[1]) + (a1[2] * a1[2] + a1[3] * a1[3]);
                ss += __shfl_xor(ss, 1); ss += __shfl_xor(ss, 2); ss += __shfl_xor(ss, 4); ss += __shfl_xor(ss, 8);
                const float rstd = 1.0f / sqrtf(ss * (1.f / 128.f) + RMS_EPS);
                const f32x4 r0 = a0 * rstd * gn0, r1 = a1 * rstd * gn1;
                u32x4 w;
                w.x = pk2(r0[0] * bf2f((unsigned short)(gsv.x & 0xffff)), r0[1] * bf2f((unsigned short)(gsv.x >> 16)));
                w.y = pk2(r0[2] * bf2f((unsigned short)(gsv.y & 0xffff)), r0[3] * bf2f((unsigned short)(gsv.y >> 16)));
                w.z = pk2(r1[0] * bf2f((unsigned short)(gsv.z & 0xffff)), r1[1] * bf2f((unsigned short)(gsv.z >> 16)));
                w.w = pk2(r1[2] * bf2f((unsigned short)(gsv.w & 0xffff)), r1[3] * bf2f((unsigned short)(gsv.w >> 16)));
                *(u32x4*)(OG + dbase + (size_t)c * 32 * 1024) = w;
            }
        }
    }
}

constexpr int N_PHASES = 34;
template <class Epi>
__device__ __forceinline__ void run_gemm(LAS unsigned char* lds, const bf16_t* A, const bf16_t* Bt, int N, int K, const Epi& E) {
    asm volatile("" : "+s"(K), "+s"(N));
    pg8::Gemm g{A, Bt, M_TOK, N, K}; pg8::StaticOrder S; S.init(M_TOK, N, mk_grid(), mk_bid());
    pg8::gemm_phase<Epi, pg8::StaticOrder, true, true>((PG8_LAS unsigned char*)lds, g, S, E);
}

template <class Epi>
__device__ __forceinline__ void run_gemm_t(LAS unsigned char* lds, const bf16_t* A, const bf16_t* Bt, int K, const Epi& E) {
    asm volatile("" : "+s"(K));
    pg8::Gemm g{A, Bt, 1024, M_TOK, K}; pg8::StaticOrder S; S.init(1024, M_TOK, mk_grid(), mk_bid());
    pg8::gemm_phase<Epi, pg8::StaticOrder, true, true>((PG8_LAS unsigned char*)lds, g, S, E);
}

__global__ void __launch_bounds__(512, 2) fwd_megakernel(Params p) {
    extern __shared__ __attribute__((aligned(16))) unsigned char lds_raw[];
    LAS unsigned char* lds = (LAS unsigned char*)lds_raw;
    cg::grid_group grid = cg::this_grid();
    const int ph_lo = p.ph_lo, ph_hi = p.ph_hi;
#pragma unroll 1
    for (int ph = ph_lo; ph < ph_hi; ++ph) {
        unsigned long long kptr = (unsigned long long)__builtin_amdgcn_kernarg_segment_ptr(); asm volatile("" : "+s"(kptr));
        const ParamsPtr pp = (ParamsPtr)kptr;
#define p (*pp)
        unsigned char* ws = p.ws;
        float* MOD = (float*)(ws + WS_MOD); const float* TAB = (const float*)(ws + WS_TAB); const float* LB = (const float*)(ws + WS_LB);
        bf16_t* H = (bf16_t*)(ws + WS_H);
        int kind, layer = 0;
        if (ph == 0) kind = 0; else if (ph == 1) kind = 1;
        else { const int qq = ph - 2, pair = qq >> 4, r = qq & 15;
            if (r < 9) { layer = 2 * pair; kind = (r < 6) ? 2 + r : 8 + (r - 6); if (r == 5) kind = 7; }
            else { layer = 2 * pair + 1; const int r2 = r - 9; kind = (r2 == 0) ? 11 : (r2 == 1) ? 12 : (r2 == 2) ? 6 : (r2 == 3) ? 7 : 8 + (r2 - 4); } }
        const int j = layer >> 1;
        switch (kind) {
        case 0: prologue_phase(pp, lds); break;
        case 1: norm_phase(p.x, p.X, false, nullptr, nullptr, true, MOD, H); break;
        case 2: { EpiProj E{(float*)(ws + R_PROJ), 1056, 1056}; run_gemm(lds, H, (const bf16_t*)(ws + W_MWIN) + (size_t)j * 1280 * 1024, 1280, 1024, E); } break;
        case 3: latnorm_phase((const float*)(ws + R_PROJ), p.mla_qn + j * 768, p.mla_kvn + j * 256, TAB, (bf16_t*)(ws + R_LATQ), (bf16_t*)(ws + R_LATKV), (bf16_t*)(ws + R_KR)); break;
        case 4: { EpiQ Eq{(bf16_t*)(ws + R_Q), TAB}; run_gemm(lds, (const bf16_t*)(ws + R_LATQ), (const bf16_t*)(ws + W_MWQB) + (size_t)j * 1536 * 768, 1536, 768, Eq);
                  const bf16_t* Wkv = (const bf16_t*)(ws + W_MWKVB) + (size_t)j * 2048 * 256;
                  EpiBf16 Ek{(bf16_t*)(ws + R_KN), 1024}; run_gemm(lds, (const bf16_t*)(ws + R_LATKV), Wkv, 1024, 256, Ek);
                  EpiVT Ev{(bf16_t*)(ws + R_VT)}; run_gemm_t(lds, Wkv + (size_t)1024 * 256, (const bf16_t*)(ws + R_LATKV), 256, Ev); } break;
        case 5: attn_phase(lds, (const bf16_t*)(ws + R_Q), (const bf16_t*)(ws + R_KN), (const bf16_t*)(ws + R_KR), (const bf16_t*)(ws + R_VT), (bf16_t*)(ws + R_O)); break;
        case 6: { const bool mla = (layer & 1) == 0; EpiResid E{p.X, MOD + (size_t)(2 * layer) * 16 * 3072};
                  const bf16_t* A = mla ? (const bf16_t*)(ws + R_O) : (const bf16_t*)H;
                  const bf16_t* Bt = mla ? (const bf16_t*)(ws + W_MWO) + (size_t)j * 1024 * 1024 : (const bf16_t*)(ws + W_HWO) + (size_t)j * 1024 * 1024;
                  run_gemm(lds, A, Bt, 1024, 1024, E); } break;
        case 7: norm_phase(p.X, p.X, true, p.ln_g + (size_t)(2 * layer) * 1024, p.ln_b + (size_t)(2 * layer) * 1024, true, MOD + (size_t)(2 * layer + 1) * 16 * 3072, H); break;
        case 8: { EpiSwiGLU E{(bf16_t*)(ws + R_T)}; run_gemm(lds, H, (const bf16_t*)(ws + W_FWIN) + (size_t)layer * 5632 * 1024, 5632, 1024, E); } break;
        case 9: { EpiResid E{p.X, MOD + (size_t)(2 * layer + 1) * 16 * 3072}; run_gemm(lds, (const bf16_t*)(ws + R_T), (const bf16_t*)(ws + W_FWOUT) + (size_t)layer * 1024 * FF, 1024, FF, E); } break;
        case 10: norm_phase(p.X, p.X, true, p.ln_g + (size_t)(2 * layer + 1) * 1024, p.ln_b + (size_t)(2 * layer + 1) * 1024, layer < 3, MOD + (size_t)(2 * layer + 2) * 16 * 3072, H); break;
        case 11: { EpiHgrnIn E{(bf16_t*)(ws + R_QS), (float*)(ws + R_LOGF), LB + j * 1024};
                   run_gemm(lds, H, (const bf16_t*)(ws + W_HWIN) + (size_t)j * 4096 * 1024, 4096, 1024, E); } break;
        case 12: hgrn_phase(lds, (const bf16_t*)(ws + R_QS), (const float*)(ws + R_LOGF), (const bf16_t*)(ws + R_VV), (const bf16_t*)(ws + R_GS), p.hgrn_gn + j * 128, H); break;
        default: break;
        }
        if (ph + 1 < ph_hi) grid.sync();
#undef p
    }
}

#ifndef MK_MULTI
#define MK_MULTI 0
#endif
extern "C" void kernel_launch(void* const* d_in, const int* in_sizes, int n_in, void* d_out, int out_size, void* d_ws, size_t ws_size, hipStream_t stream) {
    static int grid = 0;
    if (grid == 0) {
        if (n_in != 19 || out_size != M_TOK * DM || ws_size < WS_END) { fprintf(stderr, "kernel_launch: unexpected sizes: n_in %d out %d ws %zu (need %zu)\n", n_in, out_size, ws_size, (size_t)WS_END); grid = -1; return; }
        int dev = 0, cus = 0, per_cu = 0;
        hipGetDevice(&dev); hipDeviceGetAttribute(&cus, hipDeviceAttributeMultiprocessorCount, dev);
        if (hipFuncSetAttribute((const void*)fwd_megakernel, hipFuncAttributeMaxDynamicSharedMemorySize, LDS_BYTES) != hipSuccess) { fprintf(stderr, "kernel_launch: hipFuncSetAttribute failed\n"); grid = -1; return; }
        hipOccupancyMaxActiveBlocksPerMultiprocessor(&per_cu, (const void*)fwd_megakernel, 512, LDS_BYTES);
        (void)hipGetLastError();
        if (per_cu < 1) per_cu = 1;
        grid = cus * 1;
        fprintf(stderr, "kernel_launch: cus %d per_cu %d grid %d\n", cus, per_cu, grid);
    }
    if (grid < 0) return;
    Params p{};
    p.x = (const float*)d_in[0]; p.c = (const float*)d_in[1]; p.pos = (const int*)d_in[2];
    p.mla_qn = (const float*)d_in[4]; p.mla_kvn = (const float*)d_in[6]; p.hgrn_lb = (const float*)d_in[9]; p.hgrn_gn = (const float*)d_in[11];
    p.ada_w = (const float*)d_in[15]; p.ada_b = (const float*)d_in[16]; p.ln_g = (const float*)d_in[17]; p.ln_b = (const float*)d_in[18];
    p.X = (float*)d_out; p.ws = (unsigned char*)d_ws;
    p.wsrc[0] = (const float*)d_in[3]; p.wsrc[1] = (const float*)d_in[5]; p.wsrc[2] = (const float*)d_in[7]; p.wsrc[3] = (const float*)d_in[8];
    p.wsrc[4] = (const float*)d_in[10]; p.wsrc[5] = (const float*)d_in[12]; p.wsrc[6] = (const float*)d_in[13]; p.wsrc[7] = (const float*)d_in[14];
    for (int i = 0; i < 16; ++i) p.invf[i] = (float)pow(10000.0, -(double)i / 16.0);
#if MK_MULTI
    for (int ph = 0; ph < N_PHASES; ++ph) { p.ph_lo = ph; p.ph_hi = ph + 1; hipLaunchKernelGGL(fwd_megakernel, dim3(grid), dim3(512), LDS_BYTES, stream, p); }
#else
    p.ph_lo = 0; p.ph_hi = N_PHASES;
    void* args[] = {&p};
    hipError_t e = hipLaunchCooperativeKernel((const void*)fwd_megakernel, dim3(grid), dim3(512), args, LDS_BYTES, stream);
    if (e != hipSuccess) fprintf(stderr, "cooperative launch failed: %s (grid %d)\n", hipGetErrorString(e), grid);
#endif
}
```

```cpp
#include <hip/hip_runtime.h>
#include <hip/hip_cooperative_groups.h>
#include <cstdio>
#include <cstdint>
#include <cmath>
namespace cg = cooperative_groups;

__device__ __forceinline__ int mk_tid() { int t = (int)threadIdx.x; asm volatile("" : "+v"(t)); return t; }
__device__ __forceinline__ int mk_bid() { int t = (int)blockIdx.x; asm volatile("" : "+s"(t)); return t; }
__device__ __forceinline__ int mk_grid() { int t = (int)gridDim.x; asm volatile("" : "+s"(t)); return t; }
namespace pg8 {
#define PG8_LAS __attribute__((address_space(3)))
typedef unsigned short bf16_t;
typedef short bf16x8 __attribute__((ext_vector_type(8)));
typedef float f32x4 __attribute__((ext_vector_type(4)));
typedef unsigned u32x4 __attribute__((ext_vector_type(4)));
constexpr int BM = 256, BK = 64, HALF = 128, HTB = HALF * BK * 2  , STAGE_BYTES = 8 * HTB, NXCD = 8, WGM = 8;

__host__ __device__ __forceinline__ int lds_byte(int r, int c) { const int st = (r >> 4) * 2 + (c >> 5), rr = r & 15, cc = c & 31, ob = rr * 64 + cc * 2; return st * 1024 + (ob ^ (((ob >> 9) & 1) << 5)); }
__host__ __device__ __forceinline__ void stage_rc(int b, int& R, int& C) { const int st = b / 1024, sb = b % 1024, swz = sb ^ (((sb >> 9) & 1) << 5); R = (st >> 1) * 16 + swz / 64; C = (st & 1) * 32 + (swz % 64) / 2; }
__host__ __device__ __forceinline__ int perm32(int rho) { const int n = rho >> 4, i = rho & 15; return 8 * (i >> 2) + 4 * n + (i & 3); }

struct Unit { int pm, pn; };
struct Gemm { const bf16_t* A; const bf16_t* Bt; int M, N, K; };

struct StaticOrder {
    int nM, nN, nwg, G, c;
    __host__ __device__ void init(int M, int N, int G_, int c_) { nM = M / BM; nN = N / BM; nwg = nM * nN; G = G_; c = c_; }
    __host__ __device__ bool next(int i, Unit& u) const {
        const long L = (long)i * G + c; if (L >= nwg) return false;
        int wgid = (int)L; { const int q = nwg / NXCD, r = nwg % NXCD, xcd = wgid % NXCD, off = wgid / NXCD; wgid = (xcd < r ? xcd * (q + 1) : r * (q + 1) + (xcd - r) * q) + off; }
        const int nig = WGM * nN, gid = wgid / nig, fm = gid * WGM, gsz = (nM - fm) < WGM ? (nM - fm) : WGM;
        u.pm = fm + ((wgid % nig) % gsz); u.pn = (wgid % nig) / gsz; return true;
    }
    __device__ __forceinline__ void a_ready(const Unit&) const {}
    __device__ __forceinline__ void done(const Unit&) const {}
};

__device__ __forceinline__ unsigned cvt_pk_bf16(float lo, float hi) { unsigned r; asm volatile("v_cvt_pk_bf16_f32 %0, %1, %2" : "=v"(r) : "v"(lo), "v"(hi)); return r; }
template <class Epi, class Sched, bool ALIGN_EPI = false, bool SP2 = false>
__device__ __forceinline__ void gemm_phase(PG8_LAS unsigned char* lds, const Gemm g, const Sched& S, const Epi& E) {
    const int tid = mk_tid(), wid = __builtin_amdgcn_readfirstlane(tid >> 6), lane = tid & 63, wr = wid >> 2, wc = wid & 3, fr = lane & 15, fq = lane >> 4;
    const int K = g.K, nt = K / BK;
    unsigned voffA[2], voffB[2];
#pragma unroll
    for (int i = 0; i < 2; ++i) { int R, C; stage_rc(tid * 16 + i * 8192, R, C); const int Rb = Epi::PERM ? ((R & ~31) + perm32(R & 31)) : R;
        voffA[i] = (unsigned)(R * K + C) * 2u; voffB[i] = (unsigned)(Rb * K + C) * 2u; }
    const size_t kstep = (size_t)(BK * 2);
    const size_t hstep = (size_t)HALF * K * 2;
    const size_t tstep = 2 * hstep;
    const unsigned ldsw = (unsigned)wid * 1024u;
    const int aoff = lds_byte(wr * 64 + fr, fq * 8), boff = lds_byte(wc * 32 + fr, fq * 8);
#define PG8_SA(b, h) (((b) * 2 + (h)) * HTB)
#define PG8_SB(b, h) ((4 + (b) * 2 + (h)) * HTB)
#define PG8_STAGE(bufoff, gbase, voff) do { _Pragma("unroll") for (int _i = 0; _i < 2; ++_i) \
        __builtin_amdgcn_global_load_lds((const unsigned*)((const char*)(gbase) + (voff)[_i]), (PG8_LAS unsigned*)(lds + (bufoff) + ldsw + _i * 8192), 16, 0, 0); } while (0)
#define PG8_LDA(dst, b, h) do { _Pragma("unroll") for (int m = 0; m < 4; ++m) _Pragma("unroll") for (int k = 0; k < 2; ++k) dst[m][k] = *(const PG8_LAS bf16x8*)(lds + PG8_SA(b, h) + aoff + m * 2048 + k * 1024); } while (0)
#define PG8_LDB(dst, b, h) do { _Pragma("unroll") for (int n = 0; n < 2; ++n) _Pragma("unroll") for (int k = 0; k < 2; ++k) dst[n][k] = *(const PG8_LAS bf16x8*)(lds + PG8_SB(b, h) + boff + n * 2048 + k * 1024); } while (0)
#define PG8_MMA(ai, bj, At, Bt) do { __builtin_amdgcn_s_setprio(1); _Pragma("unroll") for (int m = 0; m < 4; ++m) _Pragma("unroll") for (int n = 0; n < 2; ++n) _Pragma("unroll") for (int k = 0; k < 2; ++k) \
        acc[ai][bj][m][n] = __builtin_amdgcn_mfma_f32_16x16x32_bf16(Bt[n][k], At[m][k], acc[ai][bj][m][n], 0, 0, 0); __builtin_amdgcn_s_setprio(0); } while (0)
#define PG8_WAIT_V(n) asm volatile("s_waitcnt vmcnt(" #n ")" ::: "memory")
#define PG8_WAIT_L(n) asm volatile("s_waitcnt lgkmcnt(" #n ")" ::: "memory")
#define PG8_BAR __builtin_amdgcn_s_barrier()
#define PG8_SCHED __builtin_amdgcn_sched_barrier(0)
    Unit cur, nxt; int ui = 0;
    if (!S.next(0, cur)) return;
    f32x4 acc[2][2][4][2];
#pragma unroll
    for (int a = 0; a < 2; ++a)
#pragma unroll
        for (int b = 0; b < 2; ++b)
#pragma unroll
            for (int m = 0; m < 4; ++m)
#pragma unroll
                for (int n = 0; n < 2; ++n) acc[a][b][m][n] = (f32x4){0.f, 0.f, 0.f, 0.f};
    bf16x8 At[4][2], B0[2][2], B1[2][2];
    const char* cA = (const char*)g.A + (size_t)cur.pm * tstep; const char* cB = (const char*)g.Bt + (size_t)cur.pn * tstep;
    S.a_ready(cur);
    if constexpr (SP2) {
        PG8_STAGE(PG8_SB(0, 0), cB, voffB); PG8_STAGE(PG8_SB(0, 1), cB + hstep, voffB); PG8_STAGE(PG8_SA(0, 0), cA, voffA); PG8_STAGE(PG8_SA(0, 1), cA + hstep, voffA);
        if (wr == 1) PG8_BAR;
        PG8_WAIT_V(2); PG8_BAR;
        PG8_STAGE(PG8_SB(1, 0), cB + kstep, voffB); PG8_STAGE(PG8_SA(1, 0), cA + kstep, voffA); PG8_STAGE(PG8_SB(1, 1), cB + hstep + kstep, voffB);
        PG8_WAIT_V(6); PG8_BAR;
    } else {
        PG8_STAGE(PG8_SB(0, 0), cB, voffB); PG8_STAGE(PG8_SA(0, 0), cA, voffA); PG8_STAGE(PG8_SB(0, 1), cB + hstep, voffB); PG8_STAGE(PG8_SA(0, 1), cA + hstep, voffA);
        if (wr == 1) PG8_BAR;
        PG8_WAIT_V(4); PG8_BAR;
        PG8_STAGE(PG8_SB(1, 0), cB + kstep, voffB); PG8_STAGE(PG8_SA(1, 0), cA + kstep, voffA); PG8_STAGE(PG8_SB(1, 1), cB + hstep + kstep, voffB);
        PG8_WAIT_V(6); PG8_BAR;
    }
    for (;;) {
        const bool has_next = S.next(ui + 1, nxt);
        const char* nA = has_next ? (const char*)g.A + (size_t)nxt.pm * tstep : cA; const char* nB = has_next ? (const char*)g.Bt + (size_t)nxt.pn * tstep : cB;
        for (int t = 0; t < nt; t += 2) {
            const bool last = (t == nt - 2);
            const char* a1 = cA + (size_t)(t + 1) * kstep;
            const char* a2 = last ? nA : cA + (size_t)(t + 2) * kstep; const char* b2 = last ? nB : cB + (size_t)(t + 2) * kstep;
            const char* a3 = a2 + kstep; const char* b3 = b2 + kstep;
            if (last && has_next) S.a_ready(nxt);
            if constexpr (SP2) {
            PG8_LDB(B0, 0, 0); PG8_LDB(B1, 0, 1); PG8_SCHED; PG8_LDA(At, 0, 0); PG8_STAGE(PG8_SA(1, 1), a1 + hstep, voffA);
            PG8_WAIT_V(8); PG8_WAIT_L(0); PG8_BAR; PG8_MMA(0, 0, At, B0); PG8_MMA(0, 1, At, B1); PG8_BAR; PG8_SCHED;
            PG8_LDA(At, 0, 1); PG8_STAGE(PG8_SB(0, 0), b2, voffB); PG8_STAGE(PG8_SB(0, 1), b2 + hstep, voffB); PG8_STAGE(PG8_SA(0, 0), a2, voffA);
            PG8_WAIT_V(8); PG8_WAIT_L(0); PG8_BAR; PG8_MMA(1, 0, At, B0); PG8_MMA(1, 1, At, B1); PG8_BAR; PG8_SCHED;
            PG8_LDB(B0, 1, 0); PG8_LDB(B1, 1, 1); PG8_SCHED; PG8_LDA(At, 1, 0); PG8_STAGE(PG8_SA(0, 1), a2 + hstep, voffA);
            PG8_WAIT_V(8); PG8_WAIT_L(0); PG8_BAR; PG8_MMA(0, 0, At, B0); PG8_MMA(0, 1, At, B1); PG8_BAR; PG8_SCHED;
            PG8_LDA(At, 1, 1); PG8_STAGE(PG8_SB(1, 0), b3, voffB); PG8_STAGE(PG8_SB(1, 1), b3 + hstep, voffB); PG8_STAGE(PG8_SA(1, 0), a3, voffA);
            PG8_WAIT_V(8); PG8_WAIT_L(0); PG8_BAR; PG8_MMA(1, 0, At, B0); PG8_MMA(1, 1, At, B1); PG8_BAR; PG8_SCHED;
            } else {
            PG8_LDB(B0, 0, 0); PG8_SCHED; PG8_LDA(At, 0, 0); PG8_STAGE(PG8_SA(1, 1), a1 + hstep, voffA);
            PG8_WAIT_L(8); PG8_BAR; PG8_WAIT_L(0); PG8_MMA(0, 0, At, B0); PG8_BAR; PG8_SCHED;
            PG8_LDB(B1, 0, 1); PG8_STAGE(PG8_SB(0, 0), b2, voffB);
            PG8_BAR; PG8_WAIT_L(0); PG8_MMA(0, 1, At, B1); PG8_BAR;
            PG8_LDA(At, 0, 1); PG8_STAGE(PG8_SA(0, 0), a2, voffA);
            PG8_BAR; PG8_WAIT_L(0); PG8_MMA(1, 0, At, B0); PG8_BAR; PG8_SCHED;
            PG8_STAGE(PG8_SB(0, 1), b2 + hstep, voffB);
            PG8_WAIT_V(6); PG8_BAR; PG8_MMA(1, 1, At, B1); PG8_BAR;
            PG8_LDB(B0, 1, 0); PG8_SCHED; PG8_LDA(At, 1, 0); PG8_STAGE(PG8_SA(0, 1), a2 + hstep, voffA);
            PG8_WAIT_L(8); PG8_BAR; PG8_WAIT_L(0); PG8_MMA(0, 0, At, B0); PG8_BAR; PG8_SCHED;
            PG8_LDB(B1, 1, 1); PG8_STAGE(PG8_SB(1, 0), b3, voffB);
            PG8_BAR; PG8_WAIT_L(0); PG8_MMA(0, 1, At, B1); PG8_BAR;
            PG8_LDA(At, 1, 1); PG8_STAGE(PG8_SA(1, 0), a3, voffA);
            PG8_BAR; PG8_WAIT_L(0); PG8_MMA(1, 0, At, B0); PG8_BAR; PG8_SCHED;
            PG8_STAGE(PG8_SB(1, 1), b3 + hstep, voffB);
            PG8_WAIT_V(6); PG8_BAR; PG8_MMA(1, 1, At, B1); PG8_BAR;
            }
        }
        if constexpr (ALIGN_EPI) { if (wr == 0) PG8_BAR; }
        if constexpr (!Epi::AFTER_DRAIN) { E(acc, cur, wr, wc, fr, fq); S.done(cur); }
        if (!has_next) break;
#pragma unroll
        for (int a = 0; a < 2; ++a)
#pragma unroll
            for (int b = 0; b < 2; ++b)
#pragma unroll
                for (int m = 0; m < 4; ++m)
#pragma unroll
                    for (int n = 0; n < 2; ++n) acc[a][b][m][n] = (f32x4){0.f, 0.f, 0.f, 0.f};
        cur = nxt; cA = nA; cB = nB; ++ui;
        if constexpr (ALIGN_EPI) { if (wr == 1) PG8_BAR; }
    }
    PG8_WAIT_V(0);
    if constexpr (!ALIGN_EPI) { if (wr == 0) PG8_BAR; }
    PG8_BAR;
    if constexpr (Epi::AFTER_DRAIN) { E.fused(acc, cur, wr, wc, fr, fq, lds, wid, lane); S.done(cur); }
#undef PG8_SA
#undef PG8_SB
#undef PG8_STAGE
#undef PG8_LDA
#undef PG8_LDB
#undef PG8_MMA
#undef PG8_WAIT_V
#undef PG8_WAIT_L
#undef PG8_BAR
#undef PG8_SCHED
}
}

#define LAS __attribute__((address_space(3)))
typedef unsigned short bf16_t;
typedef short bf16x8 __attribute__((ext_vector_type(8)));
typedef short bf16x4 __attribute__((ext_vector_type(4)));
typedef float f32x4 __attribute__((ext_vector_type(4)));
typedef float f32x16 __attribute__((ext_vector_type(16)));
typedef unsigned u32x4 __attribute__((ext_vector_type(4)));
typedef unsigned u32x2 __attribute__((ext_vector_type(2)));

constexpr int M_TOK = 32768, DM = 1024, SEQ = 2048, NB = 16;
constexpr int FF = 2816;
constexpr float ALPHA = 1.681792830507429f;
constexpr float LN_EPS = 1e-5f, RMS_EPS = 1e-6f;
constexpr float QSCALE = 0.10206207261596575f * 1.4426950408889634f;

constexpr size_t MiB = 1u << 20;
constexpr size_t WS_MOD = 0, WS_LB = 3 * MiB / 2, WS_TAB = 2 * MiB;
constexpr size_t W_MWIN = 6 * MiB, W_MWQB = 11 * MiB, W_MWKVB = 31 * MiB / 2, W_MWO = 35 * MiB / 2, W_HWIN = 43 * MiB / 2, W_HWO = 75 * MiB / 2,
                 W_FWIN = 83 * MiB / 2, W_FWOUT = 171 * MiB / 2;
constexpr size_t WS_H = 108 * MiB, WS_R = 172 * MiB;
constexpr size_t R_T = WS_R, R_PROJ = WS_R, R_Q = WS_R, R_LATQ = WS_R + 132 * MiB, R_LATKV = WS_R + 180 * MiB, R_O = WS_R + 132 * MiB,
                 R_KR = WS_R + 196 * MiB, R_KN = WS_R + 198 * MiB, R_VT = WS_R + 262 * MiB;
constexpr size_t R_QS = WS_R, R_LOGF = WS_R + 64 * MiB, R_VV = WS_R + 192 * MiB, R_GS = WS_R + 256 * MiB;
constexpr size_t WS_END = WS_R + 326 * MiB;
constexpr int LDS_BYTES = 131072 + 64;
constexpr size_t WS_BAR = WS_LB + 65536;

struct Params {
    const float* x; const float* c; const int* pos;
    const float* mla_qn; const float* mla_kvn; const float* hgrn_lb; const float* hgrn_gn;
    const float* ada_w; const float* ada_b; const float* ln_g; const float* ln_b;
    float* X; unsigned char* ws;
    const float* wsrc[8];
    float invf[16];
    int ph_lo, ph_hi;
};
typedef const __attribute__((address_space(4))) Params* ParamsPtr;
struct WType { int K, N, layers, mode; size_t dst; int drows; };
constexpr WType WT[8] = {
    {1024, 1056, 2, 0, W_MWIN, 1280}, {768, 1536, 2, 0, W_MWQB, 1536}, {256, 2048, 2, 2, W_MWKVB, 2048}, {1024, 1024, 2, 0, W_MWO, 1024},
    {1024, 4096, 2, 0, W_HWIN, 4096}, {1024, 1024, 2, 0, W_HWO, 1024}, {1024, 5632, 4, 1, W_FWIN, 5632}, {2816, 1024, 4, 0, W_FWOUT, 1024} };
constexpr int wt_items(int t) { return (WT[t].K / 64) * (WT[t].N / 32); }
constexpr int wt_total() { int s = 0; for (int t = 0; t < 8; ++t) s += wt_items(t) * WT[t].layers; return s; }

__device__ __forceinline__ unsigned pk2(float lo, float hi) { unsigned r; asm volatile("v_cvt_pk_bf16_f32 %0, %1, %2" : "=v"(r) : "v"(lo), "v"(hi)); return r; }
__device__ __forceinline__ float bf2f(unsigned short h) { return __uint_as_float((unsigned)h << 16); }
__device__ __forceinline__ float wave_sum(float v) {
#pragma unroll
    for (int o = 1; o < 64; o <<= 1) v += __shfl_xor(v, o);
    return v;
}
__device__ __forceinline__ float fast_rcp(float x) { return __builtin_amdgcn_rcpf(x); }
__device__ __forceinline__ float sigmoidf_(float x) { return fast_rcp(1.f + __expf(-x)); }
__device__ __forceinline__ float siluf_(float x) { return x * sigmoidf_(x); }
__device__ __forceinline__ int crow(int r, int hi) { return (r & 3) + 8 * (r >> 2) + 4 * hi; }
__device__ __forceinline__ f32x16 mfma32(bf16x8 a, bf16x8 b, f32x16 c) { return __builtin_amdgcn_mfma_f32_32x32x16_bf16(a, b, c, 0, 0, 0); }

struct EpiProj {
    static constexpr bool PERM = false, AFTER_DRAIN = false;
    float* O; int ldc, ncols;
    __device__ __forceinline__ void operator()(const pg8::f32x4 (&acc)[2][2][4][2], const pg8::Unit& u, int wr, int wc, int fr, int fq) const {
        const int row0 = u.pm * 256 + wr * 64 + fr, col0 = u.pn * 256 + wc * 32 + 4 * fq;
#pragma unroll
        for (int ai = 0; ai < 2; ++ai)
#pragma unroll
            for (int m = 0; m < 4; ++m) { float* rp = O + (size_t)(row0 + ai * 128 + m * 16) * ldc;
#pragma unroll
                for (int bj = 0; bj < 2; ++bj)
#pragma unroll
                    for (int n = 0; n < 2; ++n) { const int c = col0 + bj * 128 + n * 16; if (c < ncols) *(f32x4*)(rp + c) = acc[ai][bj][m][n]; } }
    }
};
struct EpiQ {
    static constexpr bool PERM = false, AFTER_DRAIN = false;
    bf16_t* Q; const float* tab;
    __device__ __forceinline__ void operator()(const pg8::f32x4 (&acc)[2][2][4][2], const pg8::Unit& u, int wr, int wc, int fr, int fq) const {
        const int row0 = u.pm * 256 + wr * 64 + fr;
#pragma unroll
        for (int bj = 0; bj < 2; ++bj) {
            const int c0 = u.pn * 256 + bj * 128 + wc * 32; const bool rope = ((c0 >> 5) % 3) == 2;
#pragma unroll
            for (int ai = 0; ai < 2; ++ai)
#pragma unroll
                for (int m = 0; m < 4; ++m) { const int row = row0 + ai * 128 + m * 16;
                    f32x4 v0 = acc[ai][bj][m][0], v1 = acc[ai][bj][m][1];
                    if (rope) { const f32x4 cs = *(const f32x4*)(tab + (size_t)row * 32 + 4 * fq), sn = *(const f32x4*)(tab + (size_t)row * 32 + 16 + 4 * fq);
                        const f32x4 a = v0 * cs - v1 * sn, b = v0 * sn + v1 * cs; v0 = a; v1 = b; }
                    v0 = v0 * QSCALE; v1 = v1 * QSCALE;
                    bf16_t* qp = Q + (size_t)row * 1536 + c0 + 4 * fq;
                    u32x2 w0, w1; w0.x = pk2(v0[0], v0[1]); w0.y = pk2(v0[2], v0[3]); w1.x = pk2(v1[0], v1[1]); w1.y = pk2(v1[2], v1[3]);
                    *(u32x2*)qp = w0; *(u32x2*)(qp + 16) = w1; }
        }
    }
};
struct EpiBf16 {
    static constexpr bool PERM = true, AFTER_DRAIN = false;
    bf16_t* O; int ldc;
    __device__ __forceinline__ void operator()(const pg8::f32x4 (&acc)[2][2][4][2], const pg8::Unit& u, int wr, int wc, int fr, int fq) const {
        const int row0 = u.pm * 256 + wr * 64 + fr, col0 = u.pn * 256 + wc * 32 + 8 * fq;
#pragma unroll
        for (int ai = 0; ai < 2; ++ai)
#pragma unroll
            for (int m = 0; m < 4; ++m) { bf16_t* rp = O + (size_t)(row0 + ai * 128 + m * 16) * ldc + col0;
#pragma unroll
                for (int bj = 0; bj < 2; ++bj) { const f32x4 a0 = acc[ai][bj][m][0], a1 = acc[ai][bj][m][1];
                    u32x4 w; w.x = pk2(a0[0], a0[1]); w.y = pk2(a0[2], a0[3]); w.z = pk2(a1[0], a1[1]); w.w = pk2(a1[2], a1[3]); *(u32x4*)(rp + bj * 128) = w; } }
    }
};
struct EpiVT {
    static constexpr bool PERM = true, AFTER_DRAIN = false;
    bf16_t* VT;
    __device__ __forceinline__ void operator()(const pg8::f32x4 (&acc)[2][2][4][2], const pg8::Unit& u, int wr, int wc, int fr, int fq) const {
        const int row0 = u.pm * 256 + wr * 64 + fr, tok0 = u.pn * 256 + wc * 32 + 8 * fq;
        bf16_t* base = VT + (size_t)(tok0 >> 11) * (1024 * 2048) + (tok0 & 2047);
#pragma unroll
        for (int ai = 0; ai < 2; ++ai)
#pragma unroll
            for (int m = 0; m < 4; ++m) { bf16_t* rp = base + (size_t)(row0 + ai * 128 + m * 16) * 2048;
#pragma unroll
                for (int bj = 0; bj < 2; ++bj) { const f32x4 a0 = acc[ai][bj][m][0], a1 = acc[ai][bj][m][1];
                    u32x4 w; w.x = pk2(a0[0], a0[1]); w.y = pk2(a0[2], a0[3]); w.z = pk2(a1[0], a1[1]); w.w = pk2(a1[2], a1[3]); *(u32x4*)(rp + bj * 128) = w; } }
    }
};
struct EpiResid {
    static constexpr bool PERM = false, AFTER_DRAIN = false;
    float* X; const float* modrow;
    __device__ __forceinline__ void operator()(const pg8::f32x4 (&acc)[2][2][4][2], const pg8::Unit& u, int wr, int wc, int fr, int fq) const {
        const int row0 = u.pm * 256 + wr * 64 + fr, col0 = u.pn * 256 + wc * 32 + 4 * fq;
        const int b = (u.pm * 256) >> 11; const float* gp = modrow + (size_t)b * 3072 + 2048 + col0;
        f32x4 gt[2][2];
#pragma unroll
        for (int bj = 0; bj < 2; ++bj)
#pragma unroll
            for (int n = 0; n < 2; ++n) gt[bj][n] = *(const f32x4*)(gp + bj * 128 + n * 16) + 1.0f;
#pragma unroll
        for (int ai = 0; ai < 2; ++ai)
#pragma unroll
            for (int m = 0; m < 4; ++m) { float* rp = X + (size_t)(row0 + ai * 128 + m * 16) * 1024 + col0;
#pragma unroll
                for (int bj = 0; bj < 2; ++bj)
#pragma unroll
                    for (int n = 0; n < 2; ++n) { f32x4* xp = (f32x4*)(rp + bj * 128 + n * 16); const f32x4 xo = *xp; *xp = xo * ALPHA + gt[bj][n] * acc[ai][bj][m][n]; } }
    }
};
struct EpiSwiGLU {
    static constexpr bool PERM = true, AFTER_DRAIN = false;
    bf16_t* T;
    __device__ __forceinline__ void operator()(const pg8::f32x4 (&acc)[2][2][4][2], const pg8::Unit& u, int wr, int wc, int fr, int fq) const {
        const int row0 = u.pm * 256 + wr * 64 + fr, col0 = u.pn * 128 + wc * 32 + 8 * fq;
#pragma unroll
        for (int ai = 0; ai < 2; ++ai)
#pragma unroll
            for (int m = 0; m < 4; ++m) {
                const f32x4 g0 = acc[ai][0][m][0], g1 = acc[ai][0][m][1], u0 = acc[ai][1][m][0], u1 = acc[ai][1][m][1];
                u32x4 w;
                w.x = pk2(siluf_(g0[0]) * u0[0], siluf_(g0[1]) * u0[1]); w.y = pk2(siluf_(g0[2]) * u0[2], siluf_(g0[3]) * u0[3]);
                w.z = pk2(siluf_(g1[0]) * u1[0], siluf_(g1[1]) * u1[1]); w.w = pk2(siluf_(g1[2]) * u1[2], siluf_(g1[3]) * u1[3]);
                *(u32x4*)(T + (size_t)(row0 + ai * 128 + m * 16) * FF + col0) = w; }
    }
};
struct EpiHgrnIn {
    static constexpr bool PERM = true, AFTER_DRAIN = false;
    bf16_t* QS; float* LOGF; const float* lb;
    __device__ __forceinline__ void operator()(const pg8::f32x4 (&acc)[2][2][4][2], const pg8::Unit& u, int wr, int wc, int fr, int fq) const {
        const int row0 = u.pm * 256 + wr * 64 + fr, region = u.pn >> 2, col0 = (u.pn & 3) * 256 + wc * 32 + 8 * fq;
        if (region == 1) {
#pragma unroll
            for (int bj = 0; bj < 2; ++bj) { const f32x4 l0 = *(const f32x4*)(lb + col0 + bj * 128), l1 = *(const f32x4*)(lb + col0 + bj * 128 + 4);
#pragma unroll
                for (int ai = 0; ai < 2; ++ai)
#pragma unroll
                    for (int m = 0; m < 4; ++m) { float* op = LOGF + (size_t)(row0 + ai * 128 + m * 16) * 1024 + col0 + bj * 128;
                        const f32x4 a0 = acc[ai][bj][m][0], a1 = acc[ai][bj][m][1]; f32x4 r0, r1;
#pragma unroll
                        for (int e = 0; e < 4; ++e) { r0[e] = __logf(l0[e] + (1.f - l0[e]) * sigmoidf_(a0[e])); r1[e] = __logf(l1[e] + (1.f - l1[e]) * sigmoidf_(a1[e])); }
                        *(f32x4*)op = r0; *(f32x4*)(op + 4) = r1; } }
        } else {
            bf16_t* base = QS + (size_t)(region == 0 ? 0 : (region == 2 ? (R_VV - R_QS) / 2 : (R_GS - R_QS) / 2)); const bool act = region != 2;
#pragma unroll
            for (int ai = 0; ai < 2; ++ai)
#pragma unroll
                for (int m = 0; m < 4; ++m)
#pragma unroll
                    for (int bj = 0; bj < 2; ++bj) { f32x4 a0 = acc[ai][bj][m][0], a1 = acc[ai][bj][m][1];
                        if (act) {
#pragma unroll
                            for (int e = 0; e < 4; ++e) { a0[e] = siluf_(a0[e]); a1[e] = siluf_(a1[e]); } }
                        u32x4 w; w.x = pk2(a0[0], a0[1]); w.y = pk2(a0[2], a0[3]); w.z = pk2(a1[0], a1[1]); w.w = pk2(a1[2], a1[3]);
                        *(u32x4*)(base + (size_t)(row0 + ai * 128 + m * 16) * 1024 + col0 + bj * 128) = w; }
        }
    }
};

#define XB_TMO      128
#define XB_XCNT(j)  (256  + 64 * (j))
#define XB_XSUB(j)  (1280 + 64 * (j))
#define XB_XGEN(j)  (2304 + 64 * (j))
#define XB_TOP      3328
#define XB_TOPGEN   3392
#define XCD_BAR_WORDS 3456
#define XB_SPIN_CAP (1u << 18)

__device__ __forceinline__ unsigned xb_ld(unsigned* p)              { return __hip_atomic_load(p, __ATOMIC_RELAXED, __HIP_MEMORY_SCOPE_AGENT); }
__device__ __forceinline__ unsigned xb_add(unsigned* p, unsigned v) { return __hip_atomic_fetch_add(p, v, __ATOMIC_RELAXED, __HIP_MEMORY_SCOPE_AGENT); }
__device__ __forceinline__ unsigned xb_xcc_id() { return (unsigned)__builtin_amdgcn_s_getreg((3 << 11) | 20) & 0xFu; }
#define XB_SPIN(cond, bar) do { unsigned _sp = 0; while (cond) { __builtin_amdgcn_s_sleep(1); \
    if ((++_sp & 255u) == 0u) { if (xb_ld(&(bar)[XB_TMO])) break; if (_sp > XB_SPIN_CAP) { atomicAdd(&(bar)[XB_TMO], 1u); break; } } } } while (0)

struct XcdBarrier {
    unsigned* bar; unsigned x;
    volatile LAS unsigned* st;
};

__device__ __forceinline__ XcdBarrier xcd_barrier_post(unsigned* bar, volatile LAS unsigned* st) {
    XcdBarrier b; b.bar = bar; b.x = xb_xcc_id(); b.st = st;
    if (mk_tid() == 0) (void)xb_add(&bar[XB_XCNT(b.x)], 1u);
    return b;
}
__device__ __forceinline__ void xcd_barrier_complete(unsigned* bar, unsigned x, unsigned& nloc, unsigned& nx) {
    const unsigned G = (unsigned)mk_grid();
    unsigned sum, cnt, mine, sp = 0u;
    for (;;) {
        sum = 0u; cnt = 0u; mine = 0u;
#pragma unroll
        for (unsigned j = 0; j < 16; ++j) { const unsigned c = xb_ld(&bar[XB_XCNT(j)]); sum += c; cnt += (c > 0u) ? 1u : 0u; mine = (j == x) ? c : mine; }
        if (sum == G) break;
        __builtin_amdgcn_s_sleep(1);
        if ((++sp & 255u) == 0u) { if (xb_ld(&bar[XB_TMO])) break; if (sp > XB_SPIN_CAP) { atomicAdd(&bar[XB_TMO], 1u); break; } }
    }
    nloc = mine > 0u ? mine : 1u; nx = cnt > 0u ? cnt : 1u;
}

__device__ __forceinline__ void xcd_barrier(const XcdBarrier& b) {
    asm volatile("s_waitcnt vmcnt(0)" ::: "memory");
    __syncthreads();
    if (mk_tid() == 0) {
        unsigned* bar = b.bar;
        __builtin_amdgcn_s_waitcnt(0);
        unsigned nloc = b.st[0], nx = b.st[1];
        if (nloc == 0u) { xcd_barrier_complete(bar, b.x, nloc, nx); b.st[0] = nloc; b.st[1] = nx; }
        const unsigned old = xb_add(&bar[XB_XSUB(b.x)], 1u);
        const unsigned gen = old / nloc;
        if (old + 1u == (gen + 1u) * nloc) {
            __builtin_amdgcn_fence(__ATOMIC_RELEASE, "agent");
            asm volatile("s_waitcnt vmcnt(0)" ::: "memory");
            const unsigned og = xb_add(&bar[XB_TOP], 1u);
            const unsigned tg = og / nx;
            if (og + 1u == (tg + 1u) * nx) xb_add(&bar[XB_TOPGEN], 1u);
            else XB_SPIN(xb_ld(&bar[XB_TOPGEN]) == tg, bar);
            __builtin_amdgcn_fence(__ATOMIC_ACQUIRE, "agent");
            xb_add(&bar[XB_XGEN(b.x)], 1u);
            asm volatile("s_waitcnt vmcnt(0)" ::: "memory");
        } else {
            XB_SPIN(xb_ld(&bar[XB_XGEN(b.x)]) == gen, bar);
            __builtin_amdgcn_fence(__ATOMIC_ACQUIRE, "agent");
            asm volatile("s_waitcnt vmcnt(0)" ::: "memory");
        }
    }
    __syncthreads();
}


__device__ __forceinline__ void transpose_item(const float* W, bf16_t* dst, int K, int N, int mode, int item, LAS float* scr, int lane) {
    const int nblk = N / 32, kb = item / nblk, nb = item % nblk, k0 = 64 * kb, n0 = 32 * nb;
    int drow0 = n0;
    if (mode == 1) { const int up = n0 >= FF, j0 = up ? n0 - FF : n0; drow0 = 256 * (j0 >> 7) + (up ? 128 : 0) + (j0 & 127); }
    if (mode == 2) { const int h = n0 >> 7, r = n0 & 127; drow0 = (r < 64) ? h * 64 + r : 1024 + h * 64 + (r - 64); }
#pragma unroll 8
    for (int i = 0; i < 32; ++i) { const int kk = 2 * i + (lane >> 5); scr[kk * 33 + (lane & 31)] = W[(size_t)(k0 + kk) * N + n0 + (lane & 31)]; }
    asm volatile("s_waitcnt lgkmcnt(0)" ::: "memory");
    const int c = lane & 7;
#pragma unroll
    for (int j = 0; j < 4; ++j) { const int n = (lane >> 3) + 8 * j; const LAS float* s = scr + (8 * c) * 33 + n;
        u32x4 o; o.x = pk2(s[0 * 33], s[1 * 33]); o.y = pk2(s[2 * 33], s[3 * 33]); o.z = pk2(s[4 * 33], s[5 * 33]); o.w = pk2(s[6 * 33], s[7 * 33]);
        *(u32x4*)(dst + (size_t)(drow0 + n) * K + k0 + 8 * c) = o; }
    asm volatile("s_waitcnt lgkmcnt(0)" ::: "memory");
}

__device__ __forceinline__ void prologue_phase(ParamsPtr pp, LAS unsigned char* lds) {
    const ParamsPtr p_ = pp;
#define p (*p_)
    const int tid = mk_tid(), lane = tid & 63, wave = __builtin_amdgcn_readfirstlane(tid >> 6);
    const int G = mk_grid();
    {
        LAS float* sc = (LAS float*)lds;
        LAS float* red = (LAS float*)(lds + 65536);
        for (int i = tid; i < NB * DM; i += 512) { const int b = i >> 10, k = i & 1023; const float v = p.c[i]; sc[k * 16 + b] = v / (1.f + __expf(-v)); }
        __syncthreads();
        float* MOD = (float*)(p.ws + WS_MOD);
        for (int it = mk_bid(); it < 8 * 48; it += G) {
            const int ls = it / 48, n0 = (it % 48) * 64, col = tid & 63, kg = tid >> 6;
            const float* W = p.ada_w + (size_t)ls * 1024 * 3072 + (size_t)(kg * 128) * 3072 + n0 + col;
            float acc[16];
#pragma unroll
            for (int b = 0; b < 16; ++b) acc[b] = 0.f;
#pragma unroll 4
            for (int k = 0; k < 128; ++k) { const float w = W[(size_t)k * 3072]; const LAS f32x4* s4 = (const LAS f32x4*)(sc + (kg * 128 + k) * 16);
#pragma unroll
                for (int q = 0; q < 4; ++q) { const f32x4 s = s4[q]; acc[4 * q + 0] += s[0] * w; acc[4 * q + 1] += s[1] * w; acc[4 * q + 2] += s[2] * w; acc[4 * q + 3] += s[3] * w; } }
#pragma unroll
            for (int q = 0; q < 4; ++q) *(LAS f32x4*)(red + (kg * 64 + col) * 16 + 4 * q) = (f32x4){acc[4 * q], acc[4 * q + 1], acc[4 * q + 2], acc[4 * q + 3]};
            __syncthreads();
            { const int b0 = 2 * kg;
#pragma unroll
              for (int bb = 0; bb < 2; ++bb) { float s = 0.f;
#pragma unroll
                  for (int g = 0; g < 8; ++g) s += red[(g * 64 + col) * 16 + b0 + bb];
                  MOD[((size_t)ls * 16 + b0 + bb) * 3072 + n0 + col] = s + p.ada_b[ls * 3072 + n0 + col]; } }
            __syncthreads();
        }
    }
    if (mk_bid() == 0) {
        float* LB = (float*)(p.ws + WS_LB);
        for (int cidx = tid; cidx < 1024; cidx += 512) { const float a0 = p.hgrn_lb[cidx], a1 = p.hgrn_lb[1024 + cidx], mx = fmaxf(a0, a1);
            const float e0 = expf(a0 - mx), e1 = expf(a1 - mx), s0 = e0 / (e0 + e1), s1 = e1 / (e0 + e1);
            LB[cidx] = s0 - s0; LB[1024 + cidx] = (s0 + s1) - s0; }
    }
    {
        float* TAB = (float*)(p.ws + WS_TAB);
        for (int gi = mk_bid() * 512 + tid; gi < M_TOK * 16; gi += G * 512) {
            const int m = gi >> 4, i = gi & 15; const float ang = (float)p.pos[m] * p.invf[i];
            const double r = (double)ang, q = rint(r * 0.63661977236758134308), t = fma(-q, 1.57079632679489661923, r), t2 = t * t;
            const double s = t * (1.0 + t2 * (-1.0 / 6 + t2 * (1.0 / 120 + t2 * (-1.0 / 5040 + t2 * (1.0 / 362880 + t2 * (-1.0 / 39916800 + t2 * (1.0 / 6227020800.0)))))));
            const double c = 1.0 + t2 * (-0.5 + t2 * (1.0 / 24 + t2 * (-1.0 / 720 + t2 * (1.0 / 40320 + t2 * (-1.0 / 3628800 + t2 * (1.0 / 479001600.0))))));
            const int qi = ((int)q) & 3; double cc, ss;
            if (qi == 0) { cc = c; ss = s; } else if (qi == 1) { cc = -s; ss = c; } else if (qi == 2) { cc = -c; ss = -s; } else { cc = s; ss = -c; }
            TAB[(size_t)m * 32 + i] = (float)cc; TAB[(size_t)m * 32 + 16 + i] = (float)ss; }
    }
    {
        for (int gi = mk_bid() * 512 + tid; gi < 2 * 224 * 128; gi += G * 512) { const int l = gi / (224 * 128), r = gi % (224 * 128);
            *(u32x4*)(p.ws + W_MWIN + (size_t)l * 1280 * 1024 * 2 + (size_t)1056 * 1024 * 2 + (size_t)r * 16) = (u32x4){0u, 0u, 0u, 0u}; }
    }
    __syncthreads();
    {
        LAS float* scr = (LAS float*)(lds + wave * 8448);
        const int gw = mk_bid() * 8 + wave, NGW = G * 8;
        for (int it = gw; it < wt_total(); it += NGW) {
            int r = it;
#pragma unroll
            for (int t = 0; t < 8; ++t) {
                const int ni = wt_items(t) * WT[t].layers;
                if (r >= 0 && r < ni) { const int l = r / wt_items(t), item = r % wt_items(t);
                    transpose_item(p.wsrc[t] + (size_t)l * WT[t].K * WT[t].N, (bf16_t*)(p.ws + WT[t].dst) + (size_t)l * WT[t].drows * WT[t].K, WT[t].K, WT[t].N, WT[t].mode, item, scr, lane); }
                r -= ni;
            }
        }
    }
}

#undef p
__device__ __forceinline__ void norm_phase(const float* src, float* dst, bool do_ln, const float* g, const float* bta, bool do_h, const float* modrow, bf16_t* H) {
    const int tid_ = mk_tid(), lane = tid_ & 63, wave = __builtin_amdgcn_readfirstlane(tid_ >> 6); const int gw = mk_bid() * 8 + wave, NGW = mk_grid() * 8;
    for (int m = gw; m < M_TOK; m += NGW) {
        const int b = m >> 11; const f32x4* xr = (const f32x4*)(src + (size_t)m * 1024) + lane;
        f32x4 v[4];
#pragma unroll
        for (int j = 0; j < 4; ++j) v[j] = xr[64 * j];
        if (do_ln) {
            float s = 0.f;
#pragma unroll
            for (int j = 0; j < 4; ++j) s += (v[j][0] + v[j][1]) + (v[j][2] + v[j][3]);
            const float mean = wave_sum(s) * (1.f / 1024.f); float s2 = 0.f;
#pragma unroll
            for (int j = 0; j < 4; ++j) { v[j] = v[j] - mean; s2 += (v[j][0] * v[j][0] + v[j][1] * v[j][1]) + (v[j][2] * v[j][2] + v[j][3] * v[j][3]); }
            const float rstd = 1.0f / sqrtf(wave_sum(s2) * (1.f / 1024.f) + LN_EPS);
#pragma unroll
            for (int j = 0; j < 4; ++j) { const f32x4 gg = *((const f32x4*)g + lane + 64 * j), bb = *((const f32x4*)bta + lane + 64 * j); v[j] = v[j] * rstd * gg + bb; }
        }
        if (do_ln || src != dst) { f32x4* xo = (f32x4*)(dst + (size_t)m * 1024) + lane;
#pragma unroll
            for (int j = 0; j < 4; ++j) xo[64 * j] = v[j]; }
        if (do_h) { const f32x4* sh = (const f32x4*)(modrow + (size_t)b * 3072) + lane; const f32x4* sc = (const f32x4*)(modrow + (size_t)b * 3072 + 1024) + lane;
            u32x2* ho = (u32x2*)(H + (size_t)m * 1024) + lane;
#pragma unroll
            for (int j = 0; j < 4; ++j) { const f32x4 h = v[j] * (sc[64 * j] + 1.0f) + sh[64 * j]; u32x2 w; w.x = pk2(h[0], h[1]); w.y = pk2(h[2], h[3]); ho[64 * j] = w; } }
    }
}

__device__ __forceinline__ void latnorm_phase(const float* PROJ, const float* qn, const float* kvn, const float* tab, bf16_t* LATQ, bf16_t* LATKV, bf16_t* KR) {
    const int tid_ = mk_tid(), lane = tid_ & 63, wave = __builtin_amdgcn_readfirstlane(tid_ >> 6); const int gw = mk_bid() * 8 + wave, NGW = mk_grid() * 8;
    for (int m = gw; m < M_TOK; m += NGW) {
        const float* pr = PROJ + (size_t)m * 1056;
        f32x4 v[3]; float s = 0.f;
#pragma unroll
        for (int j = 0; j < 3; ++j) { v[j] = *((const f32x4*)pr + lane + 64 * j); s += (v[j][0] * v[j][0] + v[j][1] * v[j][1]) + (v[j][2] * v[j][2] + v[j][3] * v[j][3]); }
        const f32x4 kv = *((const f32x4*)(pr + 768) + lane); const float s2 = (kv[0] * kv[0] + kv[1] * kv[1]) + (kv[2] * kv[2] + kv[3] * kv[3]);
        const float rq = 1.0f / sqrtf(wave_sum(s) * (1.f / 768.f) + RMS_EPS), rkv = 1.0f / sqrtf(wave_sum(s2) * (1.f / 256.f) + RMS_EPS);
#pragma unroll
        for (int j = 0; j < 3; ++j) { const f32x4 gg = *((const f32x4*)qn + lane + 64 * j); const f32x4 o = v[j] * rq * gg; u32x2 w; w.x = pk2(o[0], o[1]); w.y = pk2(o[2], o[3]);
            *((u32x2*)(LATQ + (size_t)m * 768) + lane + 64 * j) = w; }
        { const f32x4 gg = *((const f32x4*)kvn + lane); const f32x4 o = kv * rkv * gg; u32x2 w; w.x = pk2(o[0], o[1]); w.y = pk2(o[2], o[3]); *((u32x2*)(LATKV + (size_t)m * 256) + lane) = w; }
        if (lane < 16) { const float x1 = pr[1024 + lane], x2 = pr[1040 + lane], cs = tab[(size_t)m * 32 + lane], sn = tab[(size_t)m * 32 + 16 + lane];
            const unsigned w = pk2(x1 * cs - x2 * sn, x1 * sn + x2 * cs); KR[(size_t)m * 32 + lane] = (bf16_t)(w & 0xffff); KR[(size_t)m * 32 + 16 + lane] = (bf16_t)(w >> 16); }
    }
}

__device__ __forceinline__ void attn_phase(LAS unsigned char* lds, const bf16_t* Q, const bf16_t* KN, const bf16_t* KR, const bf16_t* VT, bf16_t* O) {
    constexpr int KPB = 208, VPB = 144, KSB = 64 * KPB, VSB = 64 * VPB;
    const int tid = mk_tid(), lane = tid & 63, wave = __builtin_amdgcn_readfirstlane(tid >> 6), q = lane & 31, g = lane >> 5;
    const unsigned kn_dst = (tid >> 3) * KPB + (tid & 7) * 16, kr_dst = (tid >> 2) * KPB + 128 + (tid & 3) * 16, vt_dst = 2 * KSB + (tid >> 3) * VPB + (tid & 7) * 16;
    for (int bh = mk_bid(); bh < 256; bh += mk_grid()) {
        const int b = bh >> 4, h = bh & 15;
        const bf16_t* kn_src = KN + (size_t)(b * 2048 + (tid >> 3)) * 1024 + h * 64 + (tid & 7) * 8;
        const bf16_t* kr_src = KR + (size_t)(b * 2048 + (tid >> 2)) * 32 + (tid & 3) * 8;
        const bf16_t* vt_src = VT + (size_t)(bh * 64 + (tid >> 3)) * 2048 + (tid & 7) * 8;
#pragma unroll 1
        for (int qb = 7; qb >= 0; --qb) {
            __syncthreads();
            const int r0 = qb * 256 + wave * 32, ntile = 4 * (qb + 1);
            bf16x8 qf[6];
            { const bf16_t* qp = Q + (size_t)(b * 2048 + r0 + q) * 1536 + h * 96 + g * 8;
#pragma unroll
              for (int ks = 0; ks < 6; ++ks) qf[ks] = *(const bf16x8*)(qp + ks * 16); }
            f32x16 o0, o1;
#pragma unroll
            for (int i = 0; i < 16; ++i) { o0[i] = 0.f; o1[i] = 0.f; }
            float mrow = -INFINITY, lrow = 0.f;
            u32x4 rk, rr, rv;
            rk = *(const u32x4*)kn_src; rv = *(const u32x4*)vt_src; if (tid < 256) rr = *(const u32x4*)kr_src;
            *(LAS u32x4*)(lds + kn_dst) = rk; *(LAS u32x4*)(lds + vt_dst) = rv; if (tid < 256) *(LAS u32x4*)(lds + kr_dst) = rr;
            __syncthreads();
#pragma unroll 1
            for (int j = 0; j < ntile; ++j) {
                const int cur = j & 1; const bool more = (j + 1 < ntile);
                if (more) { rk = *(const u32x4*)(kn_src + (size_t)(j + 1) * 64 * 1024); rv = *(const u32x4*)(vt_src + (j + 1) * 64); if (tid < 256) rr = *(const u32x4*)(kr_src + (size_t)(j + 1) * 64 * 32); }
                if (64 * j <= r0 + 31) {
                    const LAS unsigned char* kb_ = lds + cur * KSB; const LAS unsigned char* vb_ = lds + 2 * KSB + cur * VSB;
                    f32x16 s0, s1;
#pragma unroll
                    for (int i = 0; i < 16; ++i) { s0[i] = 0.f; s1[i] = 0.f; }
#pragma unroll
                    for (int ks = 0; ks < 6; ++ks) {
                        const bf16x8 a0 = *(const LAS bf16x8*)(kb_ + q * KPB + (ks * 16 + g * 8) * 2), a1 = *(const LAS bf16x8*)(kb_ + (32 + q) * KPB + (ks * 16 + g * 8) * 2);
                        s0 = mfma32(a0, qf[ks], s0); s1 = mfma32(a1, qf[ks], s1); }
                    if (64 * j + 63 > r0) { const int qa = r0 + q, k0 = 64 * j + 4 * g;
#pragma unroll
                        for (int i = 0; i < 16; ++i) { const int key = k0 + (i & 3) + 8 * (i >> 2); if (key > qa) s0[i] = -INFINITY; if (key + 32 > qa) s1[i] = -INFINITY; } }
                    float mx = fmaxf(s0[0], s1[0]);
#pragma unroll
                    for (int i = 1; i < 16; ++i) mx = fmaxf(mx, fmaxf(s0[i], s1[i]));
                    mx = fmaxf(mx, __shfl_xor(mx, 32));
                    const float mnew = fmaxf(mrow, mx), alpha = __builtin_amdgcn_exp2f(mrow - mnew); mrow = mnew;
                    float sum = 0.f;
#pragma unroll
                    for (int i = 0; i < 16; ++i) { s0[i] = __builtin_amdgcn_exp2f(s0[i] - mnew); s1[i] = __builtin_amdgcn_exp2f(s1[i] - mnew); sum += s0[i] + s1[i]; }
                    lrow = lrow * alpha + sum;
#pragma unroll
                    for (int i = 0; i < 16; ++i) { o0[i] *= alpha; o1[i] *= alpha; }
#pragma unroll
                    for (int kb = 0; kb < 2; ++kb)
#pragma unroll
                        for (int t2 = 0; t2 < 2; ++t2) {
                            u32x4 pw;
                            if (kb == 0) { pw.x = pk2(s0[8 * t2 + 0], s0[8 * t2 + 1]); pw.y = pk2(s0[8 * t2 + 2], s0[8 * t2 + 3]); pw.z = pk2(s0[8 * t2 + 4], s0[8 * t2 + 5]); pw.w = pk2(s0[8 * t2 + 6], s0[8 * t2 + 7]); }
                            else         { pw.x = pk2(s1[8 * t2 + 0], s1[8 * t2 + 1]); pw.y = pk2(s1[8 * t2 + 2], s1[8 * t2 + 3]); pw.z = pk2(s1[8 * t2 + 4], s1[8 * t2 + 5]); pw.w = pk2(s1[8 * t2 + 6], s1[8 * t2 + 7]); }
                            const bf16x8 pb = __builtin_bit_cast(bf16x8, pw);
                            const int ko = (32 * kb + 16 * t2 + 4 * g) * 2;
                            { const u32x2 lo = *(const LAS u32x2*)(vb_ + q * VPB + ko), hi = *(const LAS u32x2*)(vb_ + q * VPB + ko + 16);
                              const u32x4 av = (u32x4){lo.x, lo.y, hi.x, hi.y}; o0 = mfma32(__builtin_bit_cast(bf16x8, av), pb, o0); }
                            { const u32x2 lo = *(const LAS u32x2*)(vb_ + (32 + q) * VPB + ko), hi = *(const LAS u32x2*)(vb_ + (32 + q) * VPB + ko + 16);
                              const u32x4 av = (u32x4){lo.x, lo.y, hi.x, hi.y}; o1 = mfma32(__builtin_bit_cast(bf16x8, av), pb, o1); }
                        }
                }
                if (more) { const unsigned bo = (cur ^ 1) * KSB, vo = (cur ^ 1) * VSB;
                    *(LAS u32x4*)(lds + bo + kn_dst) = rk; *(LAS u32x4*)(lds + vo + vt_dst) = rv; if (tid < 256) *(LAS u32x4*)(lds + bo + kr_dst) = rr; }
                __syncthreads();
            }
            const float lt = lrow + __shfl_xor(lrow, 32), inv = 1.0f / lt;
            bf16_t* op = O + (size_t)(b * 2048 + r0 + q) * 1024 + h * 64 + 4 * g;
#pragma unroll
            for (int qd = 0; qd < 4; ++qd) {
                u32x2 w0, w1; w0.x = pk2(o0[4 * qd] * inv, o0[4 * qd + 1] * inv); w0.y = pk2(o0[4 * qd + 2] * inv, o0[4 * qd + 3] * inv);
                w1.x = pk2(o1[4 * qd] * inv, o1[4 * qd + 1] * inv); w1.y = pk2(o1[4 * qd + 2] * inv, o1[4 * qd + 3] * inv);
                *(u32x2*)(op + 8 * qd) = w0; *(u32x2*)(op + 32 + 8 * qd) = w1; }
        }
    }
}

__device__ __forceinline__ void hgrn_phase(LAS unsigned char* lds, const bf16_t* QS, const float* LOGF, const bf16_t* VV, const bf16_t* GS, const float* gn, bf16_t* OG) {
    constexpr int QP = 0, KPN = 8704, KPT = 17408, VTT = 27648, SST = 37888, OPART = 72704, GSUM = 106496, ELAST = 108544;
    const int tid = mk_tid(), lane = tid & 63, wave = __builtin_amdgcn_readfirstlane(tid >> 6), q = lane & 31, g = lane >> 5;
    const int ch = tid & 127, tg = tid >> 7, vb = wave & 3, kh = wave >> 2;
    const int dt = tid >> 4, dpart = tid & 15;
    for (int bh = mk_bid(); bh < 128; bh += mk_grid()) {
        const int b = bh >> 3, hh = bh & 7;
        __syncthreads();
        f32x16 st0, st1;
#pragma unroll
        for (int i = 0; i < 16; ++i) { st0[i] = 0.f; st1[i] = 0.f; }
        const size_t ebase = (size_t)(b * 2048 + 8 * tg) * 1024 + hh * 128 + ch;
        const size_t dbase = (size_t)(b * 2048 + dt) * 1024 + hh * 128 + 8 * dpart;
        f32x4 gn0 = *(const f32x4*)(gn + 8 * dpart), gn1 = *(const f32x4*)(gn + 8 * dpart + 4);
        float lf[8]; unsigned short qs[8], vv[8];
#pragma unroll
        for (int i = 0; i < 8; ++i) { lf[i] = LOGF[ebase + (size_t)i * 1024]; qs[i] = QS[ebase + (size_t)i * 1024]; vv[i] = VV[ebase + (size_t)i * 1024]; }
#pragma unroll 1
        for (int c = 0; c < 64; ++c) {
            float cs[8]; cs[0] = lf[0];
#pragma unroll
            for (int i = 1; i < 8; ++i) cs[i] = cs[i - 1] + lf[i];
            *(LAS float*)(lds + GSUM + (tg * 128 + ch) * 4) = cs[7];
            __syncthreads();
            float off = 0.f, tot = 0.f;
#pragma unroll
            for (int t = 0; t < 4; ++t) { const float gs_ = *(const LAS float*)(lds + GSUM + (t * 128 + ch) * 4); if (t < tg) off += gs_; tot += gs_; }
            {
                unsigned kt[4], vt[4];
#pragma unroll
                for (int i = 0; i < 8; i += 2) {
                    const float b0 = off + cs[i], b1 = off + cs[i + 1];
                    const float q0 = bf2f(qs[i]) * __expf(b0), q1 = bf2f(qs[i + 1]) * __expf(b1);
                    const float k0 = (1.f - __expf(lf[i])) * __expf(-b0), k1 = (1.f - __expf(lf[i + 1])) * __expf(-b1);
                    const unsigned qw = pk2(q0, q1), kw = pk2(k0, k1);
                    *(LAS unsigned short*)(lds + QP + (8 * tg + i) * 272 + ch * 2) = (unsigned short)(qw & 0xffff);
                    *(LAS unsigned short*)(lds + QP + (8 * tg + i + 1) * 272 + ch * 2) = (unsigned short)(qw >> 16);
                    *(LAS unsigned short*)(lds + KPN + (8 * tg + i) * 272 + ch * 2) = (unsigned short)(kw & 0xffff);
                    *(LAS unsigned short*)(lds + KPN + (8 * tg + i + 1) * 272 + ch * 2) = (unsigned short)(kw >> 16);
                    kt[i >> 1] = kw; vt[i >> 1] = (unsigned)vv[i] | ((unsigned)vv[i + 1] << 16);
                }
                *(LAS u32x4*)(lds + KPT + ch * 80 + tg * 16) = (u32x4){kt[0], kt[1], kt[2], kt[3]};
                *(LAS u32x4*)(lds + VTT + ch * 80 + tg * 16) = (u32x4){vt[0], vt[1], vt[2], vt[3]};
                if (tg == 3) *(LAS float*)(lds + ELAST + ch * 4) = __expf(tot);
            }
#pragma unroll
            for (int qd = 0; qd < 4; ++qd) {
                u32x2 w0, w1; w0.x = pk2(st0[4 * qd], st0[4 * qd + 1]); w0.y = pk2(st0[4 * qd + 2], st0[4 * qd + 3]); w1.x = pk2(st1[4 * qd], st1[4 * qd + 1]); w1.y = pk2(st1[4 * qd + 2], st1[4 * qd + 3]);
                *(LAS u32x2*)(lds + SST + (32 * vb + q) * 272 + (32 * (2 * kh) + 8 * qd + 4 * g) * 2) = w0;
                *(LAS u32x2*)(lds + SST + (32 * vb + q) * 272 + (32 * (2 * kh + 1) + 8 * qd + 4 * g) * 2) = w1; }
            __syncthreads();
            if (c + 1 < 64) { const size_t e2 = ebase + (size_t)(c + 1) * 32 * 1024;
#pragma unroll
                for (int i = 0; i < 8; ++i) { lf[i] = LOGF[e2 + (size_t)i * 1024]; qs[i] = QS[e2 + (size_t)i * 1024]; vv[i] = VV[e2 + (size_t)i * 1024]; } }
            const u32x4 gsv = *(const u32x4*)(GS + dbase + (size_t)c * 32 * 1024);
            {
                f32x16 oT;
#pragma unroll
                for (int i = 0; i < 16; ++i) oT[i] = 0.f;
#pragma unroll
                for (int ks = 0; ks < 4; ++ks) { const int k0 = (64 * kh + 16 * ks + 8 * g) * 2;
                    oT = mfma32(*(const LAS bf16x8*)(lds + SST + (32 * vb + q) * 272 + k0), *(const LAS bf16x8*)(lds + QP + q * 272 + k0), oT); }
                if (kh == 0) {
                    f32x16 aT;
#pragma unroll
                    for (int i = 0; i < 16; ++i) aT[i] = 0.f;
#pragma unroll
                    for (int ks = 0; ks < 8; ++ks) { const int k0 = (16 * ks + 8 * g) * 2;
                        aT = mfma32(*(const LAS bf16x8*)(lds + KPN + q * 272 + k0), *(const LAS bf16x8*)(lds + QP + q * 272 + k0), aT); }
#pragma unroll
                    for (int i = 0; i < 16; ++i) { const int s = (i & 3) + 8 * (i >> 2) + 4 * g; if (s > q) aT[i] = 0.f; }
#pragma unroll
                    for (int t2 = 0; t2 < 2; ++t2) {
                        u32x4 pw; pw.x = pk2(aT[8 * t2 + 0], aT[8 * t2 + 1]); pw.y = pk2(aT[8 * t2 + 2], aT[8 * t2 + 3]); pw.z = pk2(aT[8 * t2 + 4], aT[8 * t2 + 5]); pw.w = pk2(aT[8 * t2 + 6], aT[8 * t2 + 7]);
                        const int so = (16 * t2 + 4 * g) * 2;
                        const u32x2 lo = *(const LAS u32x2*)(lds + VTT + (32 * vb + q) * 80 + so), hi = *(const LAS u32x2*)(lds + VTT + (32 * vb + q) * 80 + so + 16);
                        const u32x4 av = (u32x4){lo.x, lo.y, hi.x, hi.y};
                        oT = mfma32(__builtin_bit_cast(bf16x8, av), __builtin_bit_cast(bf16x8, pw), oT); }
                }
#pragma unroll
                for (int qd = 0; qd < 4; ++qd) *(LAS f32x4*)(lds + OPART + kh * 16896 + q * 528 + (32 * vb + 8 * qd + 4 * g) * 4) = (f32x4){oT[4 * qd], oT[4 * qd + 1], oT[4 * qd + 2], oT[4 * qd + 3]};
            }
#pragma unroll
            for (int t2 = 0; t2 < 2; ++t2) { const int so = (16 * t2 + 8 * g) * 2; const bf16x8 bv = *(const LAS bf16x8*)(lds + VTT + (32 * vb + q) * 80 + so);
                st0 = mfma32(*(const LAS bf16x8*)(lds + KPT + (32 * (2 * kh) + q) * 80 + so), bv, st0);
                st1 = mfma32(*(const LAS bf16x8*)(lds + KPT + (32 * (2 * kh + 1) + q) * 80 + so), bv, st1); }
#pragma unroll
            for (int qd = 0; qd < 4; ++qd) { const f32x4 e0 = *(const LAS f32x4*)(lds + ELAST + (32 * (2 * kh) + 8 * qd + 4 * g) * 4), e1 = *(const LAS f32x4*)(lds + ELAST + (32 * (2 * kh + 1) + 8 * qd + 4 * g) * 4);
#pragma unroll
                for (int e = 0; e < 4; ++e) { st0[4 * qd + e] *= e0[e]; st1[4 * qd + e] *= e1[e]; } }
            __syncthreads();
            {
                const LAS float* o0p = (const LAS float*)(lds + OPART + dt * 528 + dpart * 32); const LAS float* o1p = (const LAS float*)(lds + OPART + 16896 + dt * 528 + dpart * 32);
                const f32x4 a0 = *(const LAS f32x4*)o0p + *(const LAS f32x4*)o1p, a1 = *(const LAS f32x4*)(o0p + 4) + *(const LAS f32x4*)(o1p + 4);
                float ss = (a0[0] * a0[0] + a0[1] * a0[1]) + (a0[2] * a0[2] + a0[3] * a0[3]) + (a1[0] * a1[0] + a1[1] * a1[1]) + (a1[2] * a1[2] + a1[3] * a1[3]);
                ss += __shfl_xor(ss, 1); ss += __shfl_xor(ss, 2); ss += __shfl_xor(ss, 4); ss += __shfl_xor(ss, 8);
                const float rstd = 1.0f / sqrtf(ss * (1.f / 128.f) + RMS_EPS);
                const f32x4 r0 = a0 * rstd * gn0, r1 = a1 * rstd * gn1;
                u32x4 w;
                w.x = pk2(r0[0] * bf2f((unsigned short)(gsv.x & 0xffff)), r0[1] * bf2f((unsigned short)(gsv.x >> 16)));
                w.y = pk2(r0[2] * bf2f((unsigned short)(gsv.y & 0xffff)), r0[3] * bf2f((unsigned short)(gsv.y >> 16)));
                w.z = pk2(r1[0] * bf2f((unsigned short)(gsv.z & 0xffff)), r1[1] * bf2f((unsigned short)(gsv.z >> 16)));
                w.w = pk2(r1[2] * bf2f((unsigned short)(gsv.w & 0xffff)), r1[3] * bf2f((unsigned short)(gsv.w >> 16)));
                *(u32x4*)(OG + dbase + (size_t)c * 32 * 1024) = w;
            }
        }
    }
}

constexpr int N_PHASES = 34;
template <class Epi>
__device__ __forceinline__ void run_gemm(LAS unsigned char* lds, const bf16_t* A, const bf16_t* Bt, int N, int K, const Epi& E) {
    asm volatile("" : "+s"(K), "+s"(N));
    pg8::Gemm g{A, Bt, M_TOK, N, K}; pg8::StaticOrder S; S.init(M_TOK, N, mk_grid(), mk_bid());
    pg8::gemm_phase<Epi, pg8::StaticOrder, true, true>((PG8_LAS unsigned char*)lds, g, S, E);
}

template <class Epi>
__device__ __forceinline__ void run_gemm_t(LAS unsigned char* lds, const bf16_t* A, const bf16_t* Bt, int K, const Epi& E) {
    asm volatile("" : "+s"(K));
    pg8::Gemm g{A, Bt, 1024, M_TOK, K}; pg8::StaticOrder S; S.init(1024, M_TOK, mk_grid(), mk_bid());
    pg8::gemm_phase<Epi, pg8::StaticOrder, true, true>((PG8_LAS unsigned char*)lds, g, S, E);
}

__global__ void __launch_bounds__(512, 2) fwd_megakernel(Params p) {
    extern __shared__ __attribute__((aligned(16))) unsigned char lds_raw[];
    LAS unsigned char* lds = (LAS unsigned char*)lds_raw;
    cg::grid_group grid = cg::this_grid();
    const int ph_lo = p.ph_lo, ph_hi = p.ph_hi;
    if (mk_tid() < 16) ((volatile LAS unsigned*)(lds + 131072))[mk_tid()] = 0u;
    __syncthreads();
    const XcdBarrier bar = xcd_barrier_post((unsigned*)(p.ws + WS_BAR), (volatile LAS unsigned*)(lds + 131072));
#pragma unroll 1
    for (int ph = ph_lo; ph < ph_hi; ++ph) {
        unsigned long long kptr = (unsigned long long)__builtin_amdgcn_kernarg_segment_ptr(); asm volatile("" : "+s"(kptr));
        const ParamsPtr pp = (ParamsPtr)kptr;
#define p (*pp)
        unsigned char* ws = p.ws;
        float* MOD = (float*)(ws + WS_MOD); const float* TAB = (const float*)(ws + WS_TAB); const float* LB = (const float*)(ws + WS_LB);
        bf16_t* H = (bf16_t*)(ws + WS_H);
        int kind, layer = 0;
        if (ph == 0) kind = 0; else if (ph == 1) kind = 1;
        else { const int qq = ph - 2, pair = qq >> 4, r = qq & 15;
            if (r < 9) { layer = 2 * pair; kind = (r < 6) ? 2 + r : 8 + (r - 6); if (r == 5) kind = 7; }
            else { layer = 2 * pair + 1; const int r2 = r - 9; kind = (r2 == 0) ? 11 : (r2 == 1) ? 12 : (r2 == 2) ? 6 : (r2 == 3) ? 7 : 8 + (r2 - 4); } }
        const int j = layer >> 1;
        switch (kind) {
        case 0: prologue_phase(pp, lds); break;
        case 1: norm_phase(p.x, p.X, false, nullptr, nullptr, true, MOD, H); break;
        case 2: { EpiProj E{(float*)(ws + R_PROJ), 1056, 1056}; run_gemm(lds, H, (const bf16_t*)(ws + W_MWIN) + (size_t)j * 1280 * 1024, 1280, 1024, E); } break;
        case 3: latnorm_phase((const float*)(ws + R_PROJ), p.mla_qn + j * 768, p.mla_kvn + j * 256, TAB, (bf16_t*)(ws + R_LATQ), (bf16_t*)(ws + R_LATKV), (bf16_t*)(ws + R_KR)); break;
        case 4: { EpiQ Eq{(bf16_t*)(ws + R_Q), TAB}; run_gemm(lds, (const bf16_t*)(ws + R_LATQ), (const bf16_t*)(ws + W_MWQB) + (size_t)j * 1536 * 768, 1536, 768, Eq);
                  const bf16_t* Wkv = (const bf16_t*)(ws + W_MWKVB) + (size_t)j * 2048 * 256;
                  EpiBf16 Ek{(bf16_t*)(ws + R_KN), 1024}; run_gemm(lds, (const bf16_t*)(ws + R_LATKV), Wkv, 1024, 256, Ek);
                  EpiVT Ev{(bf16_t*)(ws + R_VT)}; run_gemm_t(lds, Wkv + (size_t)1024 * 256, (const bf16_t*)(ws + R_LATKV), 256, Ev); } break;
        case 5:
#if defined(PROBE_DUP_ATTN)
            attn_phase(lds, (const bf16_t*)(ws + R_Q), (const bf16_t*)(ws + R_KN), (const bf16_t*)(ws + R_KR), (const bf16_t*)(ws + R_VT), (bf16_t*)(ws + R_O));
#endif
            attn_phase(lds, (const bf16_t*)(ws + R_Q), (const bf16_t*)(ws + R_KN), (const bf16_t*)(ws + R_KR), (const bf16_t*)(ws + R_VT), (bf16_t*)(ws + R_O)); break;
        case 6: { const bool mla = (layer & 1) == 0; EpiResid E{p.X, MOD + (size_t)(2 * layer) * 16 * 3072};
                  const bf16_t* A = mla ? (const bf16_t*)(ws + R_O) : (const bf16_t*)H;
                  const bf16_t* Bt = mla ? (const bf16_t*)(ws + W_MWO) + (size_t)j * 1024 * 1024 : (const bf16_t*)(ws + W_HWO) + (size_t)j * 1024 * 1024;
                  run_gemm(lds, A, Bt, 1024, 1024, E); } break;
        case 7: norm_phase(p.X, p.X, true, p.ln_g + (size_t)(2 * layer) * 1024, p.ln_b + (size_t)(2 * layer) * 1024, true, MOD + (size_t)(2 * layer + 1) * 16 * 3072, H); break;
        case 8: { EpiSwiGLU E{(bf16_t*)(ws + R_T)}; run_gemm(lds, H, (const bf16_t*)(ws + W_FWIN) + (size_t)layer * 5632 * 1024, 5632, 1024, E); } break;
        case 9: { EpiResid E{p.X, MOD + (size_t)(2 * layer + 1) * 16 * 3072}; run_gemm(lds, (const bf16_t*)(ws + R_T), (const bf16_t*)(ws + W_FWOUT) + (size_t)layer * 1024 * FF, 1024, FF, E); } break;
        case 10: norm_phase(p.X, p.X, true, p.ln_g + (size_t)(2 * layer + 1) * 1024, p.ln_b + (size_t)(2 * layer + 1) * 1024, layer < 3, MOD + (size_t)(2 * layer + 2) * 16 * 3072, H); break;
        case 11: { EpiHgrnIn E{(bf16_t*)(ws + R_QS), (float*)(ws + R_LOGF), LB + j * 1024};
                   run_gemm(lds, H, (const bf16_t*)(ws + W_HWIN) + (size_t)j * 4096 * 1024, 4096, 1024, E); } break;
        case 12:
#if defined(PROBE_DUP_REC)
            hgrn_phase(lds, (const bf16_t*)(ws + R_QS), (const float*)(ws + R_LOGF), (const bf16_t*)(ws + R_VV), (const bf16_t*)(ws + R_GS), p.hgrn_gn + j * 128, H);
#endif
            hgrn_phase(lds, (const bf16_t*)(ws + R_QS), (const float*)(ws + R_LOGF), (const bf16_t*)(ws + R_VV), (const bf16_t*)(ws + R_GS), p.hgrn_gn + j * 128, H); break;
        default: break;
        }
        if (ph + 1 < ph_hi) { if (ph == ph_lo) grid.sync(); else xcd_barrier(bar); }
#if defined(PROBE_DUP_SYNC)
        if (ph + 1 < ph_hi) { xcd_barrier(bar); xcd_barrier(bar); xcd_barrier(bar); xcd_barrier(bar); }
#endif
#undef p
    }
}

#ifndef MK_MULTI
#define MK_MULTI 0
#endif
extern "C" void kernel_launch(void* const* d_in, const int* in_sizes, int n_in, void* d_out, int out_size, void* d_ws, size_t ws_size, hipStream_t stream) {
    static int grid = 0;
    if (grid == 0) {
        if (n_in != 19 || out_size != M_TOK * DM || ws_size < WS_END) { fprintf(stderr, "kernel_launch: unexpected sizes: n_in %d out %d ws %zu (need %zu)\n", n_in, out_size, ws_size, (size_t)WS_END); grid = -1; return; }
        int dev = 0, cus = 0, per_cu = 0;
        hipGetDevice(&dev); hipDeviceGetAttribute(&cus, hipDeviceAttributeMultiprocessorCount, dev);
        if (hipFuncSetAttribute((const void*)fwd_megakernel, hipFuncAttributeMaxDynamicSharedMemorySize, LDS_BYTES) != hipSuccess) { fprintf(stderr, "kernel_launch: hipFuncSetAttribute failed\n"); grid = -1; return; }
        hipOccupancyMaxActiveBlocksPerMultiprocessor(&per_cu, (const void*)fwd_megakernel, 512, LDS_BYTES);
        (void)hipGetLastError();
        if (per_cu < 1) per_cu = 1;
        grid = cus * 1;
        fprintf(stderr, "kernel_launch: cus %d per_cu %d grid %d\n", cus, per_cu, grid);
    }
    if (grid < 0) return;
    if (hipMemsetAsync((char*)d_ws + WS_BAR, 0, XCD_BAR_WORDS * 4, stream) != hipSuccess) { fprintf(stderr, "kernel_launch: memset failed\n"); return; }
    Params p{};
    p.x = (const float*)d_in[0]; p.c = (const float*)d_in[1]; p.pos = (const int*)d_in[2];
    p.mla_qn = (const float*)d_in[4]; p.mla_kvn = (const float*)d_in[6]; p.hgrn_lb = (const float*)d_in[9]; p.hgrn_gn = (const float*)d_in[11];
    p.ada_w = (const float*)d_in[15]; p.ada_b = (const float*)d_in[16]; p.ln_g = (const float*)d_in[17]; p.ln_b = (const float*)d_in[18];
    p.X = (float*)d_out; p.ws = (unsigned char*)d_ws;
    p.wsrc[0] = (const float*)d_in[3]; p.wsrc[1] = (const float*)d_in[5]; p.wsrc[2] = (const float*)d_in[7]; p.wsrc[3] = (const float*)d_in[8];
    p.wsrc[4] = (const float*)d_in[10]; p.wsrc[5] = (const float*)d_in[12]; p.wsrc[6] = (const float*)d_in[13]; p.wsrc[7] = (const float*)d_in[14];
    for (int i = 0; i < 16; ++i) p.invf[i] = (float)pow(10000.0, -(double)i / 16.0);
#if MK_MULTI
    for (int ph = 0; ph < N_PHASES; ++ph) { p.ph_lo = ph; p.ph_hi = ph + 1; hipLaunchKernelGGL(fwd_megakernel, dim3(grid), dim3(512), LDS_BYTES, stream, p); }
#else
    p.ph_lo = 0; p.ph_hi = N_PHASES;
    void* args[] = {&p};
    hipError_t e = hipLaunchCooperativeKernel((const void*)fwd_megakernel, dim3(grid), dim3(512), args, LDS_BYTES, stream);
    if (e != hipSuccess) fprintf(stderr, "cooperative launch failed: %s (grid %d)\n", hipGetErrorString(e), grid);
#endif
}
```

```cpp
#include <hip/hip_runtime.h>
#include <hip/hip_cooperative_groups.h>
#include <cstdio>
#include <cstdint>
#include <cmath>
namespace cg = cooperative_groups;

__device__ __forceinline__ int mk_tid() { int t = (int)threadIdx.x; asm volatile("" : "+v"(t)); return t; }
__device__ __forceinline__ int mk_bid() { int t = (int)blockIdx.x; asm volatile("" : "+s"(t)); return t; }
__device__ __forceinline__ int mk_grid() { int t = (int)gridDim.x; asm volatile("" : "+s"(t)); return t; }
namespace pg8 {
#define PG8_LAS __attribute__((address_space(3)))
typedef unsigned short bf16_t;
typedef short bf16x8 __attribute__((ext_vector_type(8)));
typedef float f32x4 __attribute__((ext_vector_type(4)));
typedef unsigned u32x4 __attribute__((ext_vector_type(4)));
constexpr int BM = 256, BK = 64, HALF = 128, HTB = HALF * BK * 2  , STAGE_BYTES = 8 * HTB, NXCD = 8, WGM = 8;

__host__ __device__ __forceinline__ int lds_byte(int r, int c) { const int st = (r >> 4) * 2 + (c >> 5), rr = r & 15, cc = c & 31, ob = rr * 64 + cc * 2; return st * 1024 + (ob ^ (((ob >> 9) & 1) << 5)); }
__host__ __device__ __forceinline__ void stage_rc(int b, int& R, int& C) { const int st = b / 1024, sb = b % 1024, swz = sb ^ (((sb >> 9) & 1) << 5); R = (st >> 1) * 16 + swz / 64; C = (st & 1) * 32 + (swz % 64) / 2; }
__host__ __device__ __forceinline__ int perm32(int rho) { const int n = rho >> 4, i = rho & 15; return 8 * (i >> 2) + 4 * n + (i & 3); }

struct Unit { int pm, pn; };
struct Gemm { const bf16_t* A; const bf16_t* Bt; int M, N, K; };

struct StaticOrder {
    int nM, nN, nwg, G, c;
    __host__ __device__ void init(int M, int N, int G_, int c_) { nM = M / BM; nN = N / BM; nwg = nM * nN; G = G_; c = c_; }
    __host__ __device__ bool next(int i, Unit& u) const {
        const long L = (long)i * G + c; if (L >= nwg) return false;
        int wgid = (int)L; { const int q = nwg / NXCD, r = nwg % NXCD, xcd = wgid % NXCD, off = wgid / NXCD; wgid = (xcd < r ? xcd * (q + 1) : r * (q + 1) + (xcd - r) * q) + off; }
        const int nig = WGM * nN, gid = wgid / nig, fm = gid * WGM, gsz = (nM - fm) < WGM ? (nM - fm) : WGM;
        u.pm = fm + ((wgid % nig) % gsz); u.pn = (wgid % nig) / gsz; return true;
    }
    __device__ __forceinline__ void a_ready(const Unit&) const {}
    __device__ __forceinline__ void done(const Unit&) const {}
};

__device__ __forceinline__ unsigned cvt_pk_bf16(float lo, float hi) { unsigned r; asm volatile("v_cvt_pk_bf16_f32 %0, %1, %2" : "=v"(r) : "v"(lo), "v"(hi)); return r; }
template <class Epi, class Sched, bool ALIGN_EPI = false, bool SP2 = false>
__device__ __forceinline__ void gemm_phase(PG8_LAS unsigned char* lds, const Gemm g, const Sched& S, const Epi& E) {
    const int tid = mk_tid(), wid = __builtin_amdgcn_readfirstlane(tid >> 6), lane = tid & 63, wr = wid >> 2, wc = wid & 3, fr = lane & 15, fq = lane >> 4;
    const int K = g.K, nt = K / BK;
    unsigned voffA[2], voffB[2];
#pragma unroll
    for (int i = 0; i < 2; ++i) { int R, C; stage_rc(tid * 16 + i * 8192, R, C); const int Rb = Epi::PERM ? ((R & ~31) + perm32(R & 31)) : R;
        voffA[i] = (unsigned)(R * K + C) * 2u; voffB[i] = (unsigned)(Rb * K + C) * 2u; }
    const size_t kstep = (size_t)(BK * 2);
    const size_t hstep = (size_t)HALF * K * 2;
    const size_t tstep = 2 * hstep;
    const unsigned ldsw = (unsigned)wid * 1024u;
    const int aoff = lds_byte(wr * 64 + fr, fq * 8), boff = lds_byte(wc * 32 + fr, fq * 8);
#define PG8_SA(b, h) (((b) * 2 + (h)) * HTB)
#define PG8_SB(b, h) ((4 + (b) * 2 + (h)) * HTB)
#define PG8_STAGE(bufoff, gbase, voff) do { _Pragma("unroll") for (int _i = 0; _i < 2; ++_i) \
        __builtin_amdgcn_global_load_lds((const unsigned*)((const char*)(gbase) + (voff)[_i]), (PG8_LAS unsigned*)(lds + (bufoff) + ldsw + _i * 8192), 16, 0, 0); } while (0)
#define PG8_LDA(dst, b, h) do { _Pragma("unroll") for (int m = 0; m < 4; ++m) _Pragma("unroll") for (int k = 0; k < 2; ++k) dst[m][k] = *(const PG8_LAS bf16x8*)(lds + PG8_SA(b, h) + aoff + m * 2048 + k * 1024); } while (0)
#define PG8_LDB(dst, b, h) do { _Pragma("unroll") for (int n = 0; n < 2; ++n) _Pragma("unroll") for (int k = 0; k < 2; ++k) dst[n][k] = *(const PG8_LAS bf16x8*)(lds + PG8_SB(b, h) + boff + n * 2048 + k * 1024); } while (0)
#define PG8_MMA(ai, bj, At, Bt) do { __builtin_amdgcn_s_setprio(1); _Pragma("unroll") for (int m = 0; m < 4; ++m) _Pragma("unroll") for (int n = 0; n < 2; ++n) _Pragma("unroll") for (int k = 0; k < 2; ++k) \
        acc[ai][bj][m][n] = __builtin_amdgcn_mfma_f32_16x16x32_bf16(Bt[n][k], At[m][k], acc[ai][bj][m][n], 0, 0, 0); __builtin_amdgcn_s_setprio(0); } while (0)
#define PG8_WAIT_V(n) asm volatile("s_waitcnt vmcnt(" #n ")" ::: "memory")
#define PG8_WAIT_L(n) asm volatile("s_waitcnt lgkmcnt(" #n ")" ::: "memory")
#define PG8_BAR __builtin_amdgcn_s_barrier()
#define PG8_SCHED __builtin_amdgcn_sched_barrier(0)
    Unit cur, nxt; int ui = 0;
    if (!S.next(0, cur)) return;
    f32x4 acc[2][2][4][2];
#pragma unroll
    for (int a = 0; a < 2; ++a)
#pragma unroll
        for (int b = 0; b < 2; ++b)
#pragma unroll
            for (int m = 0; m < 4; ++m)
#pragma unroll
                for (int n = 0; n < 2; ++n) acc[a][b][m][n] = (f32x4){0.f, 0.f, 0.f, 0.f};
    bf16x8 At[4][2], B0[2][2], B1[2][2];
    const char* cA = (const char*)g.A + (size_t)cur.pm * tstep; const char* cB = (const char*)g.Bt + (size_t)cur.pn * tstep;
    S.a_ready(cur);
    if constexpr (SP2) {
        PG8_STAGE(PG8_SB(0, 0), cB, voffB); PG8_STAGE(PG8_SB(0, 1), cB + hstep, voffB); PG8_STAGE(PG8_SA(0, 0), cA, voffA); PG8_STAGE(PG8_SA(0, 1), cA + hstep, voffA);
        if (wr == 1) PG8_BAR;
        PG8_WAIT_V(2); PG8_BAR;
        PG8_STAGE(PG8_SB(1, 0), cB + kstep, voffB); PG8_STAGE(PG8_SA(1, 0), cA + kstep, voffA); PG8_STAGE(PG8_SB(1, 1), cB + hstep + kstep, voffB);
        PG8_WAIT_V(6); PG8_BAR;
    } else {
        PG8_STAGE(PG8_SB(0, 0), cB, voffB); PG8_STAGE(PG8_SA(0, 0), cA, voffA); PG8_STAGE(PG8_SB(0, 1), cB + hstep, voffB); PG8_STAGE(PG8_SA(0, 1), cA + hstep, voffA);
        if (wr == 1) PG8_BAR;
        PG8_WAIT_V(4); PG8_BAR;
        PG8_STAGE(PG8_SB(1, 0), cB + kstep, voffB); PG8_STAGE(PG8_SA(1, 0), cA + kstep, voffA); PG8_STAGE(PG8_SB(1, 1), cB + hstep + kstep, voffB);
        PG8_WAIT_V(6); PG8_BAR;
    }
    for (;;) {
        const bool has_next = S.next(ui + 1, nxt);
        const char* nA = has_next ? (const char*)g.A + (size_t)nxt.pm * tstep : cA; const char* nB = has_next ? (const char*)g.Bt + (size_t)nxt.pn * tstep : cB;
        for (int t = 0; t < nt; t += 2) {
            const bool last = (t == nt - 2);
            const char* a1 = cA + (size_t)(t + 1) * kstep;
            const char* a2 = last ? nA : cA + (size_t)(t + 2) * kstep; const char* b2 = last ? nB : cB + (size_t)(t + 2) * kstep;
            const char* a3 = a2 + kstep; const char* b3 = b2 + kstep;
            if (last && has_next) S.a_ready(nxt);
            if constexpr (SP2) {
            PG8_LDB(B0, 0, 0); PG8_LDB(B1, 0, 1); PG8_SCHED; PG8_LDA(At, 0, 0); PG8_STAGE(PG8_SA(1, 1), a1 + hstep, voffA);
            PG8_WAIT_V(8); PG8_WAIT_L(0); PG8_BAR; PG8_MMA(0, 0, At, B0); PG8_MMA(0, 1, At, B1); PG8_BAR; PG8_SCHED;
            PG8_LDA(At, 0, 1); PG8_STAGE(PG8_SB(0, 0), b2, voffB); PG8_STAGE(PG8_SB(0, 1), b2 + hstep, voffB); PG8_STAGE(PG8_SA(0, 0), a2, voffA);
            PG8_WAIT_V(8); PG8_WAIT_L(0); PG8_BAR; PG8_MMA(1, 0, At, B0); PG8_MMA(1, 1, At, B1); PG8_BAR; PG8_SCHED;
            PG8_LDB(B0, 1, 0); PG8_LDB(B1, 1, 1); PG8_SCHED; PG8_LDA(At, 1, 0); PG8_STAGE(PG8_SA(0, 1), a2 + hstep, voffA);
            PG8_WAIT_V(8); PG8_WAIT_L(0); PG8_BAR; PG8_MMA(0, 0, At, B0); PG8_MMA(0, 1, At, B1); PG8_BAR; PG8_SCHED;
            PG8_LDA(At, 1, 1); PG8_STAGE(PG8_SB(1, 0), b3, voffB); PG8_STAGE(PG8_SB(1, 1), b3 + hstep, voffB); PG8_STAGE(PG8_SA(1, 0), a3, voffA);
            PG8_WAIT_V(8); PG8_WAIT_L(0); PG8_BAR; PG8_MMA(1, 0, At, B0); PG8_MMA(1, 1, At, B1); PG8_BAR; PG8_SCHED;
            } else {
            PG8_LDB(B0, 0, 0); PG8_SCHED; PG8_LDA(At, 0, 0); PG8_STAGE(PG8_SA(1, 1), a1 + hstep, voffA);
            PG8_WAIT_L(8); PG8_BAR; PG8_WAIT_L(0); PG8_MMA(0, 0, At, B0); PG8_BAR; PG8_SCHED;
            PG8_LDB(B1, 0, 1); PG8_STAGE(PG8_SB(0, 0), b2, voffB);
            PG8_BAR; PG8_WAIT_L(0); PG8_MMA(0, 1, At, B1); PG8_BAR;
            PG8_LDA(At, 0, 1); PG8_STAGE(PG8_SA(0, 0), a2, voffA);
            PG8_BAR; PG8_WAIT_L(0); PG8_MMA(1, 0, At, B0); PG8_BAR; PG8_SCHED;
            PG8_STAGE(PG8_SB(0, 1), b2 + hstep, voffB);
            PG8_WAIT_V(6); PG8_BAR; PG8_MMA(1, 1, At, B1); PG8_BAR;
            PG8_LDB(B0, 1, 0); PG8_SCHED; PG8_LDA(At, 1, 0); PG8_STAGE(PG8_SA(0, 1), a2 + hstep, voffA);
            PG8_WAIT_L(8); PG8_BAR; PG8_WAIT_L(0); PG8_MMA(0, 0, At, B0); PG8_BAR; PG8_SCHED;
            PG8_LDB(B1, 1, 1); PG8_STAGE(PG8_SB(1, 0), b3, voffB);
            PG8_BAR; PG8_WAIT_L(0); PG8_MMA(0, 1, At, B1); PG8_BAR;
            PG8_LDA(At, 1, 1); PG8_STAGE(PG8_SA(1, 0), a3, voffA);
            PG8_BAR; PG8_WAIT_L(0); PG8_MMA(1, 0, At, B0); PG8_BAR; PG8_SCHED;
            PG8_STAGE(PG8_SB(1, 1), b3 + hstep, voffB);
            PG8_WAIT_V(6); PG8_BAR; PG8_MMA(1, 1, At, B1); PG8_BAR;
            }
        }
        if constexpr (ALIGN_EPI) { if (wr == 0) PG8_BAR; }
        if constexpr (!Epi::AFTER_DRAIN) { E(acc, cur, wr, wc, fr, fq); S.done(cur); }
        if (!has_next) break;
#pragma unroll
        for (int a = 0; a < 2; ++a)
#pragma unroll
            for (int b = 0; b < 2; ++b)
#pragma unroll
                for (int m = 0; m < 4; ++m)
#pragma unroll
                    for (int n = 0; n < 2; ++n) acc[a][b][m][n] = (f32x4){0.f, 0.f, 0.f, 0.f};
        cur = nxt; cA = nA; cB = nB; ++ui;
        if constexpr (ALIGN_EPI) { if (wr == 1) PG8_BAR; }
    }
    PG8_WAIT_V(0);
    if constexpr (!ALIGN_EPI) { if (wr == 0) PG8_BAR; }
    PG8_BAR;
    if constexpr (Epi::AFTER_DRAIN) { E.fused(acc, cur, wr, wc, fr, fq, lds, wid, lane); S.done(cur); }
#undef PG8_SA
#undef PG8_SB
#undef PG8_STAGE
#undef PG8_LDA
#undef PG8_LDB
#undef PG8_MMA
#undef PG8_WAIT_V
#undef PG8_WAIT_L
#undef PG8_BAR
#undef PG8_SCHED
}
}

#define LAS __attribute__((address_space(3)))
typedef unsigned short bf16_t;
typedef short bf16x8 __attribute__((ext_vector_type(8)));
typedef short bf16x4 __attribute__((ext_vector_type(4)));
typedef float f32x4 __attribute__((ext_vector_type(4)));
typedef float f32x16 __attribute__((ext_vector_type(16)));
typedef unsigned u32x4 __attribute__((ext_vector_type(4)));
typedef unsigned u32x2 __attribute__((ext_vector_type(2)));

constexpr int M_TOK = 32768, DM = 1024, SEQ = 2048, NB = 16;
constexpr int FF = 2816;
constexpr float ALPHA = 1.681792830507429f;
constexpr float LN_EPS = 1e-5f, RMS_EPS = 1e-6f;
constexpr float QSCALE = 0.10206207261596575f * 1.4426950408889634f;

constexpr size_t MiB = 1u << 20;
constexpr size_t WS_MOD = 0, WS_LB = 3 * MiB / 2, WS_TAB = 2 * MiB;
constexpr size_t W_MWIN = 6 * MiB, W_MWQB = 11 * MiB, W_MWKVB = 31 * MiB / 2, W_MWO = 35 * MiB / 2, W_HWIN = 43 * MiB / 2, W_HWO = 75 * MiB / 2,
                 W_FWIN = 83 * MiB / 2, W_FWOUT = 171 * MiB / 2;
constexpr size_t WS_H = 108 * MiB, WS_R = 172 * MiB;
constexpr size_t R_T = WS_R, R_PROJ = WS_R, R_Q = WS_R, R_LATQ = WS_R + 132 * MiB, R_LATKV = WS_R + 180 * MiB, R_O = WS_R + 132 * MiB,
                 R_KR = WS_R + 196 * MiB, R_KN = WS_R + 198 * MiB, R_VT = WS_R + 262 * MiB;
constexpr size_t R_QS = WS_R, R_LOGF = WS_R + 64 * MiB, R_VV = WS_R + 192 * MiB, R_GS = WS_R + 256 * MiB;
constexpr size_t WS_END = WS_R + 326 * MiB;
constexpr int LDS_BYTES = 131072 + 64;
constexpr size_t WS_BAR = WS_LB + 65536;
constexpr size_t WS_RS = WS_LB + 131072;

struct Params {
    const float* x; const float* c; const int* pos;
    const float* mla_qn; const float* mla_kvn; const float* hgrn_lb; const float* hgrn_gn;
    const float* ada_w; const float* ada_b; const float* ln_g; const float* ln_b;
    float* X; unsigned char* ws;
    const float* wsrc[8];
    float invf[16];
    int ph_lo, ph_hi;
};
typedef const __attribute__((address_space(4))) Params* ParamsPtr;
struct WType { int K, N, layers, mode; size_t dst; int drows; };
constexpr WType WT[8] = {
    {1024, 1056, 2, 0, W_MWIN, 1280}, {768, 1536, 2, 0, W_MWQB, 1536}, {256, 2048, 2, 2, W_MWKVB, 2048}, {1024, 1024, 2, 0, W_MWO, 1024},
    {1024, 4096, 2, 0, W_HWIN, 4096}, {1024, 1024, 2, 0, W_HWO, 1024}, {1024, 5632, 4, 1, W_FWIN, 5632}, {2816, 1024, 4, 0, W_FWOUT, 1024} };
constexpr int wt_items(int t) { return (WT[t].K / 64) * (WT[t].N / 32); }
constexpr int wt_total() { int s = 0; for (int t = 0; t < 8; ++t) s += wt_items(t) * WT[t].layers; return s; }

__device__ __forceinline__ unsigned pk2(float lo, float hi) { unsigned r; asm volatile("v_cvt_pk_bf16_f32 %0, %1, %2" : "=v"(r) : "v"(lo), "v"(hi)); return r; }
__device__ __forceinline__ float bf2f(unsigned short h) { return __uint_as_float((unsigned)h << 16); }
__device__ __forceinline__ float wave_sum(float v) {
#pragma unroll
    for (int o = 1; o < 64; o <<= 1) v += __shfl_xor(v, o);
    return v;
}
__device__ __forceinline__ float fast_rcp(float x) { return __builtin_amdgcn_rcpf(x); }
__device__ __forceinline__ float sigmoidf_(float x) { return fast_rcp(1.f + __expf(-x)); }
__device__ __forceinline__ float siluf_(float x) { return x * sigmoidf_(x); }
__device__ __forceinline__ int crow(int r, int hi) { return (r & 3) + 8 * (r >> 2) + 4 * hi; }
__device__ __forceinline__ f32x16 mfma32(bf16x8 a, bf16x8 b, f32x16 c) { return __builtin_amdgcn_mfma_f32_32x32x16_bf16(a, b, c, 0, 0, 0); }

struct EpiProj {
    static constexpr bool PERM = false, AFTER_DRAIN = false;
    float* O; int ldc, ncols;
    __device__ __forceinline__ void operator()(const pg8::f32x4 (&acc)[2][2][4][2], const pg8::Unit& u, int wr, int wc, int fr, int fq) const {
        const int row0 = u.pm * 256 + wr * 64 + fr, col0 = u.pn * 256 + wc * 32 + 4 * fq;
#pragma unroll
        for (int ai = 0; ai < 2; ++ai)
#pragma unroll
            for (int m = 0; m < 4; ++m) { float* rp = O + (size_t)(row0 + ai * 128 + m * 16) * ldc;
#pragma unroll
                for (int bj = 0; bj < 2; ++bj)
#pragma unroll
                    for (int n = 0; n < 2; ++n) { const int c = col0 + bj * 128 + n * 16; if (c < ncols) *(f32x4*)(rp + c) = acc[ai][bj][m][n]; } }
    }
};
struct EpiQ {
    static constexpr bool PERM = false, AFTER_DRAIN = false;
    bf16_t* Q; const float* tab;
    __device__ __forceinline__ void operator()(const pg8::f32x4 (&acc)[2][2][4][2], const pg8::Unit& u, int wr, int wc, int fr, int fq) const {
        const int row0 = u.pm * 256 + wr * 64 + fr;
#pragma unroll
        for (int bj = 0; bj < 2; ++bj) {
            const int c0 = u.pn * 256 + bj * 128 + wc * 32; const bool rope = ((c0 >> 5) % 3) == 2;
#pragma unroll
            for (int ai = 0; ai < 2; ++ai)
#pragma unroll
                for (int m = 0; m < 4; ++m) { const int row = row0 + ai * 128 + m * 16;
                    f32x4 v0 = acc[ai][bj][m][0], v1 = acc[ai][bj][m][1];
                    if (rope) { const f32x4 cs = *(const f32x4*)(tab + (size_t)row * 32 + 4 * fq), sn = *(const f32x4*)(tab + (size_t)row * 32 + 16 + 4 * fq);
                        const f32x4 a = v0 * cs - v1 * sn, b = v0 * sn + v1 * cs; v0 = a; v1 = b; }
                    v0 = v0 * QSCALE; v1 = v1 * QSCALE;
                    bf16_t* qp = Q + (size_t)row * 1536 + c0 + 4 * fq;
                    u32x2 w0, w1; w0.x = pk2(v0[0], v0[1]); w0.y = pk2(v0[2], v0[3]); w1.x = pk2(v1[0], v1[1]); w1.y = pk2(v1[2], v1[3]);
                    *(u32x2*)qp = w0; *(u32x2*)(qp + 16) = w1; }
        }
    }
};
struct EpiBf16 {
    static constexpr bool PERM = true, AFTER_DRAIN = false;
    bf16_t* O; int ldc;
    __device__ __forceinline__ void operator()(const pg8::f32x4 (&acc)[2][2][4][2], const pg8::Unit& u, int wr, int wc, int fr, int fq) const {
        const int row0 = u.pm * 256 + wr * 64 + fr, col0 = u.pn * 256 + wc * 32 + 8 * fq;
#pragma unroll
        for (int ai = 0; ai < 2; ++ai)
#pragma unroll
            for (int m = 0; m < 4; ++m) { bf16_t* rp = O + (size_t)(row0 + ai * 128 + m * 16) * ldc + col0;
#pragma unroll
                for (int bj = 0; bj < 2; ++bj) { const f32x4 a0 = acc[ai][bj][m][0], a1 = acc[ai][bj][m][1];
                    u32x4 w; w.x = pk2(a0[0], a0[1]); w.y = pk2(a0[2], a0[3]); w.z = pk2(a1[0], a1[1]); w.w = pk2(a1[2], a1[3]); *(u32x4*)(rp + bj * 128) = w; } }
    }
};
struct EpiVT {
    static constexpr bool PERM = true, AFTER_DRAIN = false;
    bf16_t* VT;
    __device__ __forceinline__ void operator()(const pg8::f32x4 (&acc)[2][2][4][2], const pg8::Unit& u, int wr, int wc, int fr, int fq) const {
        const int row0 = u.pm * 256 + wr * 64 + fr, tok0 = u.pn * 256 + wc * 32 + 8 * fq;
        bf16_t* base = VT + (size_t)(tok0 >> 11) * (1024 * 2048) + (tok0 & 2047);
#pragma unroll
        for (int ai = 0; ai < 2; ++ai)
#pragma unroll
            for (int m = 0; m < 4; ++m) { bf16_t* rp = base + (size_t)(row0 + ai * 128 + m * 16) * 2048;
#pragma unroll
                for (int bj = 0; bj < 2; ++bj) { const f32x4 a0 = acc[ai][bj][m][0], a1 = acc[ai][bj][m][1];
                    u32x4 w; w.x = pk2(a0[0], a0[1]); w.y = pk2(a0[2], a0[3]); w.z = pk2(a1[0], a1[1]); w.w = pk2(a1[2], a1[3]); *(u32x4*)(rp + bj * 128) = w; } }
    }
};
struct EpiResid {
    static constexpr bool PERM = false, AFTER_DRAIN = false;
    const float* Xin; float* Xout; const float* modrow; const float* RS; const float* g; const float* bta; int raw;
    __device__ __forceinline__ void operator()(const pg8::f32x4 (&acc)[2][2][4][2], const pg8::Unit& u, int wr, int wc, int fr, int fq) const {
        const int row0 = u.pm * 256 + wr * 64 + fr, col0 = u.pn * 256 + wc * 32 + 4 * fq;
        const int b = (u.pm * 256) >> 11; const float* gp = modrow + (size_t)b * 3072 + 2048 + col0;
#pragma unroll
        for (int bj = 0; bj < 2; ++bj)
#pragma unroll
            for (int n = 0; n < 2; ++n) {
                const int c = col0 + bj * 128 + n * 16;
                const f32x4 gt = *(const f32x4*)(gp + bj * 128 + n * 16) + 1.0f;
                f32x4 g4 = (f32x4){1.f, 1.f, 1.f, 1.f}, b4 = (f32x4){0.f, 0.f, 0.f, 0.f};
                if (!raw) { g4 = *(const f32x4*)(g + c); b4 = *(const f32x4*)(bta + c); }
#pragma unroll
                for (int ai = 0; ai < 2; ++ai)
#pragma unroll
                    for (int m = 0; m < 4; ++m) { const int row = row0 + ai * 128 + m * 16;
                        f32x4 xo = *(const f32x4*)(Xin + (size_t)row * 1024 + c);
                        if (!raw) { const float mean = RS[2 * row], rstd = RS[2 * row + 1]; xo = (xo - mean) * rstd * g4 + b4; }
                        *(f32x4*)(Xout + (size_t)row * 1024 + c) = xo * ALPHA + gt * acc[ai][bj][m][n]; }
            }
    }
};
struct EpiSwiGLU {
    static constexpr bool PERM = true, AFTER_DRAIN = false;
    bf16_t* T;
    __device__ __forceinline__ void operator()(const pg8::f32x4 (&acc)[2][2][4][2], const pg8::Unit& u, int wr, int wc, int fr, int fq) const {
        const int row0 = u.pm * 256 + wr * 64 + fr, col0 = u.pn * 128 + wc * 32 + 8 * fq;
#pragma unroll
        for (int ai = 0; ai < 2; ++ai)
#pragma unroll
            for (int m = 0; m < 4; ++m) {
                const f32x4 g0 = acc[ai][0][m][0], g1 = acc[ai][0][m][1], u0 = acc[ai][1][m][0], u1 = acc[ai][1][m][1];
                u32x4 w;
                w.x = pk2(siluf_(g0[0]) * u0[0], siluf_(g0[1]) * u0[1]); w.y = pk2(siluf_(g0[2]) * u0[2], siluf_(g0[3]) * u0[3]);
                w.z = pk2(siluf_(g1[0]) * u1[0], siluf_(g1[1]) * u1[1]); w.w = pk2(siluf_(g1[2]) * u1[2], siluf_(g1[3]) * u1[3]);
                *(u32x4*)(T + (size_t)(row0 + ai * 128 + m * 16) * FF + col0) = w; }
    }
};
struct EpiHgrnIn {
    static constexpr bool PERM = true, AFTER_DRAIN = false;
    bf16_t* QS; float* LOGF; const float* lb;
    __device__ __forceinline__ void operator()(const pg8::f32x4 (&acc)[2][2][4][2], const pg8::Unit& u, int wr, int wc, int fr, int fq) const {
        const int row0 = u.pm * 256 + wr * 64 + fr, region = u.pn >> 2, col0 = (u.pn & 3) * 256 + wc * 32 + 8 * fq;
        if (region == 1) {
#pragma unroll
            for (int bj = 0; bj < 2; ++bj) { const f32x4 l0 = *(const f32x4*)(lb + col0 + bj * 128), l1 = *(const f32x4*)(lb + col0 + bj * 128 + 4);
#pragma unroll
                for (int ai = 0; ai < 2; ++ai)
#pragma unroll
                    for (int m = 0; m < 4; ++m) { float* op = LOGF + (size_t)(row0 + ai * 128 + m * 16) * 1024 + col0 + bj * 128;
                        const f32x4 a0 = acc[ai][bj][m][0], a1 = acc[ai][bj][m][1]; f32x4 r0, r1;
#pragma unroll
                        for (int e = 0; e < 4; ++e) { r0[e] = __logf(l0[e] + (1.f - l0[e]) * sigmoidf_(a0[e])); r1[e] = __logf(l1[e] + (1.f - l1[e]) * sigmoidf_(a1[e])); }
                        *(f32x4*)op = r0; *(f32x4*)(op + 4) = r1; } }
        } else {
            bf16_t* base = QS + (size_t)(region == 0 ? 0 : (region == 2 ? (R_VV - R_QS) / 2 : (R_GS - R_QS) / 2)); const bool act = region != 2;
#pragma unroll
            for (int ai = 0; ai < 2; ++ai)
#pragma unroll
                for (int m = 0; m < 4; ++m)
#pragma unroll
                    for (int bj = 0; bj < 2; ++bj) { f32x4 a0 = acc[ai][bj][m][0], a1 = acc[ai][bj][m][1];
                        if (act) {
#pragma unroll
                            for (int e = 0; e < 4; ++e) { a0[e] = siluf_(a0[e]); a1[e] = siluf_(a1[e]); } }
                        u32x4 w; w.x = pk2(a0[0], a0[1]); w.y = pk2(a0[2], a0[3]); w.z = pk2(a1[0], a1[1]); w.w = pk2(a1[2], a1[3]);
                        *(u32x4*)(base + (size_t)(row0 + ai * 128 + m * 16) * 1024 + col0 + bj * 128) = w; }
        }
    }
};

#define XB_TMO      128
#define XB_XCNT(j)  (256  + 64 * (j))
#define XB_XSUB(j)  (1280 + 64 * (j))
#define XB_XGEN(j)  (2304 + 64 * (j))
#define XB_TOP      3328
#define XB_TOPGEN   3392
#define XCD_BAR_WORDS 3456
#define XB_SPIN_CAP (1u << 18)

__device__ __forceinline__ unsigned xb_ld(unsigned* p)              { return __hip_atomic_load(p, __ATOMIC_RELAXED, __HIP_MEMORY_SCOPE_AGENT); }
__device__ __forceinline__ unsigned xb_add(unsigned* p, unsigned v) { return __hip_atomic_fetch_add(p, v, __ATOMIC_RELAXED, __HIP_MEMORY_SCOPE_AGENT); }
__device__ __forceinline__ unsigned xb_xcc_id() { return (unsigned)__builtin_amdgcn_s_getreg((3 << 11) | 20) & 0xFu; }
#define XB_SPIN(cond, bar) do { unsigned _sp = 0; while (cond) { __builtin_amdgcn_s_sleep(1); \
    if ((++_sp & 255u) == 0u) { if (xb_ld(&(bar)[XB_TMO])) break; if (_sp > XB_SPIN_CAP) { atomicAdd(&(bar)[XB_TMO], 1u); break; } } } } while (0)

struct XcdBarrier {
    unsigned* bar; unsigned x;
    volatile LAS unsigned* st;
};

__device__ __forceinline__ XcdBarrier xcd_barrier_post(unsigned* bar, volatile LAS unsigned* st) {
    XcdBarrier b; b.bar = bar; b.x = xb_xcc_id(); b.st = st;
    if (mk_tid() == 0) (void)xb_add(&bar[XB_XCNT(b.x)], 1u);
    return b;
}
__device__ __forceinline__ void xcd_barrier_complete(unsigned* bar, unsigned x, unsigned& nloc, unsigned& nx) {
    const unsigned G = (unsigned)mk_grid();
    unsigned sum, cnt, mine, sp = 0u;
    for (;;) {
        sum = 0u; cnt = 0u; mine = 0u;
#pragma unroll
        for (unsigned j = 0; j < 16; ++j) { const unsigned c = xb_ld(&bar[XB_XCNT(j)]); sum += c; cnt += (c > 0u) ? 1u : 0u; mine = (j == x) ? c : mine; }
        if (sum == G) break;
        __builtin_amdgcn_s_sleep(1);
        if ((++sp & 255u) == 0u) { if (xb_ld(&bar[XB_TMO])) break; if (sp > XB_SPIN_CAP) { atomicAdd(&bar[XB_TMO], 1u); break; } }
    }
    nloc = mine > 0u ? mine : 1u; nx = cnt > 0u ? cnt : 1u;
}

__device__ __forceinline__ void xcd_barrier(const XcdBarrier& b) {
    asm volatile("s_waitcnt vmcnt(0)" ::: "memory");
    __syncthreads();
    if (mk_tid() == 0) {
        unsigned* bar = b.bar;
        __builtin_amdgcn_s_waitcnt(0);
        unsigned nloc = b.st[0], nx = b.st[1];
        if (nloc == 0u) { xcd_barrier_complete(bar, b.x, nloc, nx); b.st[0] = nloc; b.st[1] = nx; }
        const unsigned old = xb_add(&bar[XB_XSUB(b.x)], 1u);
        const unsigned gen = old / nloc;
        if (old + 1u == (gen + 1u) * nloc) {
            __builtin_amdgcn_fence(__ATOMIC_RELEASE, "agent");
            asm volatile("s_waitcnt vmcnt(0)" ::: "memory");
            const unsigned og = xb_add(&bar[XB_TOP], 1u);
            const unsigned tg = og / nx;
            if (og + 1u == (tg + 1u) * nx) xb_add(&bar[XB_TOPGEN], 1u);
            else XB_SPIN(xb_ld(&bar[XB_TOPGEN]) == tg, bar);
            __builtin_amdgcn_fence(__ATOMIC_ACQUIRE, "agent");
            xb_add(&bar[XB_XGEN(b.x)], 1u);
            asm volatile("s_waitcnt vmcnt(0)" ::: "memory");
        } else {
            XB_SPIN(xb_ld(&bar[XB_XGEN(b.x)]) == gen, bar);
            __builtin_amdgcn_fence(__ATOMIC_ACQUIRE, "agent");
            asm volatile("s_waitcnt vmcnt(0)" ::: "memory");
        }
    }
    __syncthreads();
}


__device__ __forceinline__ void transpose_item(const float* W, bf16_t* dst, int K, int N, int mode, int item, LAS float* scr, int lane) {
    const int nblk = N / 32, kb = item / nblk, nb = item % nblk, k0 = 64 * kb, n0 = 32 * nb;
    int drow0 = n0;
    if (mode == 1) { const int up = n0 >= FF, j0 = up ? n0 - FF : n0; drow0 = 256 * (j0 >> 7) + (up ? 128 : 0) + (j0 & 127); }
    if (mode == 2) { const int h = n0 >> 7, r = n0 & 127; drow0 = (r < 64) ? h * 64 + r : 1024 + h * 64 + (r - 64); }
#pragma unroll 8
    for (int i = 0; i < 32; ++i) { const int kk = 2 * i + (lane >> 5); scr[kk * 33 + (lane & 31)] = W[(size_t)(k0 + kk) * N + n0 + (lane & 31)]; }
    asm volatile("s_waitcnt lgkmcnt(0)" ::: "memory");
    const int c = lane & 7;
#pragma unroll
    for (int j = 0; j < 4; ++j) { const int n = (lane >> 3) + 8 * j; const LAS float* s = scr + (8 * c) * 33 + n;
        u32x4 o; o.x = pk2(s[0 * 33], s[1 * 33]); o.y = pk2(s[2 * 33], s[3 * 33]); o.z = pk2(s[4 * 33], s[5 * 33]); o.w = pk2(s[6 * 33], s[7 * 33]);
        *(u32x4*)(dst + (size_t)(drow0 + n) * K + k0 + 8 * c) = o; }
    asm volatile("s_waitcnt lgkmcnt(0)" ::: "memory");
}

__device__ __forceinline__ void prologue_phase(ParamsPtr pp, LAS unsigned char* lds) {
    const ParamsPtr p_ = pp;
#define p (*p_)
    const int tid = mk_tid(), lane = tid & 63, wave = __builtin_amdgcn_readfirstlane(tid >> 6);
    const int G = mk_grid();
    {
        LAS float* sc = (LAS float*)lds;
        LAS float* red = (LAS float*)(lds + 65536);
        for (int i = tid; i < NB * DM; i += 512) { const int b = i >> 10, k = i & 1023; const float v = p.c[i]; sc[k * 16 + b] = v / (1.f + __expf(-v)); }
        __syncthreads();
        float* MOD = (float*)(p.ws + WS_MOD);
        for (int it = mk_bid(); it < 8 * 48; it += G) {
            const int ls = it / 48, n0 = (it % 48) * 64, col = tid & 63, kg = tid >> 6;
            const float* W = p.ada_w + (size_t)ls * 1024 * 3072 + (size_t)(kg * 128) * 3072 + n0 + col;
            float acc[16];
#pragma unroll
            for (int b = 0; b < 16; ++b) acc[b] = 0.f;
#pragma unroll 4
            for (int k = 0; k < 128; ++k) { const float w = W[(size_t)k * 3072]; const LAS f32x4* s4 = (const LAS f32x4*)(sc + (kg * 128 + k) * 16);
#pragma unroll
                for (int q = 0; q < 4; ++q) { const f32x4 s = s4[q]; acc[4 * q + 0] += s[0] * w; acc[4 * q + 1] += s[1] * w; acc[4 * q + 2] += s[2] * w; acc[4 * q + 3] += s[3] * w; } }
#pragma unroll
            for (int q = 0; q < 4; ++q) *(LAS f32x4*)(red + (kg * 64 + col) * 16 + 4 * q) = (f32x4){acc[4 * q], acc[4 * q + 1], acc[4 * q + 2], acc[4 * q + 3]};
            __syncthreads();
            { const int b0 = 2 * kg;
#pragma unroll
              for (int bb = 0; bb < 2; ++bb) { float s = 0.f;
#pragma unroll
                  for (int g = 0; g < 8; ++g) s += red[(g * 64 + col) * 16 + b0 + bb];
                  MOD[((size_t)ls * 16 + b0 + bb) * 3072 + n0 + col] = s + p.ada_b[ls * 3072 + n0 + col]; } }
            __syncthreads();
        }
    }
    if (mk_bid() == 0) {
        float* LB = (float*)(p.ws + WS_LB);
        for (int cidx = tid; cidx < 1024; cidx += 512) { const float a0 = p.hgrn_lb[cidx], a1 = p.hgrn_lb[1024 + cidx], mx = fmaxf(a0, a1);
            const float e0 = expf(a0 - mx), e1 = expf(a1 - mx), s0 = e0 / (e0 + e1), s1 = e1 / (e0 + e1);
            LB[cidx] = s0 - s0; LB[1024 + cidx] = (s0 + s1) - s0; }
    }
    {
        float* TAB = (float*)(p.ws + WS_TAB);
        for (int gi = mk_bid() * 512 + tid; gi < M_TOK * 16; gi += G * 512) {
            const int m = gi >> 4, i = gi & 15; const float ang = (float)p.pos[m] * p.invf[i];
            const double r = (double)ang, q = rint(r * 0.63661977236758134308), t = fma(-q, 1.57079632679489661923, r), t2 = t * t;
            const double s = t * (1.0 + t2 * (-1.0 / 6 + t2 * (1.0 / 120 + t2 * (-1.0 / 5040 + t2 * (1.0 / 362880 + t2 * (-1.0 / 39916800 + t2 * (1.0 / 6227020800.0)))))));
            const double c = 1.0 + t2 * (-0.5 + t2 * (1.0 / 24 + t2 * (-1.0 / 720 + t2 * (1.0 / 40320 + t2 * (-1.0 / 3628800 + t2 * (1.0 / 479001600.0))))));
            const int qi = ((int)q) & 3; double cc, ss;
            if (qi == 0) { cc = c; ss = s; } else if (qi == 1) { cc = -s; ss = c; } else if (qi == 2) { cc = -c; ss = -s; } else { cc = s; ss = -c; }
            TAB[(size_t)m * 32 + i] = (float)cc; TAB[(size_t)m * 32 + 16 + i] = (float)ss; }
    }
    {
        for (int gi = mk_bid() * 512 + tid; gi < 2 * 224 * 128; gi += G * 512) { const int l = gi / (224 * 128), r = gi % (224 * 128);
            *(u32x4*)(p.ws + W_MWIN + (size_t)l * 1280 * 1024 * 2 + (size_t)1056 * 1024 * 2 + (size_t)r * 16) = (u32x4){0u, 0u, 0u, 0u}; }
    }
    __syncthreads();
    {
        LAS float* scr = (LAS float*)(lds + wave * 8448);
        const int gw = mk_bid() * 8 + wave, NGW = G * 8;
        for (int it = gw; it < wt_total(); it += NGW) {
            int r = it;
#pragma unroll
            for (int t = 0; t < 8; ++t) {
                const int ni = wt_items(t) * WT[t].layers;
                if (r >= 0 && r < ni) { const int l = r / wt_items(t), item = r % wt_items(t);
                    transpose_item(p.wsrc[t] + (size_t)l * WT[t].K * WT[t].N, (bf16_t*)(p.ws + WT[t].dst) + (size_t)l * WT[t].drows * WT[t].K, WT[t].K, WT[t].N, WT[t].mode, item, scr, lane); }
                r -= ni;
            }
        }
    }
}

#undef p
__device__ __forceinline__ void norm_phase(const float* src, float* dst, bool do_ln, bool write_x, const float* g, const float* bta, float* RS, bool do_h, const float* modrow, bf16_t* H) {
    const int tid_ = mk_tid(), lane = tid_ & 63, wave = __builtin_amdgcn_readfirstlane(tid_ >> 6); const int gw = mk_bid() * 8 + wave, NGW = mk_grid() * 8;
    for (int m = gw; m < M_TOK; m += NGW) {
        const int b = m >> 11; const f32x4* xr = (const f32x4*)(src + (size_t)m * 1024) + lane;
        f32x4 v[4];
#pragma unroll
        for (int j = 0; j < 4; ++j) v[j] = xr[64 * j];
        if (do_ln) {
            float s = 0.f;
#pragma unroll
            for (int j = 0; j < 4; ++j) s += (v[j][0] + v[j][1]) + (v[j][2] + v[j][3]);
            const float mean = wave_sum(s) * (1.f / 1024.f); float s2 = 0.f;
#pragma unroll
            for (int j = 0; j < 4; ++j) { v[j] = v[j] - mean; s2 += (v[j][0] * v[j][0] + v[j][1] * v[j][1]) + (v[j][2] * v[j][2] + v[j][3] * v[j][3]); }
            const float rstd = 1.0f / sqrtf(wave_sum(s2) * (1.f / 1024.f) + LN_EPS);
            if (lane == 0) { RS[2 * m] = mean; RS[2 * m + 1] = rstd; }
#pragma unroll
            for (int j = 0; j < 4; ++j) { const f32x4 gg = *((const f32x4*)g + lane + 64 * j), bb = *((const f32x4*)bta + lane + 64 * j); v[j] = v[j] * rstd * gg + bb; }
        }
        if (write_x) { f32x4* xo = (f32x4*)(dst + (size_t)m * 1024) + lane;
#pragma unroll
            for (int j = 0; j < 4; ++j) xo[64 * j] = v[j]; }
        if (do_h) { const f32x4* sh = (const f32x4*)(modrow + (size_t)b * 3072) + lane; const f32x4* sc = (const f32x4*)(modrow + (size_t)b * 3072 + 1024) + lane;
            u32x2* ho = (u32x2*)(H + (size_t)m * 1024) + lane;
#pragma unroll
            for (int j = 0; j < 4; ++j) { const f32x4 h = v[j] * (sc[64 * j] + 1.0f) + sh[64 * j]; u32x2 w; w.x = pk2(h[0], h[1]); w.y = pk2(h[2], h[3]); ho[64 * j] = w; } }
    }
}

__device__ __forceinline__ void latnorm_phase(const float* PROJ, const float* qn, const float* kvn, const float* tab, bf16_t* LATQ, bf16_t* LATKV, bf16_t* KR) {
    const int tid_ = mk_tid(), lane = tid_ & 63, wave = __builtin_amdgcn_readfirstlane(tid_ >> 6); const int gw = mk_bid() * 8 + wave, NGW = mk_grid() * 8;
    for (int m = gw; m < M_TOK; m += NGW) {
        const float* pr = PROJ + (size_t)m * 1056;
        f32x4 v[3]; float s = 0.f;
#pragma unroll
        for (int j = 0; j < 3; ++j) { v[j] = *((const f32x4*)pr + lane + 64 * j); s += (v[j][0] * v[j][0] + v[j][1] * v[j][1]) + (v[j][2] * v[j][2] + v[j][3] * v[j][3]); }
        const f32x4 kv = *((const f32x4*)(pr + 768) + lane); const float s2 = (kv[0] * kv[0] + kv[1] * kv[1]) + (kv[2] * kv[2] + kv[3] * kv[3]);
        const float rq = 1.0f / sqrtf(wave_sum(s) * (1.f / 768.f) + RMS_EPS), rkv = 1.0f / sqrtf(wave_sum(s2) * (1.f / 256.f) + RMS_EPS);
#pragma unroll
        for (int j = 0; j < 3; ++j) { const f32x4 gg = *((const f32x4*)qn + lane + 64 * j); const f32x4 o = v[j] * rq * gg; u32x2 w; w.x = pk2(o[0], o[1]); w.y = pk2(o[2], o[3]);
            *((u32x2*)(LATQ + (size_t)m * 768) + lane + 64 * j) = w; }
        { const f32x4 gg = *((const f32x4*)kvn + lane); const f32x4 o = kv * rkv * gg; u32x2 w; w.x = pk2(o[0], o[1]); w.y = pk2(o[2], o[3]); *((u32x2*)(LATKV + (size_t)m * 256) + lane) = w; }
        if (lane < 16) { const float x1 = pr[1024 + lane], x2 = pr[1040 + lane], cs = tab[(size_t)m * 32 + lane], sn = tab[(size_t)m * 32 + 16 + lane];
            const unsigned w = pk2(x1 * cs - x2 * sn, x1 * sn + x2 * cs); KR[(size_t)m * 32 + lane] = (bf16_t)(w & 0xffff); KR[(size_t)m * 32 + 16 + lane] = (bf16_t)(w >> 16); }
    }
}

__device__ __forceinline__ void attn_phase(LAS unsigned char* lds, const bf16_t* Q, const bf16_t* KN, const bf16_t* KR, const bf16_t* VT, bf16_t* O) {
    constexpr int KPB = 208, VPB = 144, KSB = 64 * KPB, VSB = 64 * VPB;
    const int tid = mk_tid(), lane = tid & 63, wave = __builtin_amdgcn_readfirstlane(tid >> 6), q = lane & 31, g = lane >> 5;
    const unsigned kn_dst = (tid >> 3) * KPB + (tid & 7) * 16, kr_dst = (tid >> 2) * KPB + 128 + (tid & 3) * 16, vt_dst = 2 * KSB + (tid >> 3) * VPB + (tid & 7) * 16;
    for (int bh = mk_bid(); bh < 256; bh += mk_grid()) {
        const int b = bh >> 4, h = bh & 15;
        const bf16_t* kn_src = KN + (size_t)(b * 2048 + (tid >> 3)) * 1024 + h * 64 + (tid & 7) * 8;
        const bf16_t* kr_src = KR + (size_t)(b * 2048 + (tid >> 2)) * 32 + (tid & 3) * 8;
        const bf16_t* vt_src = VT + (size_t)(bh * 64 + (tid >> 3)) * 2048 + (tid & 7) * 8;
#pragma unroll 1
        for (int qb = 7; qb >= 0; --qb) {
            __syncthreads();
            const int r0 = qb * 256 + wave * 32, ntile = 4 * (qb + 1);
            bf16x8 qf[6];
            { const bf16_t* qp = Q + (size_t)(b * 2048 + r0 + q) * 1536 + h * 96 + g * 8;
#pragma unroll
              for (int ks = 0; ks < 6; ++ks) qf[ks] = *(const bf16x8*)(qp + ks * 16); }
            f32x16 o0, o1;
#pragma unroll
            for (int i = 0; i < 16; ++i) { o0[i] = 0.f; o1[i] = 0.f; }
            float mrow = -INFINITY, lrow = 0.f;
            u32x4 rk, rr, rv;
            rk = *(const u32x4*)kn_src; rv = *(const u32x4*)vt_src; if (tid < 256) rr = *(const u32x4*)kr_src;
            *(LAS u32x4*)(lds + kn_dst) = rk; *(LAS u32x4*)(lds + vt_dst) = rv; if (tid < 256) *(LAS u32x4*)(lds + kr_dst) = rr;
            __syncthreads();
#pragma unroll 1
            for (int j = 0; j < ntile; ++j) {
                const int cur = j & 1; const bool more = (j + 1 < ntile);
                if (more) { rk = *(const u32x4*)(kn_src + (size_t)(j + 1) * 64 * 1024); rv = *(const u32x4*)(vt_src + (j + 1) * 64); if (tid < 256) rr = *(const u32x4*)(kr_src + (size_t)(j + 1) * 64 * 32); }
                if (64 * j <= r0 + 31) {
                    const LAS unsigned char* kb_ = lds + cur * KSB; const LAS unsigned char* vb_ = lds + 2 * KSB + cur * VSB;
                    f32x16 s0, s1;
#pragma unroll
                    for (int i = 0; i < 16; ++i) { s0[i] = 0.f; s1[i] = 0.f; }
#pragma unroll
                    for (int ks = 0; ks < 6; ++ks) {
                        const bf16x8 a0 = *(const LAS bf16x8*)(kb_ + q * KPB + (ks * 16 + g * 8) * 2), a1 = *(const LAS bf16x8*)(kb_ + (32 + q) * KPB + (ks * 16 + g * 8) * 2);
                        s0 = mfma32(a0, qf[ks], s0); s1 = mfma32(a1, qf[ks], s1); }
                    if (64 * j + 63 > r0) { const int qa = r0 + q, k0 = 64 * j + 4 * g;
#pragma unroll
                        for (int i = 0; i < 16; ++i) { const int key = k0 + (i & 3) + 8 * (i >> 2); if (key > qa) s0[i] = -INFINITY; if (key + 32 > qa) s1[i] = -INFINITY; } }
                    float mx = fmaxf(s0[0], s1[0]);
#pragma unroll
                    for (int i = 1; i < 16; ++i) mx = fmaxf(mx, fmaxf(s0[i], s1[i]));
                    mx = fmaxf(mx, __shfl_xor(mx, 32));
                    const float mnew = fmaxf(mrow, mx), alpha = __builtin_amdgcn_exp2f(mrow - mnew); mrow = mnew;
                    float sum = 0.f;
#pragma unroll
                    for (int i = 0; i < 16; ++i) { s0[i] = __builtin_amdgcn_exp2f(s0[i] - mnew); s1[i] = __builtin_amdgcn_exp2f(s1[i] - mnew); sum += s0[i] + s1[i]; }
                    lrow = lrow * alpha + sum;
#pragma unroll
                    for (int i = 0; i < 16; ++i) { o0[i] *= alpha; o1[i] *= alpha; }
#pragma unroll
                    for (int kb = 0; kb < 2; ++kb)
#pragma unroll
                        for (int t2 = 0; t2 < 2; ++t2) {
                            u32x4 pw;
                            if (kb == 0) { pw.x = pk2(s0[8 * t2 + 0], s0[8 * t2 + 1]); pw.y = pk2(s0[8 * t2 + 2], s0[8 * t2 + 3]); pw.z = pk2(s0[8 * t2 + 4], s0[8 * t2 + 5]); pw.w = pk2(s0[8 * t2 + 6], s0[8 * t2 + 7]); }
                            else         { pw.x = pk2(s1[8 * t2 + 0], s1[8 * t2 + 1]); pw.y = pk2(s1[8 * t2 + 2], s1[8 * t2 + 3]); pw.z = pk2(s1[8 * t2 + 4], s1[8 * t2 + 5]); pw.w = pk2(s1[8 * t2 + 6], s1[8 * t2 + 7]); }
                            const bf16x8 pb = __builtin_bit_cast(bf16x8, pw);
                            const int ko = (32 * kb + 16 * t2 + 4 * g) * 2;
                            { const u32x2 lo = *(const LAS u32x2*)(vb_ + q * VPB + ko), hi = *(const LAS u32x2*)(vb_ + q * VPB + ko + 16);
                              const u32x4 av = (u32x4){lo.x, lo.y, hi.x, hi.y}; o0 = mfma32(__builtin_bit_cast(bf16x8, av), pb, o0); }
                            { const u32x2 lo = *(const LAS u32x2*)(vb_ + (32 + q) * VPB + ko), hi = *(const LAS u32x2*)(vb_ + (32 + q) * VPB + ko + 16);
                              const u32x4 av = (u32x4){lo.x, lo.y, hi.x, hi.y}; o1 = mfma32(__builtin_bit_cast(bf16x8, av), pb, o1); }
                        }
                }
                if (more) { const unsigned bo = (cur ^ 1) * KSB, vo = (cur ^ 1) * VSB;
                    *(LAS u32x4*)(lds + bo + kn_dst) = rk; *(LAS u32x4*)(lds + vo + vt_dst) = rv; if (tid < 256) *(LAS u32x4*)(lds + bo + kr_dst) = rr; }
                __syncthreads();
            }
            const float lt = lrow + __shfl_xor(lrow, 32), inv = 1.0f / lt;
            bf16_t* op = O + (size_t)(b * 2048 + r0 + q) * 1024 + h * 64 + 4 * g;
#pragma unroll
            for (int qd = 0; qd < 4; ++qd) {
                u32x2 w0, w1; w0.x = pk2(o0[4 * qd] * inv, o0[4 * qd + 1] * inv); w0.y = pk2(o0[4 * qd + 2] * inv, o0[4 * qd + 3] * inv);
                w1.x = pk2(o1[4 * qd] * inv, o1[4 * qd + 1] * inv); w1.y = pk2(o1[4 * qd + 2] * inv, o1[4 * qd + 3] * inv);
                *(u32x2*)(op + 8 * qd) = w0; *(u32x2*)(op + 32 + 8 * qd) = w1; }
        }
    }
}

__device__ __forceinline__ void hgrn_phase(LAS unsigned char* lds, const bf16_t* QS, const float* LOGF, const bf16_t* VV, const bf16_t* GS, const float* gn, bf16_t* OG) {
    constexpr int QP = 0, KPN = 8704, KPT = 17408, VTT = 27648, SST = 37888, OPART = 72704, GSUM = 106496, ELAST = 108544;
    const int tid = mk_tid(), lane = tid & 63, wave = __builtin_amdgcn_readfirstlane(tid >> 6), q = lane & 31, g = lane >> 5;
    const int ch = tid & 127, tg = tid >> 7, vb = wave & 3, kh = wave >> 2;
    const int dt = tid >> 4, dpart = tid & 15;
    for (int bh = mk_bid(); bh < 128; bh += mk_grid()) {
        const int b = bh >> 3, hh = bh & 7;
        __syncthreads();
        f32x16 st0, st1;
#pragma unroll
        for (int i = 0; i < 16; ++i) { st0[i] = 0.f; st1[i] = 0.f; }
        const size_t ebase = (size_t)(b * 2048 + 8 * tg) * 1024 + hh * 128 + ch;
        const size_t dbase = (size_t)(b * 2048 + dt) * 1024 + hh * 128 + 8 * dpart;
        f32x4 gn0 = *(const f32x4*)(gn + 8 * dpart), gn1 = *(const f32x4*)(gn + 8 * dpart + 4);
        float lf[8]; unsigned short qs[8], vv[8];
#pragma unroll
        for (int i = 0; i < 8; ++i) { lf[i] = LOGF[ebase + (size_t)i * 1024]; qs[i] = QS[ebase + (size_t)i * 1024]; vv[i] = VV[ebase + (size_t)i * 1024]; }
        u32x4 gsv_next = *(const u32x4*)(GS + dbase);
#pragma unroll 1
        for (int c = 0; c < 64; ++c) {
            float cs[8]; cs[0] = lf[0];
#pragma unroll
            for (int i = 1; i < 8; ++i) cs[i] = cs[i - 1] + lf[i];
            *(LAS float*)(lds + GSUM + (tg * 128 + ch) * 4) = cs[7];
            __syncthreads();
            float off = 0.f, tot = 0.f;
#pragma unroll
            for (int t = 0; t < 4; ++t) { const float gs_ = *(const LAS float*)(lds + GSUM + (t * 128 + ch) * 4); if (t < tg) off += gs_; tot += gs_; }
            {
                unsigned kt[4], vt[4];
#pragma unroll
                for (int i = 0; i < 8; i += 2) {
                    const float b0 = off + cs[i], b1 = off + cs[i + 1];
                    const float q0 = bf2f(qs[i]) * __expf(b0), q1 = bf2f(qs[i + 1]) * __expf(b1);
                    const float k0 = (1.f - __expf(lf[i])) * __expf(-b0), k1 = (1.f - __expf(lf[i + 1])) * __expf(-b1);
                    const unsigned qw = pk2(q0, q1), kw = pk2(k0, k1);
                    *(LAS unsigned short*)(lds + QP + (8 * tg + i) * 272 + ch * 2) = (unsigned short)(qw & 0xffff);
                    *(LAS unsigned short*)(lds + QP + (8 * tg + i + 1) * 272 + ch * 2) = (unsigned short)(qw >> 16);
                    *(LAS unsigned short*)(lds + KPN + (8 * tg + i) * 272 + ch * 2) = (unsigned short)(kw & 0xffff);
                    *(LAS unsigned short*)(lds + KPN + (8 * tg + i + 1) * 272 + ch * 2) = (unsigned short)(kw >> 16);
                    kt[i >> 1] = kw; vt[i >> 1] = (unsigned)vv[i] | ((unsigned)vv[i + 1] << 16);
                }
                *(LAS u32x4*)(lds + KPT + ch * 80 + tg * 16) = (u32x4){kt[0], kt[1], kt[2], kt[3]};
                *(LAS u32x4*)(lds + VTT + ch * 80 + tg * 16) = (u32x4){vt[0], vt[1], vt[2], vt[3]};
                if (tg == 3) *(LAS float*)(lds + ELAST + ch * 4) = __expf(tot);
            }
#pragma unroll
            for (int qd = 0; qd < 4; ++qd) {
                u32x2 w0, w1; w0.x = pk2(st0[4 * qd], st0[4 * qd + 1]); w0.y = pk2(st0[4 * qd + 2], st0[4 * qd + 3]); w1.x = pk2(st1[4 * qd], st1[4 * qd + 1]); w1.y = pk2(st1[4 * qd + 2], st1[4 * qd + 3]);
                *(LAS u32x2*)(lds + SST + (32 * vb + q) * 272 + (32 * (2 * kh) + 8 * qd + 4 * g) * 2) = w0;
                *(LAS u32x2*)(lds + SST + (32 * vb + q) * 272 + (32 * (2 * kh + 1) + 8 * qd + 4 * g) * 2) = w1; }
            __syncthreads();
            const u32x4 gsv = gsv_next;
            if (c + 1 < 64) { const size_t e2 = ebase + (size_t)(c + 1) * 32 * 1024;
                gsv_next = *(const u32x4*)(GS + dbase + (size_t)(c + 1) * 32 * 1024);
#pragma unroll
                for (int i = 0; i < 8; ++i) { lf[i] = LOGF[e2 + (size_t)i * 1024]; qs[i] = QS[e2 + (size_t)i * 1024]; vv[i] = VV[e2 + (size_t)i * 1024]; } }
            {
                f32x16 oT;
#pragma unroll
                for (int i = 0; i < 16; ++i) oT[i] = 0.f;
#pragma unroll
                for (int ks = 0; ks < 4; ++ks) { const int k0 = (64 * kh + 16 * ks + 8 * g) * 2;
                    oT = mfma32(*(const LAS bf16x8*)(lds + SST + (32 * vb + q) * 272 + k0), *(const LAS bf16x8*)(lds + QP + q * 272 + k0), oT); }
                if (kh == 0) {
                    f32x16 aT;
#pragma unroll
                    for (int i = 0; i < 16; ++i) aT[i] = 0.f;
#pragma unroll
                    for (int ks = 0; ks < 8; ++ks) { const int k0 = (16 * ks + 8 * g) * 2;
                        aT = mfma32(*(const LAS bf16x8*)(lds + KPN + q * 272 + k0), *(const LAS bf16x8*)(lds + QP + q * 272 + k0), aT); }
#pragma unroll
                    for (int i = 0; i < 16; ++i) { const int s = (i & 3) + 8 * (i >> 2) + 4 * g; if (s > q) aT[i] = 0.f; }
#pragma unroll
                    for (int t2 = 0; t2 < 2; ++t2) {
                        u32x4 pw; pw.x = pk2(aT[8 * t2 + 0], aT[8 * t2 + 1]); pw.y = pk2(aT[8 * t2 + 2], aT[8 * t2 + 3]); pw.z = pk2(aT[8 * t2 + 4], aT[8 * t2 + 5]); pw.w = pk2(aT[8 * t2 + 6], aT[8 * t2 + 7]);
                        const int so = (16 * t2 + 4 * g) * 2;
                        const u32x2 lo = *(const LAS u32x2*)(lds + VTT + (32 * vb + q) * 80 + so), hi = *(const LAS u32x2*)(lds + VTT + (32 * vb + q) * 80 + so + 16);
                        const u32x4 av = (u32x4){lo.x, lo.y, hi.x, hi.y};
                        oT = mfma32(__builtin_bit_cast(bf16x8, av), __builtin_bit_cast(bf16x8, pw), oT); }
                }
#pragma unroll
                for (int qd = 0; qd < 4; ++qd) *(LAS f32x4*)(lds + OPART + kh * 16896 + q * 528 + (32 * vb + 8 * qd + 4 * g) * 4) = (f32x4){oT[4 * qd], oT[4 * qd + 1], oT[4 * qd + 2], oT[4 * qd + 3]};
            }
#pragma unroll
            for (int t2 = 0; t2 < 2; ++t2) { const int so = (16 * t2 + 8 * g) * 2; const bf16x8 bv = *(const LAS bf16x8*)(lds + VTT + (32 * vb + q) * 80 + so);
                st0 = mfma32(*(const LAS bf16x8*)(lds + KPT + (32 * (2 * kh) + q) * 80 + so), bv, st0);
                st1 = mfma32(*(const LAS bf16x8*)(lds + KPT + (32 * (2 * kh + 1) + q) * 80 + so), bv, st1); }
#pragma unroll
            for (int qd = 0; qd < 4; ++qd) { const f32x4 e0 = *(const LAS f32x4*)(lds + ELAST + (32 * (2 * kh) + 8 * qd + 4 * g) * 4), e1 = *(const LAS f32x4*)(lds + ELAST + (32 * (2 * kh + 1) + 8 * qd + 4 * g) * 4);
#pragma unroll
                for (int e = 0; e < 4; ++e) { st0[4 * qd + e] *= e0[e]; st1[4 * qd + e] *= e1[e]; } }
            __syncthreads();
            {
                const LAS float* o0p = (const LAS float*)(lds + OPART + dt * 528 + dpart * 32); const LAS float* o1p = (const LAS float*)(lds + OPART + 16896 + dt * 528 + dpart * 32);
                const f32x4 a0 = *(const LAS f32x4*)o0p + *(const LAS f32x4*)o1p, a1 = *(const LAS f32x4*)(o0p + 4) + *(const LAS f32x4*)(o1p + 4);
                float ss = (a0[0] * a0[0] + a0[1] * a0[1]) + (a0[2] * a0[2] + a0[3] * a0[3]) + (a1[0] * a1[0] + a1[1] * a1[1]) + (a1[2] * a1[2] + a1[3] * a1[3]);
                ss += __shfl_xor(ss, 1); ss += __shfl_xor(ss, 2); ss += __shfl_xor(ss, 4); ss += __shfl_xor(ss, 8);
                const float rstd = 1.0f / sqrtf(ss * (1.f / 128.f) + RMS_EPS);
                const f32x4 r0 = a0 * rstd * gn0, r1 = a1 * rstd * gn1;
                u32x4 w;
                w.x = pk2(r0[0] * bf2f((unsigned short)(gsv.x & 0xffff)), r0[1] * bf2f((unsigned short)(gsv.x >> 16)));
                w.y = pk2(r0[2] * bf2f((unsigned short)(gsv.y & 0xffff)), r0[3] * bf2f((unsigned short)(gsv.y >> 16)));
                w.z = pk2(r1[0] * bf2f((unsigned short)(gsv.z & 0xffff)), r1[1] * bf2f((unsigned short)(gsv.z >> 16)));
                w.w = pk2(r1[2] * bf2f((unsigned short)(gsv.w & 0xffff)), r1[3] * bf2f((unsigned short)(gsv.w >> 16)));
                *(u32x4*)(OG + dbase + (size_t)c * 32 * 1024) = w;
            }
        }
    }
}

constexpr int N_PHASES = 34;
template <class Epi>
__device__ __forceinline__ void run_gemm(LAS unsigned char* lds, const bf16_t* A, const bf16_t* Bt, int N, int K, const Epi& E) {
    asm volatile("" : "+s"(K), "+s"(N));
    pg8::Gemm g{A, Bt, M_TOK, N, K}; pg8::StaticOrder S; S.init(M_TOK, N, mk_grid(), mk_bid());
    pg8::gemm_phase<Epi, pg8::StaticOrder, true, true>((PG8_LAS unsigned char*)lds, g, S, E);
}

template <class Epi>
__device__ __forceinline__ void run_gemm_t(LAS unsigned char* lds, const bf16_t* A, const bf16_t* Bt, int K, const Epi& E) {
    asm volatile("" : "+s"(K));
    pg8::Gemm g{A, Bt, 1024, M_TOK, K}; pg8::StaticOrder S; S.init(1024, M_TOK, mk_grid(), mk_bid());
    pg8::gemm_phase<Epi, pg8::StaticOrder, true, true>((PG8_LAS unsigned char*)lds, g, S, E);
}

__global__ void __launch_bounds__(512, 2) fwd_megakernel(Params p) {
    extern __shared__ __attribute__((aligned(16))) unsigned char lds_raw[];
    LAS unsigned char* lds = (LAS unsigned char*)lds_raw;
    cg::grid_group grid = cg::this_grid();
    const int ph_lo = p.ph_lo, ph_hi = p.ph_hi;
    if (mk_tid() < 16) ((volatile LAS unsigned*)(lds + 131072))[mk_tid()] = 0u;
    __syncthreads();
    const XcdBarrier bar = xcd_barrier_post((unsigned*)(p.ws + WS_BAR), (volatile LAS unsigned*)(lds + 131072));
#pragma unroll 1
    for (int ph = ph_lo; ph < ph_hi; ++ph) {
        unsigned long long kptr = (unsigned long long)__builtin_amdgcn_kernarg_segment_ptr(); asm volatile("" : "+s"(kptr));
        const ParamsPtr pp = (ParamsPtr)kptr;
#define p (*pp)
        unsigned char* ws = p.ws;
        float* MOD = (float*)(ws + WS_MOD); const float* TAB = (const float*)(ws + WS_TAB); const float* LB = (const float*)(ws + WS_LB);
        bf16_t* H = (bf16_t*)(ws + WS_H); float* RS = (float*)(ws + WS_RS);
        int kind, layer = 0;
        if (ph == 0) kind = 0; else if (ph == 1) kind = 1;
        else { const int qq = ph - 2, pair = qq >> 4, r = qq & 15;
            if (r < 9) { layer = 2 * pair; kind = (r < 6) ? 2 + r : 8 + (r - 6); if (r == 5) kind = 7; }
            else { layer = 2 * pair + 1; const int r2 = r - 9; kind = (r2 == 0) ? 11 : (r2 == 1) ? 12 : (r2 == 2) ? 6 : (r2 == 3) ? 7 : 8 + (r2 - 4); } }
        const int j = layer >> 1;
        switch (kind) {
        case 0:
#if defined(PROBE_DUP_PRO)
            prologue_phase(pp, lds); __syncthreads();
#endif
            prologue_phase(pp, lds); break;
        case 1:
#if defined(PROBE_DUP_NORM0)
            norm_phase(p.x, p.X, false, false, nullptr, nullptr, RS, true, MOD, H); norm_phase(p.x, p.X, false, false, nullptr, nullptr, RS, true, MOD, H); norm_phase(p.x, p.X, false, false, nullptr, nullptr, RS, true, MOD, H); norm_phase(p.x, p.X, false, false, nullptr, nullptr, RS, true, MOD, H);
#endif
            norm_phase(p.x, p.X, false, false, nullptr, nullptr, RS, true, MOD, H); break;
        case 2: { EpiProj E{(float*)(ws + R_PROJ), 1056, 1056}; run_gemm(lds, H, (const bf16_t*)(ws + W_MWIN) + (size_t)j * 1280 * 1024, 1280, 1024, E); } break;
        case 3: latnorm_phase((const float*)(ws + R_PROJ), p.mla_qn + j * 768, p.mla_kvn + j * 256, TAB, (bf16_t*)(ws + R_LATQ), (bf16_t*)(ws + R_LATKV), (bf16_t*)(ws + R_KR)); break;
        case 4: { EpiQ Eq{(bf16_t*)(ws + R_Q), TAB}; run_gemm(lds, (const bf16_t*)(ws + R_LATQ), (const bf16_t*)(ws + W_MWQB) + (size_t)j * 1536 * 768, 1536, 768, Eq);
                  const bf16_t* Wkv = (const bf16_t*)(ws + W_MWKVB) + (size_t)j * 2048 * 256;
                  EpiBf16 Ek{(bf16_t*)(ws + R_KN), 1024}; run_gemm(lds, (const bf16_t*)(ws + R_LATKV), Wkv, 1024, 256, Ek);
                  EpiVT Ev{(bf16_t*)(ws + R_VT)}; run_gemm_t(lds, Wkv + (size_t)1024 * 256, (const bf16_t*)(ws + R_LATKV), 256, Ev); } break;
        case 5:
#if defined(PROBE_DUP_ATTN)
            attn_phase(lds, (const bf16_t*)(ws + R_Q), (const bf16_t*)(ws + R_KN), (const bf16_t*)(ws + R_KR), (const bf16_t*)(ws + R_VT), (bf16_t*)(ws + R_O));
#endif
            attn_phase(lds, (const bf16_t*)(ws + R_Q), (const bf16_t*)(ws + R_KN), (const bf16_t*)(ws + R_KR), (const bf16_t*)(ws + R_VT), (bf16_t*)(ws + R_O)); break;
        case 6: { const bool mla = (layer & 1) == 0; const int pl = layer > 0 ? 2 * layer - 1 : 0;
                  EpiResid E{layer == 0 ? p.x : (const float*)p.X, p.X, MOD + (size_t)(2 * layer) * 16 * 3072, RS, p.ln_g + (size_t)pl * 1024, p.ln_b + (size_t)pl * 1024, layer == 0 ? 1 : 0};
                  const bf16_t* A = mla ? (const bf16_t*)(ws + R_O) : (const bf16_t*)H;
                  const bf16_t* Bt = mla ? (const bf16_t*)(ws + W_MWO) + (size_t)j * 1024 * 1024 : (const bf16_t*)(ws + W_HWO) + (size_t)j * 1024 * 1024;
                  run_gemm(lds, A, Bt, 1024, 1024, E); } break;
        case 7: norm_phase(p.X, p.X, true, false, p.ln_g + (size_t)(2 * layer) * 1024, p.ln_b + (size_t)(2 * layer) * 1024, RS, true, MOD + (size_t)(2 * layer + 1) * 16 * 3072, H); break;
        case 8: { EpiSwiGLU E{(bf16_t*)(ws + R_T)};
#if defined(PROBE_DUP_G4)
            run_gemm(lds, H, (const bf16_t*)(ws + W_FWIN) + (size_t)layer * 5632 * 1024, 5632, 1024, E);
#endif
            run_gemm(lds, H, (const bf16_t*)(ws + W_FWIN) + (size_t)layer * 5632 * 1024, 5632, 1024, E); } break;
        case 9: { EpiResid E{p.X, p.X, MOD + (size_t)(2 * layer + 1) * 16 * 3072, RS, p.ln_g + (size_t)(2 * layer) * 1024, p.ln_b + (size_t)(2 * layer) * 1024, 0}; run_gemm(lds, (const bf16_t*)(ws + R_T), (const bf16_t*)(ws + W_FWOUT) + (size_t)layer * 1024 * FF, 1024, FF, E); } break;
        case 10: norm_phase(p.X, p.X, true, layer == 3, p.ln_g + (size_t)(2 * layer + 1) * 1024, p.ln_b + (size_t)(2 * layer + 1) * 1024, RS, layer < 3, MOD + (size_t)(2 * layer + 2) * 16 * 3072, H); break;
        case 11: { EpiHgrnIn E{(bf16_t*)(ws + R_QS), (float*)(ws + R_LOGF), LB + j * 1024};
                   run_gemm(lds, H, (const bf16_t*)(ws + W_HWIN) + (size_t)j * 4096 * 1024, 4096, 1024, E); } break;
        case 12:
#if defined(PROBE_DUP_REC)
            hgrn_phase(lds, (const bf16_t*)(ws + R_QS), (const float*)(ws + R_LOGF), (const bf16_t*)(ws + R_VV), (const bf16_t*)(ws + R_GS), p.hgrn_gn + j * 128, H);
#endif
            hgrn_phase(lds, (const bf16_t*)(ws + R_QS), (const float*)(ws + R_LOGF), (const bf16_t*)(ws + R_VV), (const bf16_t*)(ws + R_GS), p.hgrn_gn + j * 128, H); break;
        default: break;
        }
        if (ph + 1 < ph_hi) { if (ph == ph_lo) grid.sync(); else xcd_barrier(bar); }
#if defined(PROBE_DUP_SYNC)
        if (ph + 1 < ph_hi) { xcd_barrier(bar); xcd_barrier(bar); xcd_barrier(bar); xcd_barrier(bar); }
#endif
#undef p
    }
}

#ifndef MK_MULTI
#define MK_MULTI 0
#endif
extern "C" void kernel_launch(void* const* d_in, const int* in_sizes, int n_in, void* d_out, int out_size, void* d_ws, size_t ws_size, hipStream_t stream) {
    static int grid = 0;
    if (grid == 0) {
        if (n_in != 19 || out_size != M_TOK * DM || ws_size < WS_END) { fprintf(stderr, "kernel_launch: unexpected sizes: n_in %d out %d ws %zu (need %zu)\n", n_in, out_size, ws_size, (size_t)WS_END); grid = -1; return; }
        int dev = 0, cus = 0, per_cu = 0;
        hipGetDevice(&dev); hipDeviceGetAttribute(&cus, hipDeviceAttributeMultiprocessorCount, dev);
        if (hipFuncSetAttribute((const void*)fwd_megakernel, hipFuncAttributeMaxDynamicSharedMemorySize, LDS_BYTES) != hipSuccess) { fprintf(stderr, "kernel_launch: hipFuncSetAttribute failed\n"); grid = -1; return; }
        hipOccupancyMaxActiveBlocksPerMultiprocessor(&per_cu, (const void*)fwd_megakernel, 512, LDS_BYTES);
        (void)hipGetLastError();
        if (per_cu < 1) per_cu = 1;
        grid = cus * 1;
        fprintf(stderr, "kernel_launch: cus %d per_cu %d grid %d\n", cus, per_cu, grid);
    }
    if (grid < 0) return;
    if (hipMemsetAsync((char*)d_ws + WS_BAR, 0, XCD_BAR_WORDS * 4, stream) != hipSuccess) { fprintf(stderr, "kernel_launch: memset failed\n"); return; }
    Params p{};
    p.x = (const float*)d_in[0]; p.c = (const float*)d_in[1]; p.pos = (const int*)d_in[2];
    p.mla_qn = (const float*)d_in[4]; p.mla_kvn = (const float*)d_in[6]; p.hgrn_lb = (const float*)d_in[9]; p.hgrn_gn = (const float*)d_in[11];
    p.ada_w = (const float*)d_in[15]; p.ada_b = (const float*)d_in[16]; p.ln_g = (const float*)d_in[17]; p.ln_b = (const float*)d_in[18];
    p.X = (float*)d_out; p.ws = (unsigned char*)d_ws;
    p.wsrc[0] = (const float*)d_in[3]; p.wsrc[1] = (const float*)d_in[5]; p.wsrc[2] = (const float*)d_in[7]; p.wsrc[3] = (const float*)d_in[8];
    p.wsrc[4] = (const float*)d_in[10]; p.wsrc[5] = (const float*)d_in[12]; p.wsrc[6] = (const float*)d_in[13]; p.wsrc[7] = (const float*)d_in[14];
    for (int i = 0; i < 16; ++i) p.invf[i] = (float)pow(10000.0, -(double)i / 16.0);
#if MK_MULTI
    for (int ph = 0; ph < N_PHASES; ++ph) { p.ph_lo = ph; p.ph_hi = ph + 1; hipLaunchKernelGGL(fwd_megakernel, dim3(grid), dim3(512), LDS_BYTES, stream, p); }
#else
    p.ph_lo = 0; p.ph_hi = N_PHASES;
    void* args[] = {&p};
    hipError_t e = hipLaunchCooperativeKernel((const void*)fwd_megakernel, dim3(grid), dim3(512), args, LDS_BYTES, stream);
    if (e != hipSuccess) fprintf(stderr, "cooperative launch failed: %s (grid %d)\n", hipGetErrorString(e), grid);
#endif
}
```

```cpp
#include <hip/hip_runtime.h>
#include <hip/hip_cooperative_groups.h>
#include <cstdio>
#include <cstdint>
#include <cmath>
namespace cg = cooperative_groups;

__device__ __forceinline__ int mk_tid() { int t = (int)threadIdx.x; asm volatile("" : "+v"(t)); return t; }
__device__ __forceinline__ int mk_bid() { int t = (int)blockIdx.x; asm volatile("" : "+s"(t)); return t; }
__device__ __forceinline__ int mk_grid() { int t = (int)gridDim.x; asm volatile("" : "+s"(t)); return t; }
namespace pg8 {
#define PG8_LAS __attribute__((address_space(3)))
typedef unsigned short bf16_t;
typedef short bf16x8 __attribute__((ext_vector_type(8)));
typedef float f32x4 __attribute__((ext_vector_type(4)));
typedef unsigned u32x4 __attribute__((ext_vector_type(4)));
constexpr int BM = 256, BK = 64, HALF = 128, HTB = HALF * BK * 2  , STAGE_BYTES = 8 * HTB, NXCD = 8, WGM = 8;

__host__ __device__ __forceinline__ int lds_byte(int r, int c) { const int st = (r >> 4) * 2 + (c >> 5), rr = r & 15, cc = c & 31, ob = rr * 64 + cc * 2; return st * 1024 + (ob ^ (((ob >> 9) & 1) << 5)); }
__host__ __device__ __forceinline__ void stage_rc(int b, int& R, int& C) { const int st = b / 1024, sb = b % 1024, swz = sb ^ (((sb >> 9) & 1) << 5); R = (st >> 1) * 16 + swz / 64; C = (st & 1) * 32 + (swz % 64) / 2; }
__host__ __device__ __forceinline__ int perm32(int rho) { const int n = rho >> 4, i = rho & 15; return 8 * (i >> 2) + 4 * n + (i & 3); }

struct Unit { int pm, pn; };
struct Gemm { const bf16_t* A; const bf16_t* Bt; int M, N, K; };

struct StaticOrder {
    int nM, nN, nwg, G, c;
    __host__ __device__ void init(int M, int N, int G_, int c_) { nM = M / BM; nN = N / BM; nwg = nM * nN; G = G_; c = c_; }
    __host__ __device__ bool next(int i, Unit& u) const {
        const long L = (long)i * G + c; if (L >= nwg) return false;
        int wgid = (int)L; { const int q = nwg / NXCD, r = nwg % NXCD, xcd = wgid % NXCD, off = wgid / NXCD; wgid = (xcd < r ? xcd * (q + 1) : r * (q + 1) + (xcd - r) * q) + off; }
        const int nig = WGM * nN, gid = wgid / nig, fm = gid * WGM, gsz = (nM - fm) < WGM ? (nM - fm) : WGM;
        u.pm = fm + ((wgid % nig) % gsz); u.pn = (wgid % nig) / gsz; return true;
    }
    __device__ __forceinline__ void a_ready(const Unit&) const {}
    __device__ __forceinline__ void done(const Unit&) const {}
};

__device__ __forceinline__ unsigned cvt_pk_bf16(float lo, float hi) { unsigned r; asm volatile("v_cvt_pk_bf16_f32 %0, %1, %2" : "=v"(r) : "v"(lo), "v"(hi)); return r; }
template <class Epi, class Sched, bool ALIGN_EPI = false, bool SP2 = false>
__device__ __forceinline__ void gemm_phase(PG8_LAS unsigned char* lds, const Gemm g, const Sched& S, const Epi& E) {
    const int tid = mk_tid(), wid = __builtin_amdgcn_readfirstlane(tid >> 6), lane = tid & 63, wr = wid >> 2, wc = wid & 3, fr = lane & 15, fq = lane >> 4;
    const int K = g.K, nt = K / BK;
    unsigned voffA[2], voffB[2];
#pragma unroll
    for (int i = 0; i < 2; ++i) { int R, C; stage_rc(tid * 16 + i * 8192, R, C); const int Rb = Epi::PERM ? ((R & ~31) + perm32(R & 31)) : R;
        voffA[i] = (unsigned)(R * K + C) * 2u; voffB[i] = (unsigned)(Rb * K + C) * 2u; }
    const size_t kstep = (size_t)(BK * 2);
    const size_t hstep = (size_t)HALF * K * 2;
    const size_t tstep = 2 * hstep;
    const unsigned ldsw = (unsigned)wid * 1024u;
    const int aoff = lds_byte(wr * 64 + fr, fq * 8), boff = lds_byte(wc * 32 + fr, fq * 8);
#define PG8_SA(b, h) (((b) * 2 + (h)) * HTB)
#define PG8_SB(b, h) ((4 + (b) * 2 + (h)) * HTB)
#define PG8_STAGE(bufoff, gbase, voff) do { _Pragma("unroll") for (int _i = 0; _i < 2; ++_i) \
        __builtin_amdgcn_global_load_lds((const unsigned*)((const char*)(gbase) + (voff)[_i]), (PG8_LAS unsigned*)(lds + (bufoff) + ldsw + _i * 8192), 16, 0, 0); } while (0)
#define PG8_LDA(dst, b, h) do { _Pragma("unroll") for (int m = 0; m < 4; ++m) _Pragma("unroll") for (int k = 0; k < 2; ++k) dst[m][k] = *(const PG8_LAS bf16x8*)(lds + PG8_SA(b, h) + aoff + m * 2048 + k * 1024); } while (0)
#define PG8_LDB(dst, b, h) do { _Pragma("unroll") for (int n = 0; n < 2; ++n) _Pragma("unroll") for (int k = 0; k < 2; ++k) dst[n][k] = *(const PG8_LAS bf16x8*)(lds + PG8_SB(b, h) + boff + n * 2048 + k * 1024); } while (0)
#define PG8_MMA(ai, bj, At, Bt) do { __builtin_amdgcn_s_setprio(1); _Pragma("unroll") for (int m = 0; m < 4; ++m) _Pragma("unroll") for (int n = 0; n < 2; ++n) _Pragma("unroll") for (int k = 0; k < 2; ++k) \
        acc[ai][bj][m][n] = __builtin_amdgcn_mfma_f32_16x16x32_bf16(Bt[n][k], At[m][k], acc[ai][bj][m][n], 0, 0, 0); __builtin_amdgcn_s_setprio(0); } while (0)
#define PG8_WAIT_V(n) asm volatile("s_waitcnt vmcnt(" #n ")" ::: "memory")
#define PG8_WAIT_L(n) asm volatile("s_waitcnt lgkmcnt(" #n ")" ::: "memory")
#define PG8_BAR __builtin_amdgcn_s_barrier()
#define PG8_SCHED __builtin_amdgcn_sched_barrier(0)
    Unit cur, nxt; int ui = 0;
    if (!S.next(0, cur)) return;
    f32x4 acc[2][2][4][2];
#pragma unroll
    for (int a = 0; a < 2; ++a)
#pragma unroll
        for (int b = 0; b < 2; ++b)
#pragma unroll
            for (int m = 0; m < 4; ++m)
#pragma unroll
                for (int n = 0; n < 2; ++n) acc[a][b][m][n] = (f32x4){0.f, 0.f, 0.f, 0.f};
    bf16x8 At[4][2], B0[2][2], B1[2][2];
    const char* cA = (const char*)g.A + (size_t)cur.pm * tstep; const char* cB = (const char*)g.Bt + (size_t)cur.pn * tstep;
    S.a_ready(cur);
    if constexpr (SP2) {
        PG8_STAGE(PG8_SB(0, 0), cB, voffB); PG8_STAGE(PG8_SB(0, 1), cB + hstep, voffB); PG8_STAGE(PG8_SA(0, 0), cA, voffA); PG8_STAGE(PG8_SA(0, 1), cA + hstep, voffA);
        if (wr == 1) PG8_BAR;
        PG8_WAIT_V(2); PG8_BAR;
        PG8_STAGE(PG8_SB(1, 0), cB + kstep, voffB); PG8_STAGE(PG8_SA(1, 0), cA + kstep, voffA); PG8_STAGE(PG8_SB(1, 1), cB + hstep + kstep, voffB);
        PG8_WAIT_V(6); PG8_BAR;
    } else {
        PG8_STAGE(PG8_SB(0, 0), cB, voffB); PG8_STAGE(PG8_SA(0, 0), cA, voffA); PG8_STAGE(PG8_SB(0, 1), cB + hstep, voffB); PG8_STAGE(PG8_SA(0, 1), cA + hstep, voffA);
        if (wr == 1) PG8_BAR;
        PG8_WAIT_V(4); PG8_BAR;
        PG8_STAGE(PG8_SB(1, 0), cB + kstep, voffB); PG8_STAGE(PG8_SA(1, 0), cA + kstep, voffA); PG8_STAGE(PG8_SB(1, 1), cB + hstep + kstep, voffB);
        PG8_WAIT_V(6); PG8_BAR;
    }
    for (;;) {
        const bool has_next = S.next(ui + 1, nxt);
        const char* nA = has_next ? (const char*)g.A + (size_t)nxt.pm * tstep : cA; const char* nB = has_next ? (const char*)g.Bt + (size_t)nxt.pn * tstep : cB;
        for (int t = 0; t < nt; t += 2) {
            const bool last = (t == nt - 2);
            const char* a1 = cA + (size_t)(t + 1) * kstep;
            const char* a2 = last ? nA : cA + (size_t)(t + 2) * kstep; const char* b2 = last ? nB : cB + (size_t)(t + 2) * kstep;
            const char* a3 = a2 + kstep; const char* b3 = b2 + kstep;
            if (last && has_next) S.a_ready(nxt);
            if constexpr (SP2) {
            PG8_LDB(B0, 0, 0); PG8_LDB(B1, 0, 1); PG8_SCHED; PG8_LDA(At, 0, 0); PG8_STAGE(PG8_SA(1, 1), a1 + hstep, voffA);
            PG8_WAIT_V(8); PG8_WAIT_L(0); PG8_BAR; PG8_MMA(0, 0, At, B0); PG8_MMA(0, 1, At, B1); PG8_BAR; PG8_SCHED;
            PG8_LDA(At, 0, 1); PG8_STAGE(PG8_SB(0, 0), b2, voffB); PG8_STAGE(PG8_SB(0, 1), b2 + hstep, voffB); PG8_STAGE(PG8_SA(0, 0), a2, voffA);
            PG8_WAIT_V(8); PG8_WAIT_L(0); PG8_BAR; PG8_MMA(1, 0, At, B0); PG8_MMA(1, 1, At, B1); PG8_BAR; PG8_SCHED;
            PG8_LDB(B0, 1, 0); PG8_LDB(B1, 1, 1); PG8_SCHED; PG8_LDA(At, 1, 0); PG8_STAGE(PG8_SA(0, 1), a2 + hstep, voffA);
            PG8_WAIT_V(8); PG8_WAIT_L(0); PG8_BAR; PG8_MMA(0, 0, At, B0); PG8_MMA(0, 1, At, B1); PG8_BAR; PG8_SCHED;
            PG8_LDA(At, 1, 1); PG8_STAGE(PG8_SB(1, 0), b3, voffB); PG8_STAGE(PG8_SB(1, 1), b3 + hstep, voffB); PG8_STAGE(PG8_SA(1, 0), a3, voffA);
            PG8_WAIT_V(8); PG8_WAIT_L(0); PG8_BAR; PG8_MMA(1, 0, At, B0); PG8_MMA(1, 1, At, B1); PG8_BAR; PG8_SCHED;
            } else {
            PG8_LDB(B0, 0, 0); PG8_SCHED; PG8_LDA(At, 0, 0); PG8_STAGE(PG8_SA(1, 1), a1 + hstep, voffA);
            PG8_WAIT_L(8); PG8_BAR; PG8_WAIT_L(0); PG8_MMA(0, 0, At, B0); PG8_BAR; PG8_SCHED;
            PG8_LDB(B1, 0, 1); PG8_STAGE(PG8_SB(0, 0), b2, voffB);
            PG8_BAR; PG8_WAIT_L(0); PG8_MMA(0, 1, At, B1); PG8_BAR;
            PG8_LDA(At, 0, 1); PG8_STAGE(PG8_SA(0, 0), a2, voffA);
            PG8_BAR; PG8_WAIT_L(0); PG8_MMA(1, 0, At, B0); PG8_BAR; PG8_SCHED;
            PG8_STAGE(PG8_SB(0, 1), b2 + hstep, voffB);
            PG8_WAIT_V(6); PG8_BAR; PG8_MMA(1, 1, At, B1); PG8_BAR;
            PG8_LDB(B0, 1, 0); PG8_SCHED; PG8_LDA(At, 1, 0); PG8_STAGE(PG8_SA(0, 1), a2 + hstep, voffA);
            PG8_WAIT_L(8); PG8_BAR; PG8_WAIT_L(0); PG8_MMA(0, 0, At, B0); PG8_BAR; PG8_SCHED;
            PG8_LDB(B1, 1, 1); PG8_STAGE(PG8_SB(1, 0), b3, voffB);
            PG8_BAR; PG8_WAIT_L(0); PG8_MMA(0, 1, At, B1); PG8_BAR;
            PG8_LDA(At, 1, 1); PG8_STAGE(PG8_SA(1, 0), a3, voffA);
            PG8_BAR; PG8_WAIT_L(0); PG8_MMA(1, 0, At, B0); PG8_BAR; PG8_SCHED;
            PG8_STAGE(PG8_SB(1, 1), b3 + hstep, voffB);
            PG8_WAIT_V(6); PG8_BAR; PG8_MMA(1, 1, At, B1); PG8_BAR;
            }
        }
        if constexpr (ALIGN_EPI) { if (wr == 0) PG8_BAR; }
        if constexpr (!Epi::AFTER_DRAIN) { E(acc, cur, wr, wc, fr, fq); S.done(cur); }
        if (!has_next) break;
#pragma unroll
        for (int a = 0; a < 2; ++a)
#pragma unroll
            for (int b = 0; b < 2; ++b)
#pragma unroll
                for (int m = 0; m < 4; ++m)
#pragma unroll
                    for (int n = 0; n < 2; ++n) acc[a][b][m][n] = (f32x4){0.f, 0.f, 0.f, 0.f};
        cur = nxt; cA = nA; cB = nB; ++ui;
        if constexpr (ALIGN_EPI) { if (wr == 1) PG8_BAR; }
    }
    PG8_WAIT_V(0);
    if constexpr (!ALIGN_EPI) { if (wr == 0) PG8_BAR; }
    PG8_BAR;
    if constexpr (Epi::AFTER_DRAIN) { E.fused(acc, cur, wr, wc, fr, fq, lds, wid, lane); S.done(cur); }
#undef PG8_SA
#undef PG8_SB
#undef PG8_STAGE
#undef PG8_LDA
#undef PG8_LDB
#undef PG8_MMA
#undef PG8_WAIT_V
#undef PG8_WAIT_L
#undef PG8_BAR
#undef PG8_SCHED
}
}

#define LAS __attribute__((address_space(3)))
typedef unsigned short bf16_t;
typedef short bf16x8 __attribute__((ext_vector_type(8)));
typedef short bf16x4 __attribute__((ext_vector_type(4)));
typedef float f32x4 __attribute__((ext_vector_type(4)));
typedef float f32x16 __attribute__((ext_vector_type(16)));
typedef unsigned u32x4 __attribute__((ext_vector_type(4)));
typedef unsigned u32x2 __attribute__((ext_vector_type(2)));

constexpr int M_TOK = 32768, DM = 1024, SEQ = 2048, NB = 16;
constexpr int FF = 2816;
constexpr float ALPHA = 1.681792830507429f;
constexpr float LN_EPS = 1e-5f, RMS_EPS = 1e-6f;
constexpr float QSCALE = 0.10206207261596575f * 1.4426950408889634f;

constexpr size_t MiB = 1u << 20;
constexpr size_t WS_MOD = 0, WS_LB = 3 * MiB / 2, WS_TAB = 2 * MiB;
constexpr size_t W_MWIN = 6 * MiB, W_MWQB = 11 * MiB, W_MWKVB = 31 * MiB / 2, W_MWO = 35 * MiB / 2, W_HWIN = 43 * MiB / 2, W_HWO = 75 * MiB / 2,
                 W_FWIN = 83 * MiB / 2, W_FWOUT = 171 * MiB / 2;
constexpr size_t WS_H = 108 * MiB, WS_R = 172 * MiB;
constexpr size_t R_T = WS_R, R_PROJ = WS_R, R_Q = WS_R, R_LATQ = WS_R + 132 * MiB, R_LATKV = WS_R + 180 * MiB, R_O = WS_R + 132 * MiB,
                 R_KR = WS_R + 196 * MiB, R_KN = WS_R + 198 * MiB, R_VT = WS_R + 262 * MiB;
constexpr size_t R_QS = WS_R, R_LOGF = WS_R + 64 * MiB, R_VV = WS_R + 192 * MiB, R_GS = WS_R + 256 * MiB;
constexpr size_t WS_END = WS_R + 326 * MiB;
constexpr int LDS_BYTES = 131072 + 64;
constexpr size_t WS_BAR = WS_LB + 65536;
constexpr size_t WS_RS = WS_LB + 131072;

struct Params {
    const float* x; const float* c; const int* pos;
    const float* mla_qn; const float* mla_kvn; const float* hgrn_lb; const float* hgrn_gn;
    const float* ada_w; const float* ada_b; const float* ln_g; const float* ln_b;
    float* X; unsigned char* ws;
    const float* wsrc[8];
    float invf[16];
    int ph_lo, ph_hi;
};
typedef const __attribute__((address_space(4))) Params* ParamsPtr;
struct WType { int K, N, layers, mode; size_t dst; int drows; };
constexpr WType WT[8] = {
    {1024, 1056, 2, 0, W_MWIN, 1280}, {768, 1536, 2, 0, W_MWQB, 1536}, {256, 2048, 2, 2, W_MWKVB, 2048}, {1024, 1024, 2, 0, W_MWO, 1024},
    {1024, 4096, 2, 0, W_HWIN, 4096}, {1024, 1024, 2, 0, W_HWO, 1024}, {1024, 5632, 4, 1, W_FWIN, 5632}, {2816, 1024, 4, 0, W_FWOUT, 1024} };
constexpr int wt_items(int t) { return (WT[t].K / 64) * (WT[t].N / 32); }
constexpr int wt_total() { int s = 0; for (int t = 0; t < 8; ++t) s += wt_items(t) * WT[t].layers; return s; }

__device__ __forceinline__ unsigned pk2(float lo, float hi) { unsigned r; asm volatile("v_cvt_pk_bf16_f32 %0, %1, %2" : "=v"(r) : "v"(lo), "v"(hi)); return r; }
__device__ __forceinline__ float bf2f(unsigned short h) { return __uint_as_float((unsigned)h << 16); }
__device__ __forceinline__ float wave_sum(float v) {
#pragma unroll
    for (int o = 1; o < 64; o <<= 1) v += __shfl_xor(v, o);
    return v;
}
__device__ __forceinline__ float fast_rcp(float x) { return __builtin_amdgcn_rcpf(x); }
__device__ __forceinline__ float sigmoidf_(float x) { return fast_rcp(1.f + __expf(-x)); }
__device__ __forceinline__ float siluf_(float x) { return x * sigmoidf_(x); }
__device__ __forceinline__ int crow(int r, int hi) { return (r & 3) + 8 * (r >> 2) + 4 * hi; }
__device__ __forceinline__ f32x16 mfma32(bf16x8 a, bf16x8 b, f32x16 c) { return __builtin_amdgcn_mfma_f32_32x32x16_bf16(a, b, c, 0, 0, 0); }

struct EpiProj {
    static constexpr bool PERM = false, AFTER_DRAIN = false;
    float* O; int ldc, ncols;
    __device__ __forceinline__ void operator()(const pg8::f32x4 (&acc)[2][2][4][2], const pg8::Unit& u, int wr, int wc, int fr, int fq) const {
        const int row0 = u.pm * 256 + wr * 64 + fr, col0 = u.pn * 256 + wc * 32 + 4 * fq;
#pragma unroll
        for (int ai = 0; ai < 2; ++ai)
#pragma unroll
            for (int m = 0; m < 4; ++m) { float* rp = O + (size_t)(row0 + ai * 128 + m * 16) * ldc;
#pragma unroll
                for (int bj = 0; bj < 2; ++bj)
#pragma unroll
                    for (int n = 0; n < 2; ++n) { const int c = col0 + bj * 128 + n * 16; if (c < ncols) *(f32x4*)(rp + c) = acc[ai][bj][m][n]; } }
    }
};
struct EpiQ {
    static constexpr bool PERM = false, AFTER_DRAIN = false;
    bf16_t* Q; const float* tab;
    __device__ __forceinline__ void operator()(const pg8::f32x4 (&acc)[2][2][4][2], const pg8::Unit& u, int wr, int wc, int fr, int fq) const {
        const int row0 = u.pm * 256 + wr * 64 + fr;
#pragma unroll
        for (int bj = 0; bj < 2; ++bj) {
            const int c0 = u.pn * 256 + bj * 128 + wc * 32; const bool rope = ((c0 >> 5) % 3) == 2;
#pragma unroll
            for (int ai = 0; ai < 2; ++ai)
#pragma unroll
                for (int m = 0; m < 4; ++m) { const int row = row0 + ai * 128 + m * 16;
                    f32x4 v0 = acc[ai][bj][m][0], v1 = acc[ai][bj][m][1];
                    if (rope) { const f32x4 cs = *(const f32x4*)(tab + (size_t)row * 32 + 4 * fq), sn = *(const f32x4*)(tab + (size_t)row * 32 + 16 + 4 * fq);
                        const f32x4 a = v0 * cs - v1 * sn, b = v0 * sn + v1 * cs; v0 = a; v1 = b; }
                    v0 = v0 * QSCALE; v1 = v1 * QSCALE;
                    bf16_t* qp = Q + (size_t)row * 1536 + c0 + 4 * fq;
                    u32x2 w0, w1; w0.x = pk2(v0[0], v0[1]); w0.y = pk2(v0[2], v0[3]); w1.x = pk2(v1[0], v1[1]); w1.y = pk2(v1[2], v1[3]);
                    *(u32x2*)qp = w0; *(u32x2*)(qp + 16) = w1; }
        }
    }
};
struct EpiBf16 {
    static constexpr bool PERM = true, AFTER_DRAIN = false;
    bf16_t* O; int ldc;
    __device__ __forceinline__ void operator()(const pg8::f32x4 (&acc)[2][2][4][2], const pg8::Unit& u, int wr, int wc, int fr, int fq) const {
        const int row0 = u.pm * 256 + wr * 64 + fr, col0 = u.pn * 256 + wc * 32 + 8 * fq;
#pragma unroll
        for (int ai = 0; ai < 2; ++ai)
#pragma unroll
            for (int m = 0; m < 4; ++m) { bf16_t* rp = O + (size_t)(row0 + ai * 128 + m * 16) * ldc + col0;
#pragma unroll
                for (int bj = 0; bj < 2; ++bj) { const f32x4 a0 = acc[ai][bj][m][0], a1 = acc[ai][bj][m][1];
                    u32x4 w; w.x = pk2(a0[0], a0[1]); w.y = pk2(a0[2], a0[3]); w.z = pk2(a1[0], a1[1]); w.w = pk2(a1[2], a1[3]); *(u32x4*)(rp + bj * 128) = w; } }
    }
};
struct EpiVT {
    static constexpr bool PERM = true, AFTER_DRAIN = false;
    bf16_t* VT;
    __device__ __forceinline__ void operator()(const pg8::f32x4 (&acc)[2][2][4][2], const pg8::Unit& u, int wr, int wc, int fr, int fq) const {
        const int row0 = u.pm * 256 + wr * 64 + fr, tok0 = u.pn * 256 + wc * 32 + 8 * fq;
        bf16_t* base = VT + (size_t)(tok0 >> 11) * (1024 * 2048) + (tok0 & 2047);
#pragma unroll
        for (int ai = 0; ai < 2; ++ai)
#pragma unroll
            for (int m = 0; m < 4; ++m) { bf16_t* rp = base + (size_t)(row0 + ai * 128 + m * 16) * 2048;
#pragma unroll
                for (int bj = 0; bj < 2; ++bj) { const f32x4 a0 = acc[ai][bj][m][0], a1 = acc[ai][bj][m][1];
                    u32x4 w; w.x = pk2(a0[0], a0[1]); w.y = pk2(a0[2], a0[3]); w.z = pk2(a1[0], a1[1]); w.w = pk2(a1[2], a1[3]); *(u32x4*)(rp + bj * 128) = w; } }
    }
};
struct EpiResid {
    static constexpr bool PERM = false, AFTER_DRAIN = false;
    const float* Xin; float* Xout; const float* modrow; const float* RS; const float* g; const float* bta; int raw;
    __device__ __forceinline__ void operator()(const pg8::f32x4 (&acc)[2][2][4][2], const pg8::Unit& u, int wr, int wc, int fr, int fq) const {
        const int row0 = u.pm * 256 + wr * 64 + fr, col0 = u.pn * 256 + wc * 32 + 4 * fq;
        const int b = (u.pm * 256) >> 11; const float* gp = modrow + (size_t)b * 3072 + 2048 + col0;
#pragma unroll
        for (int bj = 0; bj < 2; ++bj)
#pragma unroll
            for (int n = 0; n < 2; ++n) {
                const int c = col0 + bj * 128 + n * 16;
                const f32x4 gt = *(const f32x4*)(gp + bj * 128 + n * 16) + 1.0f;
                f32x4 g4 = (f32x4){1.f, 1.f, 1.f, 1.f}, b4 = (f32x4){0.f, 0.f, 0.f, 0.f};
                if (!raw) { g4 = *(const f32x4*)(g + c); b4 = *(const f32x4*)(bta + c); }
#pragma unroll
                for (int ai = 0; ai < 2; ++ai)
#pragma unroll
                    for (int m = 0; m < 4; ++m) { const int row = row0 + ai * 128 + m * 16;
                        f32x4 xo = *(const f32x4*)(Xin + (size_t)row * 1024 + c);
                        if (!raw) { const float mean = RS[2 * row], rstd = RS[2 * row + 1]; xo = (xo - mean) * rstd * g4 + b4; }
                        *(f32x4*)(Xout + (size_t)row * 1024 + c) = xo * ALPHA + gt * acc[ai][bj][m][n]; }
            }
    }
};
struct EpiSwiGLU {
    static constexpr bool PERM = true, AFTER_DRAIN = false;
    bf16_t* T;
    __device__ __forceinline__ void operator()(const pg8::f32x4 (&acc)[2][2][4][2], const pg8::Unit& u, int wr, int wc, int fr, int fq) const {
        const int row0 = u.pm * 256 + wr * 64 + fr, col0 = u.pn * 128 + wc * 32 + 8 * fq;
#pragma unroll
        for (int ai = 0; ai < 2; ++ai)
#pragma unroll
            for (int m = 0; m < 4; ++m) {
                const f32x4 g0 = acc[ai][0][m][0], g1 = acc[ai][0][m][1], u0 = acc[ai][1][m][0], u1 = acc[ai][1][m][1];
                u32x4 w;
                w.x = pk2(siluf_(g0[0]) * u0[0], siluf_(g0[1]) * u0[1]); w.y = pk2(siluf_(g0[2]) * u0[2], siluf_(g0[3]) * u0[3]);
                w.z = pk2(siluf_(g1[0]) * u1[0], siluf_(g1[1]) * u1[1]); w.w = pk2(siluf_(g1[2]) * u1[2], siluf_(g1[3]) * u1[3]);
                *(u32x4*)(T + (size_t)(row0 + ai * 128 + m * 16) * FF + col0) = w; }
    }
};
struct EpiHgrnIn {
    static constexpr bool PERM = true, AFTER_DRAIN = false;
    bf16_t* QS; float* LOGF; const float* lb;
    __device__ __forceinline__ void operator()(const pg8::f32x4 (&acc)[2][2][4][2], const pg8::Unit& u, int wr, int wc, int fr, int fq) const {
        const int row0 = u.pm * 256 + wr * 64 + fr, region = u.pn >> 2, col0 = (u.pn & 3) * 256 + wc * 32 + 8 * fq;
        if (region == 1) {
#pragma unroll
            for (int bj = 0; bj < 2; ++bj) { const f32x4 l0 = *(const f32x4*)(lb + col0 + bj * 128), l1 = *(const f32x4*)(lb + col0 + bj * 128 + 4);
#pragma unroll
                for (int ai = 0; ai < 2; ++ai)
#pragma unroll
                    for (int m = 0; m < 4; ++m) { float* op = LOGF + (size_t)(row0 + ai * 128 + m * 16) * 1024 + col0 + bj * 128;
                        const f32x4 a0 = acc[ai][bj][m][0], a1 = acc[ai][bj][m][1]; f32x4 r0, r1;
#pragma unroll
                        for (int e = 0; e < 4; ++e) { r0[e] = __logf(l0[e] + (1.f - l0[e]) * sigmoidf_(a0[e])); r1[e] = __logf(l1[e] + (1.f - l1[e]) * sigmoidf_(a1[e])); }
                        *(f32x4*)op = r0; *(f32x4*)(op + 4) = r1; } }
        } else {
            bf16_t* base = QS + (size_t)(region == 0 ? 0 : (region == 2 ? (R_VV - R_QS) / 2 : (R_GS - R_QS) / 2)); const bool act = region != 2;
#pragma unroll
            for (int ai = 0; ai < 2; ++ai)
#pragma unroll
                for (int m = 0; m < 4; ++m)
#pragma unroll
                    for (int bj = 0; bj < 2; ++bj) { f32x4 a0 = acc[ai][bj][m][0], a1 = acc[ai][bj][m][1];
                        if (act) {
#pragma unroll
                            for (int e = 0; e < 4; ++e) { a0[e] = siluf_(a0[e]); a1[e] = siluf_(a1[e]); } }
                        u32x4 w; w.x = pk2(a0[0], a0[1]); w.y = pk2(a0[2], a0[3]); w.z = pk2(a1[0], a1[1]); w.w = pk2(a1[2], a1[3]);
                        *(u32x4*)(base + (size_t)(row0 + ai * 128 + m * 16) * 1024 + col0 + bj * 128) = w; }
        }
    }
};

#define XB_TMO      128
#define XB_XCNT(j)  (256  + 64 * (j))
#define XB_XSUB(j)  (1280 + 64 * (j))
#define XB_XGEN(j)  (2304 + 64 * (j))
#define XB_TOP      3328
#define XB_TOPGEN   3392
#define XCD_BAR_WORDS 3456
#define XB_SPIN_CAP (1u << 18)

__device__ __forceinline__ unsigned xb_ld(unsigned* p)              { return __hip_atomic_load(p, __ATOMIC_RELAXED, __HIP_MEMORY_SCOPE_AGENT); }
__device__ __forceinline__ unsigned xb_add(unsigned* p, unsigned v) { return __hip_atomic_fetch_add(p, v, __ATOMIC_RELAXED, __HIP_MEMORY_SCOPE_AGENT); }
__device__ __forceinline__ unsigned xb_xcc_id() { return (unsigned)__builtin_amdgcn_s_getreg((3 << 11) | 20) & 0xFu; }
#define XB_SPIN(cond, bar) do { unsigned _sp = 0; while (cond) { __builtin_amdgcn_s_sleep(1); \
    if ((++_sp & 255u) == 0u) { if (xb_ld(&(bar)[XB_TMO])) break; if (_sp > XB_SPIN_CAP) { atomicAdd(&(bar)[XB_TMO], 1u); break; } } } } while (0)

struct XcdBarrier {
    unsigned* bar; unsigned x;
    volatile LAS unsigned* st;
};

__device__ __forceinline__ XcdBarrier xcd_barrier_post(unsigned* bar, volatile LAS unsigned* st) {
    XcdBarrier b; b.bar = bar; b.x = xb_xcc_id(); b.st = st;
    if (mk_tid() == 0) (void)xb_add(&bar[XB_XCNT(b.x)], 1u);
    return b;
}
__device__ __forceinline__ void xcd_barrier_complete(unsigned* bar, unsigned x, unsigned& nloc, unsigned& nx) {
    const unsigned G = (unsigned)mk_grid();
    unsigned sum, cnt, mine, sp = 0u;
    for (;;) {
        sum = 0u; cnt = 0u; mine = 0u;
#pragma unroll
        for (unsigned j = 0; j < 16; ++j) { const unsigned c = xb_ld(&bar[XB_XCNT(j)]); sum += c; cnt += (c > 0u) ? 1u : 0u; mine = (j == x) ? c : mine; }
        if (sum == G) break;
        __builtin_amdgcn_s_sleep(1);
        if ((++sp & 255u) == 0u) { if (xb_ld(&bar[XB_TMO])) break; if (sp > XB_SPIN_CAP) { atomicAdd(&bar[XB_TMO], 1u); break; } }
    }
    nloc = mine > 0u ? mine : 1u; nx = cnt > 0u ? cnt : 1u;
}

__device__ __forceinline__ void xcd_barrier(const XcdBarrier& b) {
    asm volatile("s_waitcnt vmcnt(0)" ::: "memory");
    __syncthreads();
    if (mk_tid() == 0) {
        unsigned* bar = b.bar;
        __builtin_amdgcn_s_waitcnt(0);
        unsigned nloc = b.st[0], nx = b.st[1];
        if (nloc == 0u) { xcd_barrier_complete(bar, b.x, nloc, nx); b.st[0] = nloc; b.st[1] = nx; }
        const unsigned old = xb_add(&bar[XB_XSUB(b.x)], 1u);
        const unsigned gen = old / nloc;
        if (old + 1u == (gen + 1u) * nloc) {
            __builtin_amdgcn_fence(__ATOMIC_RELEASE, "agent");
            asm volatile("s_waitcnt vmcnt(0)" ::: "memory");
            const unsigned og = xb_add(&bar[XB_TOP], 1u);
            const unsigned tg = og / nx;
            if (og + 1u == (tg + 1u) * nx) xb_add(&bar[XB_TOPGEN], 1u);
            else XB_SPIN(xb_ld(&bar[XB_TOPGEN]) == tg, bar);
            __builtin_amdgcn_fence(__ATOMIC_ACQUIRE, "agent");
            xb_add(&bar[XB_XGEN(b.x)], 1u);
            asm volatile("s_waitcnt vmcnt(0)" ::: "memory");
        } else {
            XB_SPIN(xb_ld(&bar[XB_XGEN(b.x)]) == gen, bar);
            __builtin_amdgcn_fence(__ATOMIC_ACQUIRE, "agent");
            asm volatile("s_waitcnt vmcnt(0)" ::: "memory");
        }
    }
    __syncthreads();
}


__device__ __forceinline__ void transpose_item(const float* W, bf16_t* dst, int K, int N, int mode, int item, LAS float* scr, int lane) {
    const int nblk = N / 32, kb = item / nblk, nb = item % nblk, k0 = 64 * kb, n0 = 32 * nb;
    int drow0 = n0;
    if (mode == 1) { const int up = n0 >= FF, j0 = up ? n0 - FF : n0; drow0 = 256 * (j0 >> 7) + (up ? 128 : 0) + (j0 & 127); }
    if (mode == 2) { const int h = n0 >> 7, r = n0 & 127; drow0 = (r < 64) ? h * 64 + r : 1024 + h * 64 + (r - 64); }
#pragma unroll 8
    for (int i = 0; i < 32; ++i) { const int kk = 2 * i + (lane >> 5); scr[kk * 33 + (lane & 31)] = W[(size_t)(k0 + kk) * N + n0 + (lane & 31)]; }
    asm volatile("s_waitcnt lgkmcnt(0)" ::: "memory");
    const int c = lane & 7;
#pragma unroll
    for (int j = 0; j < 4; ++j) { const int n = (lane >> 3) + 8 * j; const LAS float* s = scr + (8 * c) * 33 + n;
        u32x4 o; o.x = pk2(s[0 * 33], s[1 * 33]); o.y = pk2(s[2 * 33], s[3 * 33]); o.z = pk2(s[4 * 33], s[5 * 33]); o.w = pk2(s[6 * 33], s[7 * 33]);
        *(u32x4*)(dst + (size_t)(drow0 + n) * K + k0 + 8 * c) = o; }
    asm volatile("s_waitcnt lgkmcnt(0)" ::: "memory");
}

__device__ __forceinline__ void prologue_phase(ParamsPtr pp, LAS unsigned char* lds) {
    const ParamsPtr p_ = pp;
#define p (*p_)
    const int tid = mk_tid(), lane = tid & 63, wave = __builtin_amdgcn_readfirstlane(tid >> 6);
    const int G = mk_grid();
    {
        LAS float* sc = (LAS float*)lds;
        LAS float* red = (LAS float*)(lds + 65536);
        for (int i = tid; i < NB * DM; i += 512) { const int b = i >> 10, k = i & 1023; const float v = p.c[i]; sc[k * 16 + b] = v / (1.f + __expf(-v)); }
        __syncthreads();
        float* MOD = (float*)(p.ws + WS_MOD);
        for (int it = mk_bid(); it < 8 * 48; it += G) {
            const int ls = it / 48, n0 = (it % 48) * 64, col = tid & 63, kg = tid >> 6;
            const float* W = p.ada_w + (size_t)ls * 1024 * 3072 + (size_t)(kg * 128) * 3072 + n0 + col;
            float acc[16];
#pragma unroll
            for (int b = 0; b < 16; ++b) acc[b] = 0.f;
#pragma unroll 4
            for (int k = 0; k < 128; ++k) { const float w = W[(size_t)k * 3072]; const LAS f32x4* s4 = (const LAS f32x4*)(sc + (kg * 128 + k) * 16);
#pragma unroll
                for (int q = 0; q < 4; ++q) { const f32x4 s = s4[q]; acc[4 * q + 0] += s[0] * w; acc[4 * q + 1] += s[1] * w; acc[4 * q + 2] += s[2] * w; acc[4 * q + 3] += s[3] * w; } }
#pragma unroll
            for (int q = 0; q < 4; ++q) *(LAS f32x4*)(red + (kg * 64 + col) * 16 + 4 * q) = (f32x4){acc[4 * q], acc[4 * q + 1], acc[4 * q + 2], acc[4 * q + 3]};
            __syncthreads();
            { const int b0 = 2 * kg;
#pragma unroll
              for (int bb = 0; bb < 2; ++bb) { float s = 0.f;
#pragma unroll
                  for (int g = 0; g < 8; ++g) s += red[(g * 64 + col) * 16 + b0 + bb];
                  MOD[((size_t)ls * 16 + b0 + bb) * 3072 + n0 + col] = s + p.ada_b[ls * 3072 + n0 + col]; } }
            __syncthreads();
        }
    }
    if (mk_bid() == 0) {
        float* LB = (float*)(p.ws + WS_LB);
        for (int cidx = tid; cidx < 1024; cidx += 512) { const float a0 = p.hgrn_lb[cidx], a1 = p.hgrn_lb[1024 + cidx], mx = fmaxf(a0, a1);
            const float e0 = expf(a0 - mx), e1 = expf(a1 - mx), s0 = e0 / (e0 + e1), s1 = e1 / (e0 + e1);
            LB[cidx] = s0 - s0; LB[1024 + cidx] = (s0 + s1) - s0; }
    }
    {
        float* TAB = (float*)(p.ws + WS_TAB);
        for (int gi = mk_bid() * 512 + tid; gi < M_TOK * 16; gi += G * 512) {
            const int m = gi >> 4, i = gi & 15; const float ang = (float)p.pos[m] * p.invf[i];
            const double r = (double)ang, q = rint(r * 0.63661977236758134308), t = fma(-q, 1.57079632679489661923, r), t2 = t * t;
            const double s = t * (1.0 + t2 * (-1.0 / 6 + t2 * (1.0 / 120 + t2 * (-1.0 / 5040 + t2 * (1.0 / 362880 + t2 * (-1.0 / 39916800 + t2 * (1.0 / 6227020800.0)))))));
            const double c = 1.0 + t2 * (-0.5 + t2 * (1.0 / 24 + t2 * (-1.0 / 720 + t2 * (1.0 / 40320 + t2 * (-1.0 / 3628800 + t2 * (1.0 / 479001600.0))))));
            const int qi = ((int)q) & 3; double cc, ss;
            if (qi == 0) { cc = c; ss = s; } else if (qi == 1) { cc = -s; ss = c; } else if (qi == 2) { cc = -c; ss = -s; } else { cc = s; ss = -c; }
            TAB[(size_t)m * 32 + i] = (float)cc; TAB[(size_t)m * 32 + 16 + i] = (float)ss; }
    }
    {
        for (int gi = mk_bid() * 512 + tid; gi < 2 * 224 * 128; gi += G * 512) { const int l = gi / (224 * 128), r = gi % (224 * 128);
            *(u32x4*)(p.ws + W_MWIN + (size_t)l * 1280 * 1024 * 2 + (size_t)1056 * 1024 * 2 + (size_t)r * 16) = (u32x4){0u, 0u, 0u, 0u}; }
    }
    __syncthreads();
    {
        LAS float* scr = (LAS float*)(lds + wave * 8448);
        const int gw = mk_bid() * 8 + wave, NGW = G * 8;
        for (int it = gw; it < wt_total(); it += NGW) {
            int r = it;
#pragma unroll
            for (int t = 0; t < 8; ++t) {
                const int ni = wt_items(t) * WT[t].layers;
                if (r >= 0 && r < ni) { const int l = r / wt_items(t), item = r % wt_items(t);
                    transpose_item(p.wsrc[t] + (size_t)l * WT[t].K * WT[t].N, (bf16_t*)(p.ws + WT[t].dst) + (size_t)l * WT[t].drows * WT[t].K, WT[t].K, WT[t].N, WT[t].mode, item, scr, lane); }
                r -= ni;
            }
        }
    }
}

#undef p
__device__ __forceinline__ void norm_phase(const float* src, float* dst, bool do_ln, bool write_x, const float* g, const float* bta, float* RS, bool do_h, const float* modrow, bf16_t* H) {
    const int tid_ = mk_tid(), lane = tid_ & 63, wave = __builtin_amdgcn_readfirstlane(tid_ >> 6); const int gw = mk_bid() * 8 + wave, NGW = mk_grid() * 8;
    for (int m0 = gw * 4; m0 < M_TOK; m0 += NGW * 4) {
        const int b = m0 >> 11;
        f32x4 v[4][4];
#pragma unroll
        for (int r = 0; r < 4; ++r) { const f32x4* xr = (const f32x4*)(src + (size_t)(m0 + r) * 1024) + lane;
#pragma unroll
            for (int j = 0; j < 4; ++j) v[r][j] = xr[64 * j]; }
        if (do_ln) {
            float s[4];
#pragma unroll
            for (int r = 0; r < 4; ++r) { s[r] = 0.f;
#pragma unroll
                for (int j = 0; j < 4; ++j) s[r] += (v[r][j][0] + v[r][j][1]) + (v[r][j][2] + v[r][j][3]); }
#pragma unroll
            for (int o = 1; o < 64; o <<= 1) {
#pragma unroll
                for (int r = 0; r < 4; ++r) s[r] += __shfl_xor(s[r], o); }
            float mean[4], s2[4];
#pragma unroll
            for (int r = 0; r < 4; ++r) { mean[r] = s[r] * (1.f / 1024.f); s2[r] = 0.f;
#pragma unroll
                for (int j = 0; j < 4; ++j) { v[r][j] = v[r][j] - mean[r]; s2[r] += (v[r][j][0] * v[r][j][0] + v[r][j][1] * v[r][j][1]) + (v[r][j][2] * v[r][j][2] + v[r][j][3] * v[r][j][3]); } }
#pragma unroll
            for (int o = 1; o < 64; o <<= 1) {
#pragma unroll
                for (int r = 0; r < 4; ++r) s2[r] += __shfl_xor(s2[r], o); }
#pragma unroll
            for (int r = 0; r < 4; ++r) { const float rstd = 1.0f / sqrtf(s2[r] * (1.f / 1024.f) + LN_EPS);
                if (lane == 0) { RS[2 * (m0 + r)] = mean[r]; RS[2 * (m0 + r) + 1] = rstd; }
#pragma unroll
                for (int j = 0; j < 4; ++j) v[r][j] = v[r][j] * rstd; }
#pragma unroll
            for (int j = 0; j < 4; ++j) { const f32x4 gg = *((const f32x4*)g + lane + 64 * j), bb = *((const f32x4*)bta + lane + 64 * j);
#pragma unroll
                for (int r = 0; r < 4; ++r) v[r][j] = v[r][j] * gg + bb; }
        }
        if (write_x) {
#pragma unroll
            for (int r = 0; r < 4; ++r) { f32x4* xo = (f32x4*)(dst + (size_t)(m0 + r) * 1024) + lane;
#pragma unroll
                for (int j = 0; j < 4; ++j) xo[64 * j] = v[r][j]; } }
        if (do_h) { const f32x4* sh = (const f32x4*)(modrow + (size_t)b * 3072) + lane; const f32x4* sc = (const f32x4*)(modrow + (size_t)b * 3072 + 1024) + lane;
#pragma unroll
            for (int j = 0; j < 4; ++j) { const f32x4 s1 = sc[64 * j] + 1.0f, s0 = sh[64 * j];
#pragma unroll
                for (int r = 0; r < 4; ++r) { const f32x4 h = v[r][j] * s1 + s0; u32x2 w; w.x = pk2(h[0], h[1]); w.y = pk2(h[2], h[3]); *((u32x2*)(H + (size_t)(m0 + r) * 1024) + lane + 64 * j) = w; } } }
    }
}

__device__ __forceinline__ void latnorm_phase(const float* PROJ, const float* qn, const float* kvn, const float* tab, bf16_t* LATQ, bf16_t* LATKV, bf16_t* KR) {
    const int tid_ = mk_tid(), lane = tid_ & 63, wave = __builtin_amdgcn_readfirstlane(tid_ >> 6); const int gw = mk_bid() * 8 + wave, NGW = mk_grid() * 8;
    for (int m = gw; m < M_TOK; m += NGW) {
        const float* pr = PROJ + (size_t)m * 1056;
        f32x4 v[3]; float s = 0.f;
#pragma unroll
        for (int j = 0; j < 3; ++j) { v[j] = *((const f32x4*)pr + lane + 64 * j); s += (v[j][0] * v[j][0] + v[j][1] * v[j][1]) + (v[j][2] * v[j][2] + v[j][3] * v[j][3]); }
        const f32x4 kv = *((const f32x4*)(pr + 768) + lane); const float s2 = (kv[0] * kv[0] + kv[1] * kv[1]) + (kv[2] * kv[2] + kv[3] * kv[3]);
        const float rq = 1.0f / sqrtf(wave_sum(s) * (1.f / 768.f) + RMS_EPS), rkv = 1.0f / sqrtf(wave_sum(s2) * (1.f / 256.f) + RMS_EPS);
#pragma unroll
        for (int j = 0; j < 3; ++j) { const f32x4 gg = *((const f32x4*)qn + lane + 64 * j); const f32x4 o = v[j] * rq * gg; u32x2 w; w.x = pk2(o[0], o[1]); w.y = pk2(o[2], o[3]);
            *((u32x2*)(LATQ + (size_t)m * 768) + lane + 64 * j) = w; }
        { const f32x4 gg = *((const f32x4*)kvn + lane); const f32x4 o = kv * rkv * gg; u32x2 w; w.x = pk2(o[0], o[1]); w.y = pk2(o[2], o[3]); *((u32x2*)(LATKV + (size_t)m * 256) + lane) = w; }
        if (lane < 16) { const float x1 = pr[1024 + lane], x2 = pr[1040 + lane], cs = tab[(size_t)m * 32 + lane], sn = tab[(size_t)m * 32 + 16 + lane];
            const unsigned w = pk2(x1 * cs - x2 * sn, x1 * sn + x2 * cs); KR[(size_t)m * 32 + lane] = (bf16_t)(w & 0xffff); KR[(size_t)m * 32 + 16 + lane] = (bf16_t)(w >> 16); }
    }
}

__device__ __forceinline__ void attn_phase(LAS unsigned char* lds, const bf16_t* Q, const bf16_t* KN, const bf16_t* KR, const bf16_t* VT, bf16_t* O) {
    constexpr int KPB = 208, VPB = 144, KSB = 64 * KPB, VSB = 64 * VPB;
    const int tid = mk_tid(), lane = tid & 63, wave = __builtin_amdgcn_readfirstlane(tid >> 6), q = lane & 31, g = lane >> 5;
    const unsigned kn_dst = (tid >> 3) * KPB + (tid & 7) * 16, kr_dst = (tid >> 2) * KPB + 128 + (tid & 3) * 16, vt_dst = 2 * KSB + (tid >> 3) * VPB + (tid & 7) * 16;
    for (int bh = mk_bid(); bh < 256; bh += mk_grid()) {
        const int b = bh >> 4, h = bh & 15;
        const bf16_t* kn_src = KN + (size_t)(b * 2048 + (tid >> 3)) * 1024 + h * 64 + (tid & 7) * 8;
        const bf16_t* kr_src = KR + (size_t)(b * 2048 + (tid >> 2)) * 32 + (tid & 3) * 8;
        const bf16_t* vt_src = VT + (size_t)(bh * 64 + (tid >> 3)) * 2048 + (tid & 7) * 8;
#pragma unroll 1
        for (int qb = 7; qb >= 0; --qb) {
            __syncthreads();
            const int r0 = qb * 256 + wave * 32, ntile = 4 * (qb + 1);
            bf16x8 qf[6];
            { const bf16_t* qp = Q + (size_t)(b * 2048 + r0 + q) * 1536 + h * 96 + g * 8;
#pragma unroll
              for (int ks = 0; ks < 6; ++ks) qf[ks] = *(const bf16x8*)(qp + ks * 16); }
            f32x16 o0, o1;
#pragma unroll
            for (int i = 0; i < 16; ++i) { o0[i] = 0.f; o1[i] = 0.f; }
            float mrow = -INFINITY, lrow = 0.f;
            u32x4 rk, rr, rv;
            rk = *(const u32x4*)kn_src; rv = *(const u32x4*)vt_src; if (tid < 256) rr = *(const u32x4*)kr_src;
            *(LAS u32x4*)(lds + kn_dst) = rk; *(LAS u32x4*)(lds + vt_dst) = rv; if (tid < 256) *(LAS u32x4*)(lds + kr_dst) = rr;
            __syncthreads();
#pragma unroll 1
            for (int j = 0; j < ntile; ++j) {
                const int cur = j & 1; const bool more = (j + 1 < ntile);
                if (more) { rk = *(const u32x4*)(kn_src + (size_t)(j + 1) * 64 * 1024); rv = *(const u32x4*)(vt_src + (j + 1) * 64); if (tid < 256) rr = *(const u32x4*)(kr_src + (size_t)(j + 1) * 64 * 32); }
                if (64 * j <= r0 + 31) {
                    const LAS unsigned char* kb_ = lds + cur * KSB; const LAS unsigned char* vb_ = lds + 2 * KSB + cur * VSB;
                    f32x16 s0, s1;
#pragma unroll
                    for (int i = 0; i < 16; ++i) { s0[i] = 0.f; s1[i] = 0.f; }
#pragma unroll
                    for (int ks = 0; ks < 6; ++ks) {
                        const bf16x8 a0 = *(const LAS bf16x8*)(kb_ + q * KPB + (ks * 16 + g * 8) * 2), a1 = *(const LAS bf16x8*)(kb_ + (32 + q) * KPB + (ks * 16 + g * 8) * 2);
                        s0 = mfma32(a0, qf[ks], s0); s1 = mfma32(a1, qf[ks], s1); }
                    if (64 * j + 63 > r0) { const int qa = r0 + q, k0 = 64 * j + 4 * g;
#pragma unroll
                        for (int i = 0; i < 16; ++i) { const int key = k0 + (i & 3) + 8 * (i >> 2); if (key > qa) s0[i] = -INFINITY; if (key + 32 > qa) s1[i] = -INFINITY; } }
                    float mx = fmaxf(s0[0], s1[0]);
#pragma unroll
                    for (int i = 1; i < 16; ++i) mx = fmaxf(mx, fmaxf(s0[i], s1[i]));
                    mx = fmaxf(mx, __shfl_xor(mx, 32));
                    const float mnew = fmaxf(mrow, mx), alpha = __builtin_amdgcn_exp2f(mrow - mnew); mrow = mnew;
                    float sum = 0.f;
#pragma unroll
                    for (int i = 0; i < 16; ++i) { s0[i] = __builtin_amdgcn_exp2f(s0[i] - mnew); s1[i] = __builtin_amdgcn_exp2f(s1[i] - mnew); sum += s0[i] + s1[i]; }
                    lrow = lrow * alpha + sum;
#pragma unroll
                    for (int i = 0; i < 16; ++i) { o0[i] *= alpha; o1[i] *= alpha; }
#pragma unroll
                    for (int kb = 0; kb < 2; ++kb)
#pragma unroll
                        for (int t2 = 0; t2 < 2; ++t2) {
                            u32x4 pw;
                            if (kb == 0) { pw.x = pk2(s0[8 * t2 + 0], s0[8 * t2 + 1]); pw.y = pk2(s0[8 * t2 + 2], s0[8 * t2 + 3]); pw.z = pk2(s0[8 * t2 + 4], s0[8 * t2 + 5]); pw.w = pk2(s0[8 * t2 + 6], s0[8 * t2 + 7]); }
                            else         { pw.x = pk2(s1[8 * t2 + 0], s1[8 * t2 + 1]); pw.y = pk2(s1[8 * t2 + 2], s1[8 * t2 + 3]); pw.z = pk2(s1[8 * t2 + 4], s1[8 * t2 + 5]); pw.w = pk2(s1[8 * t2 + 6], s1[8 * t2 + 7]); }
                            const bf16x8 pb = __builtin_bit_cast(bf16x8, pw);
                            const int ko = (32 * kb + 16 * t2 + 4 * g) * 2;
                            { const u32x2 lo = *(const LAS u32x2*)(vb_ + q * VPB + ko), hi = *(const LAS u32x2*)(vb_ + q * VPB + ko + 16);
                              const u32x4 av = (u32x4){lo.x, lo.y, hi.x, hi.y}; o0 = mfma32(__builtin_bit_cast(bf16x8, av), pb, o0); }
                            { const u32x2 lo = *(const LAS u32x2*)(vb_ + (32 + q) * VPB + ko), hi = *(const LAS u32x2*)(vb_ + (32 + q) * VPB + ko + 16);
                              const u32x4 av = (u32x4){lo.x, lo.y, hi.x, hi.y}; o1 = mfma32(__builtin_bit_cast(bf16x8, av), pb, o1); }
                        }
                }
                if (more) { const unsigned bo = (cur ^ 1) * KSB, vo = (cur ^ 1) * VSB;
                    *(LAS u32x4*)(lds + bo + kn_dst) = rk; *(LAS u32x4*)(lds + vo + vt_dst) = rv; if (tid < 256) *(LAS u32x4*)(lds + bo + kr_dst) = rr; }
                __syncthreads();
            }
            const float lt = lrow + __shfl_xor(lrow, 32), inv = 1.0f / lt;
            bf16_t* op = O + (size_t)(b * 2048 + r0 + q) * 1024 + h * 64 + 4 * g;
#pragma unroll
            for (int qd = 0; qd < 4; ++qd) {
                u32x2 w0, w1; w0.x = pk2(o0[4 * qd] * inv, o0[4 * qd + 1] * inv); w0.y = pk2(o0[4 * qd + 2] * inv, o0[4 * qd + 3] * inv);
                w1.x = pk2(o1[4 * qd] * inv, o1[4 * qd + 1] * inv); w1.y = pk2(o1[4 * qd + 2] * inv, o1[4 * qd + 3] * inv);
                *(u32x2*)(op + 8 * qd) = w0; *(u32x2*)(op + 32 + 8 * qd) = w1; }
        }
    }
}

__device__ __forceinline__ void hgrn_phase(LAS unsigned char* lds, const bf16_t* QS, const float* LOGF, const bf16_t* VV, const bf16_t* GS, const float* gn, bf16_t* OG) {
    constexpr int QP = 0, KPN = 8704, KPT = 17408, VTT = 27648, SST = 37888, OPART = 72704, GSUM = 106496, ELAST = 108544;
    const int tid = mk_tid(), lane = tid & 63, wave = __builtin_amdgcn_readfirstlane(tid >> 6), q = lane & 31, g = lane >> 5;
    const int ch = tid & 127, tg = tid >> 7, vb = wave & 3, kh = wave >> 2;
    const int dt = tid >> 4, dpart = tid & 15;
    for (int bh = mk_bid(); bh < 128; bh += mk_grid()) {
        const int b = bh >> 3, hh = bh & 7;
        __syncthreads();
        f32x16 st0, st1;
#pragma unroll
        for (int i = 0; i < 16; ++i) { st0[i] = 0.f; st1[i] = 0.f; }
        const size_t ebase = (size_t)(b * 2048 + 8 * tg) * 1024 + hh * 128 + ch;
        const size_t dbase = (size_t)(b * 2048 + dt) * 1024 + hh * 128 + 8 * dpart;
        f32x4 gn0 = *(const f32x4*)(gn + 8 * dpart), gn1 = *(const f32x4*)(gn + 8 * dpart + 4);
        float lf[8]; unsigned short qs[8], vv[8];
#pragma unroll
        for (int i = 0; i < 8; ++i) { lf[i] = LOGF[ebase + (size_t)i * 1024]; qs[i] = QS[ebase + (size_t)i * 1024]; vv[i] = VV[ebase + (size_t)i * 1024]; }
        u32x4 gsv_next = *(const u32x4*)(GS + dbase);
#pragma unroll 1
        for (int c = 0; c < 64; ++c) {
            float cs[8]; cs[0] = lf[0];
#pragma unroll
            for (int i = 1; i < 8; ++i) cs[i] = cs[i - 1] + lf[i];
            *(LAS float*)(lds + GSUM + (tg * 128 + ch) * 4) = cs[7];
            __syncthreads();
            float off = 0.f, tot = 0.f;
#pragma unroll
            for (int t = 0; t < 4; ++t) { const float gs_ = *(const LAS float*)(lds + GSUM + (t * 128 + ch) * 4); if (t < tg) off += gs_; tot += gs_; }
            {
                unsigned kt[4], vt[4];
#pragma unroll
                for (int i = 0; i < 8; i += 2) {
                    const float b0 = off + cs[i], b1 = off + cs[i + 1];
                    const float q0 = bf2f(qs[i]) * __expf(b0), q1 = bf2f(qs[i + 1]) * __expf(b1);
                    const float k0 = (1.f - __expf(lf[i])) * __expf(-b0), k1 = (1.f - __expf(lf[i + 1])) * __expf(-b1);
                    const unsigned qw = pk2(q0, q1), kw = pk2(k0, k1);
                    *(LAS unsigned short*)(lds + QP + (8 * tg + i) * 272 + ch * 2) = (unsigned short)(qw & 0xffff);
                    *(LAS unsigned short*)(lds + QP + (8 * tg + i + 1) * 272 + ch * 2) = (unsigned short)(qw >> 16);
                    *(LAS unsigned short*)(lds + KPN + (8 * tg + i) * 272 + ch * 2) = (unsigned short)(kw & 0xffff);
                    *(LAS unsigned short*)(lds + KPN + (8 * tg + i + 1) * 272 + ch * 2) = (unsigned short)(kw >> 16);
                    kt[i >> 1] = kw; vt[i >> 1] = (unsigned)vv[i] | ((unsigned)vv[i + 1] << 16);
                }
                *(LAS u32x4*)(lds + KPT + ch * 80 + tg * 16) = (u32x4){kt[0], kt[1], kt[2], kt[3]};
                *(LAS u32x4*)(lds + VTT + ch * 80 + tg * 16) = (u32x4){vt[0], vt[1], vt[2], vt[3]};
                if (tg == 3) *(LAS float*)(lds + ELAST + ch * 4) = __expf(tot);
            }
#pragma unroll
            for (int qd = 0; qd < 4; ++qd) {
                u32x2 w0, w1; w0.x = pk2(st0[4 * qd], st0[4 * qd + 1]); w0.y = pk2(st0[4 * qd + 2], st0[4 * qd + 3]); w1.x = pk2(st1[4 * qd], st1[4 * qd + 1]); w1.y = pk2(st1[4 * qd + 2], st1[4 * qd + 3]);
                *(LAS u32x2*)(lds + SST + (32 * vb + q) * 272 + (32 * (2 * kh) + 8 * qd + 4 * g) * 2) = w0;
                *(LAS u32x2*)(lds + SST + (32 * vb + q) * 272 + (32 * (2 * kh + 1) + 8 * qd + 4 * g) * 2) = w1; }
            __syncthreads();
            const u32x4 gsv = gsv_next;
            if (c + 1 < 64) { const size_t e2 = ebase + (size_t)(c + 1) * 32 * 1024;
                gsv_next = *(const u32x4*)(GS + dbase + (size_t)(c + 1) * 32 * 1024);
#pragma unroll
                for (int i = 0; i < 8; ++i) { lf[i] = LOGF[e2 + (size_t)i * 1024]; qs[i] = QS[e2 + (size_t)i * 1024]; vv[i] = VV[e2 + (size_t)i * 1024]; } }
            {
                f32x16 oT;
#pragma unroll
                for (int i = 0; i < 16; ++i) oT[i] = 0.f;
#pragma unroll
                for (int ks = 0; ks < 4; ++ks) { const int k0 = (64 * kh + 16 * ks + 8 * g) * 2;
                    oT = mfma32(*(const LAS bf16x8*)(lds + SST + (32 * vb + q) * 272 + k0), *(const LAS bf16x8*)(lds + QP + q * 272 + k0), oT); }
                if (kh == 0) {
                    f32x16 aT;
#pragma unroll
                    for (int i = 0; i < 16; ++i) aT[i] = 0.f;
#pragma unroll
                    for (int ks = 0; ks < 8; ++ks) { const int k0 = (16 * ks + 8 * g) * 2;
                        aT = mfma32(*(const LAS bf16x8*)(lds + KPN + q * 272 + k0), *(const LAS bf16x8*)(lds + QP + q * 272 + k0), aT); }
#pragma unroll
                    for (int i = 0; i < 16; ++i) { const int s = (i & 3) + 8 * (i >> 2) + 4 * g; if (s > q) aT[i] = 0.f; }
#pragma unroll
                    for (int t2 = 0; t2 < 2; ++t2) {
                        u32x4 pw; pw.x = pk2(aT[8 * t2 + 0], aT[8 * t2 + 1]); pw.y = pk2(aT[8 * t2 + 2], aT[8 * t2 + 3]); pw.z = pk2(aT[8 * t2 + 4], aT[8 * t2 + 5]); pw.w = pk2(aT[8 * t2 + 6], aT[8 * t2 + 7]);
                        const int so = (16 * t2 + 4 * g) * 2;
                        const u32x2 lo = *(const LAS u32x2*)(lds + VTT + (32 * vb + q) * 80 + so), hi = *(const LAS u32x2*)(lds + VTT + (32 * vb + q) * 80 + so + 16);
                        const u32x4 av = (u32x4){lo.x, lo.y, hi.x, hi.y};
                        oT = mfma32(__builtin_bit_cast(bf16x8, av), __builtin_bit_cast(bf16x8, pw), oT); }
                }
#pragma unroll
                for (int qd = 0; qd < 4; ++qd) *(LAS f32x4*)(lds + OPART + kh * 16896 + q * 528 + (32 * vb + 8 * qd + 4 * g) * 4) = (f32x4){oT[4 * qd], oT[4 * qd + 1], oT[4 * qd + 2], oT[4 * qd + 3]};
            }
#pragma unroll
            for (int t2 = 0; t2 < 2; ++t2) { const int so = (16 * t2 + 8 * g) * 2; const bf16x8 bv = *(const LAS bf16x8*)(lds + VTT + (32 * vb + q) * 80 + so);
                st0 = mfma32(*(const LAS bf16x8*)(lds + KPT + (32 * (2 * kh) + q) * 80 + so), bv, st0);
                st1 = mfma32(*(const LAS bf16x8*)(lds + KPT + (32 * (2 * kh + 1) + q) * 80 + so), bv, st1); }
#pragma unroll
            for (int qd = 0; qd < 4; ++qd) { const f32x4 e0 = *(const LAS f32x4*)(lds + ELAST + (32 * (2 * kh) + 8 * qd + 4 * g) * 4), e1 = *(const LAS f32x4*)(lds + ELAST + (32 * (2 * kh + 1) + 8 * qd + 4 * g) * 4);
#pragma unroll
                for (int e = 0; e < 4; ++e) { st0[4 * qd + e] *= e0[e]; st1[4 * qd + e] *= e1[e]; } }
            __syncthreads();
            {
                const LAS float* o0p = (const LAS float*)(lds + OPART + dt * 528 + dpart * 32); const LAS float* o1p = (const LAS float*)(lds + OPART + 16896 + dt * 528 + dpart * 32);
                const f32x4 a0 = *(const LAS f32x4*)o0p + *(const LAS f32x4*)o1p, a1 = *(const LAS f32x4*)(o0p + 4) + *(const LAS f32x4*)(o1p + 4);
                float ss = (a0[0] * a0[0] + a0[1] * a0[1]) + (a0[2] * a0[2] + a0[3] * a0[3]) + (a1[0] * a1[0] + a1[1] * a1[1]) + (a1[2] * a1[2] + a1[3] * a1[3]);
                ss += __shfl_xor(ss, 1); ss += __shfl_xor(ss, 2); ss += __shfl_xor(ss, 4); ss += __shfl_xor(ss, 8);
                const float rstd = 1.0f / sqrtf(ss * (1.f / 128.f) + RMS_EPS);
                const f32x4 r0 = a0 * rstd * gn0, r1 = a1 * rstd * gn1;
                u32x4 w;
                w.x = pk2(r0[0] * bf2f((unsigned short)(gsv.x & 0xffff)), r0[1] * bf2f((unsigned short)(gsv.x >> 16)));
                w.y = pk2(r0[2] * bf2f((unsigned short)(gsv.y & 0xffff)), r0[3] * bf2f((unsigned short)(gsv.y >> 16)));
                w.z = pk2(r1[0] * bf2f((unsigned short)(gsv.z & 0xffff)), r1[1] * bf2f((unsigned short)(gsv.z >> 16)));
                w.w = pk2(r1[2] * bf2f((unsigned short)(gsv.w & 0xffff)), r1[3] * bf2f((unsigned short)(gsv.w >> 16)));
                *(u32x4*)(OG + dbase + (size_t)c * 32 * 1024) = w;
            }
        }
    }
}

constexpr int N_PHASES = 34;
template <class Epi>
__device__ __forceinline__ void run_gemm(LAS unsigned char* lds, const bf16_t* A, const bf16_t* Bt, int N, int K, const Epi& E) {
    asm volatile("" : "+s"(K), "+s"(N));
    pg8::Gemm g{A, Bt, M_TOK, N, K}; pg8::StaticOrder S; S.init(M_TOK, N, mk_grid(), mk_bid());
    pg8::gemm_phase<Epi, pg8::StaticOrder, true, true>((PG8_LAS unsigned char*)lds, g, S, E);
}

template <class Epi>
__device__ __forceinline__ void run_gemm_t(LAS unsigned char* lds, const bf16_t* A, const bf16_t* Bt, int K, const Epi& E) {
    asm volatile("" : "+s"(K));
    pg8::Gemm g{A, Bt, 1024, M_TOK, K}; pg8::StaticOrder S; S.init(1024, M_TOK, mk_grid(), mk_bid());
    pg8::gemm_phase<Epi, pg8::StaticOrder, true, true>((PG8_LAS unsigned char*)lds, g, S, E);
}

__global__ void __launch_bounds__(512, 2) fwd_megakernel(Params p) {
    extern __shared__ __attribute__((aligned(16))) unsigned char lds_raw[];
    LAS unsigned char* lds = (LAS unsigned char*)lds_raw;
    cg::grid_group grid = cg::this_grid();
    const int ph_lo = p.ph_lo, ph_hi = p.ph_hi;
    if (mk_tid() < 16) ((volatile LAS unsigned*)(lds + 131072))[mk_tid()] = 0u;
    __syncthreads();
    const XcdBarrier bar = xcd_barrier_post((unsigned*)(p.ws + WS_BAR), (volatile LAS unsigned*)(lds + 131072));
#if defined(PROBE_TIME_MASK)
    unsigned long long t_acc = 0;
#endif
#pragma unroll 1
    for (int ph = ph_lo; ph < ph_hi; ++ph) {
#if defined(PROBE_TIME_MASK)
        const unsigned long long t_ph0 = __builtin_amdgcn_s_memrealtime();
#endif
        unsigned long long kptr = (unsigned long long)__builtin_amdgcn_kernarg_segment_ptr(); asm volatile("" : "+s"(kptr));
        const ParamsPtr pp = (ParamsPtr)kptr;
#define p (*pp)
        unsigned char* ws = p.ws;
        float* MOD = (float*)(ws + WS_MOD); const float* TAB = (const float*)(ws + WS_TAB); const float* LB = (const float*)(ws + WS_LB);
        bf16_t* H = (bf16_t*)(ws + WS_H); float* RS = (float*)(ws + WS_RS);
        int kind, layer = 0;
        if (ph == 0) kind = 0; else if (ph == 1) kind = 1;
        else { const int qq = ph - 2, pair = qq >> 4, r = qq & 15;
            if (r < 9) { layer = 2 * pair; kind = (r < 6) ? 2 + r : 8 + (r - 6); if (r == 5) kind = 7; }
            else { layer = 2 * pair + 1; const int r2 = r - 9; kind = (r2 == 0) ? 11 : (r2 == 1) ? 12 : (r2 == 2) ? 6 : (r2 == 3) ? 7 : 8 + (r2 - 4); } }
        const int j = layer >> 1;
        switch (kind) {
        case 0:
#if defined(PROBE_DUP_PRO)
            prologue_phase(pp, lds); __syncthreads();
#endif
            prologue_phase(pp, lds); break;
        case 1:
#if defined(PROBE_DUP_NORM0)
            norm_phase(p.x, p.X, false, false, nullptr, nullptr, RS, true, MOD, H); norm_phase(p.x, p.X, false, false, nullptr, nullptr, RS, true, MOD, H); norm_phase(p.x, p.X, false, false, nullptr, nullptr, RS, true, MOD, H); norm_phase(p.x, p.X, false, false, nullptr, nullptr, RS, true, MOD, H);
#endif
            norm_phase(p.x, p.X, false, false, nullptr, nullptr, RS, true, MOD, H); break;
        case 2: { EpiProj E{(float*)(ws + R_PROJ), 1056, 1056}; run_gemm(lds, H, (const bf16_t*)(ws + W_MWIN) + (size_t)j * 1280 * 1024, 1280, 1024, E); } break;
        case 3: latnorm_phase((const float*)(ws + R_PROJ), p.mla_qn + j * 768, p.mla_kvn + j * 256, TAB, (bf16_t*)(ws + R_LATQ), (bf16_t*)(ws + R_LATKV), (bf16_t*)(ws + R_KR)); break;
        case 4: { EpiQ Eq{(bf16_t*)(ws + R_Q), TAB}; run_gemm(lds, (const bf16_t*)(ws + R_LATQ), (const bf16_t*)(ws + W_MWQB) + (size_t)j * 1536 * 768, 1536, 768, Eq);
                  const bf16_t* Wkv = (const bf16_t*)(ws + W_MWKVB) + (size_t)j * 2048 * 256;
                  EpiBf16 Ek{(bf16_t*)(ws + R_KN), 1024}; run_gemm(lds, (const bf16_t*)(ws + R_LATKV), Wkv, 1024, 256, Ek);
                  EpiVT Ev{(bf16_t*)(ws + R_VT)}; run_gemm_t(lds, Wkv + (size_t)1024 * 256, (const bf16_t*)(ws + R_LATKV), 256, Ev); } break;
        case 5:
#if defined(PROBE_DUP_ATTN)
            attn_phase(lds, (const bf16_t*)(ws + R_Q), (const bf16_t*)(ws + R_KN), (const bf16_t*)(ws + R_KR), (const bf16_t*)(ws + R_VT), (bf16_t*)(ws + R_O));
#endif
            attn_phase(lds, (const bf16_t*)(ws + R_Q), (const bf16_t*)(ws + R_KN), (const bf16_t*)(ws + R_KR), (const bf16_t*)(ws + R_VT), (bf16_t*)(ws + R_O)); break;
        case 6: { const bool mla = (layer & 1) == 0; const int pl = layer > 0 ? 2 * layer - 1 : 0;
                  EpiResid E{layer == 0 ? p.x : (const float*)p.X, p.X, MOD + (size_t)(2 * layer) * 16 * 3072, RS, p.ln_g + (size_t)pl * 1024, p.ln_b + (size_t)pl * 1024, layer == 0 ? 1 : 0};
                  const bf16_t* A = mla ? (const bf16_t*)(ws + R_O) : (const bf16_t*)H;
                  const bf16_t* Bt = mla ? (const bf16_t*)(ws + W_MWO) + (size_t)j * 1024 * 1024 : (const bf16_t*)(ws + W_HWO) + (size_t)j * 1024 * 1024;
                  run_gemm(lds, A, Bt, 1024, 1024, E); } break;
        case 7: norm_phase(p.X, p.X, true, false, p.ln_g + (size_t)(2 * layer) * 1024, p.ln_b + (size_t)(2 * layer) * 1024, RS, true, MOD + (size_t)(2 * layer + 1) * 16 * 3072, H); break;
        case 8: { EpiSwiGLU E{(bf16_t*)(ws + R_T)};
#if defined(PROBE_DUP_G4)
            run_gemm(lds, H, (const bf16_t*)(ws + W_FWIN) + (size_t)layer * 5632 * 1024, 5632, 1024, E);
#endif
            run_gemm(lds, H, (const bf16_t*)(ws + W_FWIN) + (size_t)layer * 5632 * 1024, 5632, 1024, E); } break;
        case 9: { EpiResid E{p.X, p.X, MOD + (size_t)(2 * layer + 1) * 16 * 3072, RS, p.ln_g + (size_t)(2 * layer) * 1024, p.ln_b + (size_t)(2 * layer) * 1024, 0}; run_gemm(lds, (const bf16_t*)(ws + R_T), (const bf16_t*)(ws + W_FWOUT) + (size_t)layer * 1024 * FF, 1024, FF, E); } break;
        case 10: norm_phase(p.X, p.X, true, layer == 3, p.ln_g + (size_t)(2 * layer + 1) * 1024, p.ln_b + (size_t)(2 * layer + 1) * 1024, RS, layer < 3, MOD + (size_t)(2 * layer + 2) * 16 * 3072, H); break;
        case 11: { EpiHgrnIn E{(bf16_t*)(ws + R_QS), (float*)(ws + R_LOGF), LB + j * 1024};
                   run_gemm(lds, H, (const bf16_t*)(ws + W_HWIN) + (size_t)j * 4096 * 1024, 4096, 1024, E); } break;
        case 12:
#if defined(PROBE_DUP_REC)
            hgrn_phase(lds, (const bf16_t*)(ws + R_QS), (const float*)(ws + R_LOGF), (const bf16_t*)(ws + R_VV), (const bf16_t*)(ws + R_GS), p.hgrn_gn + j * 128, H);
#endif
            hgrn_phase(lds, (const bf16_t*)(ws + R_QS), (const float*)(ws + R_LOGF), (const bf16_t*)(ws + R_VV), (const bf16_t*)(ws + R_GS), p.hgrn_gn + j * 128, H); break;
        default: break;
        }
        if (ph + 1 < ph_hi) { if (ph == ph_lo) grid.sync(); else xcd_barrier(bar); }
#if defined(PROBE_TIME_MASK)
        if ((PROBE_TIME_MASK >> kind) & 1) t_acc += __builtin_amdgcn_s_memrealtime() - t_ph0;
#endif
#if defined(PROBE_DUP_SYNC)
        if (ph + 1 < ph_hi) { xcd_barrier(bar); xcd_barrier(bar); xcd_barrier(bar); xcd_barrier(bar); }
#endif
#undef p
    }
#if defined(PROBE_TIME_MASK)
    if (mk_bid() == 0) { const unsigned long long t_e = __builtin_amdgcn_s_memrealtime(); while (__builtin_amdgcn_s_memrealtime() - t_e < t_acc) __builtin_amdgcn_s_sleep(8); }
#endif
}

#ifndef MK_MULTI
#define MK_MULTI 0
#endif
extern "C" void kernel_launch(void* const* d_in, const int* in_sizes, int n_in, void* d_out, int out_size, void* d_ws, size_t ws_size, hipStream_t stream) {
    static int grid = 0;
    if (grid == 0) {
        if (n_in != 19 || out_size != M_TOK * DM || ws_size < WS_END) { fprintf(stderr, "kernel_launch: unexpected sizes: n_in %d out %d ws %zu (need %zu)\n", n_in, out_size, ws_size, (size_t)WS_END); grid = -1; return; }
        int dev = 0, cus = 0, per_cu = 0;
        hipGetDevice(&dev); hipDeviceGetAttribute(&cus, hipDeviceAttributeMultiprocessorCount, dev);
        if (hipFuncSetAttribute((const void*)fwd_megakernel, hipFuncAttributeMaxDynamicSharedMemorySize, LDS_BYTES) != hipSuccess) { fprintf(stderr, "kernel_launch: hipFuncSetAttribute failed\n"); grid = -1; return; }
        hipOccupancyMaxActiveBlocksPerMultiprocessor(&per_cu, (const void*)fwd_megakernel, 512, LDS_BYTES);
        (void)hipGetLastError();
        if (per_cu < 1) per_cu = 1;
        grid = cus * 1;
        fprintf(stderr, "kernel_launch: cus %d per_cu %d grid %d\n", cus, per_cu, grid);
    }
    if (grid < 0) return;
    if (hipMemsetAsync((char*)d_ws + WS_BAR, 0, XCD_BAR_WORDS * 4, stream) != hipSuccess) { fprintf(stderr, "kernel_launch: memset failed\n"); return; }
    Params p{};
    p.x = (const float*)d_in[0]; p.c = (const float*)d_in[1]; p.pos = (const int*)d_in[2];
    p.mla_qn = (const float*)d_in[4]; p.mla_kvn = (const float*)d_in[6]; p.hgrn_lb = (const float*)d_in[9]; p.hgrn_gn = (const float*)d_in[11];
    p.ada_w = (const float*)d_in[15]; p.ada_b = (const float*)d_in[16]; p.ln_g = (const float*)d_in[17]; p.ln_b = (const float*)d_in[18];
    p.X = (float*)d_out; p.ws = (unsigned char*)d_ws;
    p.wsrc[0] = (const float*)d_in[3]; p.wsrc[1] = (const float*)d_in[5]; p.wsrc[2] = (const float*)d_in[7]; p.wsrc[3] = (const float*)d_in[8];
    p.wsrc[4] = (const float*)d_in[10]; p.wsrc[5] = (const float*)d_in[12]; p.wsrc[6] = (const float*)d_in[13]; p.wsrc[7] = (const float*)d_in[14];
    for (int i = 0; i < 16; ++i) p.invf[i] = (float)pow(10000.0, -(double)i / 16.0);
#if MK_MULTI
    for (int ph = 0; ph < N_PHASES; ++ph) { p.ph_lo = ph; p.ph_hi = ph + 1; hipLaunchKernelGGL(fwd_megakernel, dim3(grid), dim3(512), LDS_BYTES, stream, p); }
#else
    p.ph_lo = 0; p.ph_hi = N_PHASES;
    void* args[] = {&p};
    hipError_t e = hipLaunchCooperativeKernel((const void*)fwd_megakernel, dim3(grid), dim3(512), args, LDS_BYTES, stream);
    if (e != hipSuccess) fprintf(stderr, "cooperative launch failed: %s (grid %d)\n", hipGetErrorString(e), grid);
#endif
}
```

```cpp
#include <hip/hip_runtime.h>
#include <hip/hip_cooperative_groups.h>
#include <cstdio>
#include <cstdint>
#include <cmath>
namespace cg = cooperative_groups;

__device__ __forceinline__ int mk_tid() { int t = (int)threadIdx.x; asm volatile("" : "+v"(t)); return t; }
__device__ __forceinline__ int mk_bid() { int t = (int)blockIdx.x; asm volatile("" : "+s"(t)); return t; }
__device__ __forceinline__ int mk_grid() { int t = (int)gridDim.x; asm volatile("" : "+s"(t)); return t; }
namespace pg8 {
#define PG8_LAS __attribute__((address_space(3)))
typedef unsigned short bf16_t;
typedef short bf16x8 __attribute__((ext_vector_type(8)));
typedef float f32x4 __attribute__((ext_vector_type(4)));
typedef unsigned u32x4 __attribute__((ext_vector_type(4)));
constexpr int BM = 256, BK = 64, HALF = 128, HTB = HALF * BK * 2  , STAGE_BYTES = 8 * HTB, NXCD = 8, WGM = 8;

__host__ __device__ __forceinline__ int lds_byte(int r, int c) { const int st = (r >> 4) * 2 + (c >> 5), rr = r & 15, cc = c & 31, ob = rr * 64 + cc * 2; return st * 1024 + (ob ^ (((ob >> 9) & 1) << 5)); }
__host__ __device__ __forceinline__ void stage_rc(int b, int& R, int& C) { const int st = b / 1024, sb = b % 1024, swz = sb ^ (((sb >> 9) & 1) << 5); R = (st >> 1) * 16 + swz / 64; C = (st & 1) * 32 + (swz % 64) / 2; }
__host__ __device__ __forceinline__ int perm32(int rho) { const int n = rho >> 4, i = rho & 15; return 8 * (i >> 2) + 4 * n + (i & 3); }

struct Unit { int pm, pn; };
struct Gemm { const bf16_t* A; const bf16_t* Bt; int M, N, K; };

struct StaticOrder {
    int nM, nN, nwg, G, c;
    __host__ __device__ void init(int M, int N, int G_, int c_) { nM = M / BM; nN = N / BM; nwg = nM * nN; G = G_; c = c_; }
    __host__ __device__ bool next(int i, Unit& u) const {
        const long L = (long)i * G + c; if (L >= nwg) return false;
        int wgid = (int)L; { const int q = nwg / NXCD, r = nwg % NXCD, xcd = wgid % NXCD, off = wgid / NXCD; wgid = (xcd < r ? xcd * (q + 1) : r * (q + 1) + (xcd - r) * q) + off; }
        const int nig = WGM * nN, gid = wgid / nig, fm = gid * WGM, gsz = (nM - fm) < WGM ? (nM - fm) : WGM;
        u.pm = fm + ((wgid % nig) % gsz); u.pn = (wgid % nig) / gsz; return true;
    }
    __device__ __forceinline__ void a_ready(const Unit&) const {}
    __device__ __forceinline__ void done(const Unit&) const {}
};

__device__ __forceinline__ unsigned cvt_pk_bf16(float lo, float hi) { unsigned r; asm volatile("v_cvt_pk_bf16_f32 %0, %1, %2" : "=v"(r) : "v"(lo), "v"(hi)); return r; }
template <class Epi, class Sched, bool ALIGN_EPI = false, bool SP2 = false>
__device__ __forceinline__ void gemm_phase(PG8_LAS unsigned char* lds, const Gemm g, const Sched& S, const Epi& E) {
    const int tid = mk_tid(), wid = __builtin_amdgcn_readfirstlane(tid >> 6), lane = tid & 63, wr = wid >> 2, wc = wid & 3, fr = lane & 15, fq = lane >> 4;
    const int K = g.K, nt = K / BK;
    unsigned voffA[2], voffB[2];
#pragma unroll
    for (int i = 0; i < 2; ++i) { int R, C; stage_rc(tid * 16 + i * 8192, R, C); const int Rb = Epi::PERM ? ((R & ~31) + perm32(R & 31)) : R;
        voffA[i] = (unsigned)(R * K + C) * 2u; voffB[i] = (unsigned)(Rb * K + C) * 2u; }
    const size_t kstep = (size_t)(BK * 2);
    const size_t hstep = (size_t)HALF * K * 2;
    const size_t tstep = 2 * hstep;
    const unsigned ldsw = (unsigned)wid * 1024u;
    const int aoff = lds_byte(wr * 64 + fr, fq * 8), boff = lds_byte(wc * 32 + fr, fq * 8);
#define PG8_SA(b, h) (((b) * 2 + (h)) * HTB)
#define PG8_SB(b, h) ((4 + (b) * 2 + (h)) * HTB)
#define PG8_STAGE(bufoff, gbase, voff) do { _Pragma("unroll") for (int _i = 0; _i < 2; ++_i) \
        __builtin_amdgcn_global_load_lds((const unsigned*)((const char*)(gbase) + (voff)[_i]), (PG8_LAS unsigned*)(lds + (bufoff) + ldsw + _i * 8192), 16, 0, 0); } while (0)
#define PG8_LDA(dst, b, h) do { _Pragma("unroll") for (int m = 0; m < 4; ++m) _Pragma("unroll") for (int k = 0; k < 2; ++k) dst[m][k] = *(const PG8_LAS bf16x8*)(lds + PG8_SA(b, h) + aoff + m * 2048 + k * 1024); } while (0)
#define PG8_LDB(dst, b, h) do { _Pragma("unroll") for (int n = 0; n < 2; ++n) _Pragma("unroll") for (int k = 0; k < 2; ++k) dst[n][k] = *(const PG8_LAS bf16x8*)(lds + PG8_SB(b, h) + boff + n * 2048 + k * 1024); } while (0)
#define PG8_MMA(ai, bj, At, Bt) do { __builtin_amdgcn_s_setprio(1); _Pragma("unroll") for (int m = 0; m < 4; ++m) _Pragma("unroll") for (int n = 0; n < 2; ++n) _Pragma("unroll") for (int k = 0; k < 2; ++k) \
        acc[ai][bj][m][n] = __builtin_amdgcn_mfma_f32_16x16x32_bf16(Bt[n][k], At[m][k], acc[ai][bj][m][n], 0, 0, 0); __builtin_amdgcn_s_setprio(0); } while (0)
#define PG8_WAIT_V(n) asm volatile("s_waitcnt vmcnt(" #n ")" ::: "memory")
#define PG8_WAIT_L(n) asm volatile("s_waitcnt lgkmcnt(" #n ")" ::: "memory")
#define PG8_BAR __builtin_amdgcn_s_barrier()
#define PG8_SCHED __builtin_amdgcn_sched_barrier(0)
    Unit cur, nxt; int ui = 0;
    if (!S.next(0, cur)) return;
    f32x4 acc[2][2][4][2];
#pragma unroll
    for (int a = 0; a < 2; ++a)
#pragma unroll
        for (int b = 0; b < 2; ++b)
#pragma unroll
            for (int m = 0; m < 4; ++m)
#pragma unroll
                for (int n = 0; n < 2; ++n) acc[a][b][m][n] = (f32x4){0.f, 0.f, 0.f, 0.f};
    bf16x8 At[4][2], B0[2][2], B1[2][2];
    const char* cA = (const char*)g.A + (size_t)cur.pm * tstep; const char* cB = (const char*)g.Bt + (size_t)cur.pn * tstep;
    S.a_ready(cur);
    if constexpr (SP2) {
        PG8_STAGE(PG8_SB(0, 0), cB, voffB); PG8_STAGE(PG8_SB(0, 1), cB + hstep, voffB); PG8_STAGE(PG8_SA(0, 0), cA, voffA); PG8_STAGE(PG8_SA(0, 1), cA + hstep, voffA);
        if (wr == 1) PG8_BAR;
        PG8_WAIT_V(2); PG8_BAR;
        PG8_STAGE(PG8_SB(1, 0), cB + kstep, voffB); PG8_STAGE(PG8_SA(1, 0), cA + kstep, voffA); PG8_STAGE(PG8_SB(1, 1), cB + hstep + kstep, voffB);
        PG8_WAIT_V(6); PG8_BAR;
    } else {
        PG8_STAGE(PG8_SB(0, 0), cB, voffB); PG8_STAGE(PG8_SA(0, 0), cA, voffA); PG8_STAGE(PG8_SB(0, 1), cB + hstep, voffB); PG8_STAGE(PG8_SA(0, 1), cA + hstep, voffA);
        if (wr == 1) PG8_BAR;
        PG8_WAIT_V(4); PG8_BAR;
        PG8_STAGE(PG8_SB(1, 0), cB + kstep, voffB); PG8_STAGE(PG8_SA(1, 0), cA + kstep, voffA); PG8_STAGE(PG8_SB(1, 1), cB + hstep + kstep, voffB);
        PG8_WAIT_V(6); PG8_BAR;
    }
    for (;;) {
        const bool has_next = S.next(ui + 1, nxt);
        const char* nA = has_next ? (const char*)g.A + (size_t)nxt.pm * tstep : cA; const char* nB = has_next ? (const char*)g.Bt + (size_t)nxt.pn * tstep : cB;
        for (int t = 0; t < nt; t += 2) {
            const bool last = (t == nt - 2);
            const char* a1 = cA + (size_t)(t + 1) * kstep;
            const char* a2 = last ? nA : cA + (size_t)(t + 2) * kstep; const char* b2 = last ? nB : cB + (size_t)(t + 2) * kstep;
            const char* a3 = a2 + kstep; const char* b3 = b2 + kstep;
            if (last && has_next) S.a_ready(nxt);
            if constexpr (SP2) {
            PG8_LDB(B0, 0, 0); PG8_LDB(B1, 0, 1); PG8_SCHED; PG8_LDA(At, 0, 0); PG8_STAGE(PG8_SA(1, 1), a1 + hstep, voffA);
            PG8_WAIT_V(8); PG8_WAIT_L(0); PG8_BAR; PG8_MMA(0, 0, At, B0); PG8_MMA(0, 1, At, B1); PG8_BAR; PG8_SCHED;
            PG8_LDA(At, 0, 1); PG8_STAGE(PG8_SB(0, 0), b2, voffB); PG8_STAGE(PG8_SB(0, 1), b2 + hstep, voffB); PG8_STAGE(PG8_SA(0, 0), a2, voffA);
            PG8_WAIT_V(8); PG8_WAIT_L(0); PG8_BAR; PG8_MMA(1, 0, At, B0); PG8_MMA(1, 1, At, B1); PG8_BAR; PG8_SCHED;
            PG8_LDB(B0, 1, 0); PG8_LDB(B1, 1, 1); PG8_SCHED; PG8_LDA(At, 1, 0); PG8_STAGE(PG8_SA(0, 1), a2 + hstep, voffA);
            PG8_WAIT_V(8); PG8_WAIT_L(0); PG8_BAR; PG8_MMA(0, 0, At, B0); PG8_MMA(0, 1, At, B1); PG8_BAR; PG8_SCHED;
            PG8_LDA(At, 1, 1); PG8_STAGE(PG8_SB(1, 0), b3, voffB); PG8_STAGE(PG8_SB(1, 1), b3 + hstep, voffB); PG8_STAGE(PG8_SA(1, 0), a3, voffA);
            PG8_WAIT_V(8); PG8_WAIT_L(0); PG8_BAR; PG8_MMA(1, 0, At, B0); PG8_MMA(1, 1, At, B1); PG8_BAR; PG8_SCHED;
            } else {
            PG8_LDB(B0, 0, 0); PG8_SCHED; PG8_LDA(At, 0, 0); PG8_STAGE(PG8_SA(1, 1), a1 + hstep, voffA);
            PG8_WAIT_L(8); PG8_BAR; PG8_WAIT_L(0); PG8_MMA(0, 0, At, B0); PG8_BAR; PG8_SCHED;
            PG8_LDB(B1, 0, 1); PG8_STAGE(PG8_SB(0, 0), b2, voffB);
            PG8_BAR; PG8_WAIT_L(0); PG8_MMA(0, 1, At, B1); PG8_BAR;
            PG8_LDA(At, 0, 1); PG8_STAGE(PG8_SA(0, 0), a2, voffA);
            PG8_BAR; PG8_WAIT_L(0); PG8_MMA(1, 0, At, B0); PG8_BAR; PG8_SCHED;
            PG8_STAGE(PG8_SB(0, 1), b2 + hstep, voffB);
            PG8_WAIT_V(6); PG8_BAR; PG8_MMA(1, 1, At, B1); PG8_BAR;
            PG8_LDB(B0, 1, 0); PG8_SCHED; PG8_LDA(At, 1, 0); PG8_STAGE(PG8_SA(0, 1), a2 + hstep, voffA);
            PG8_WAIT_L(8); PG8_BAR; PG8_WAIT_L(0); PG8_MMA(0, 0, At, B0); PG8_BAR; PG8_SCHED;
            PG8_LDB(B1, 1, 1); PG8_STAGE(PG8_SB(1, 0), b3, voffB);
            PG8_BAR; PG8_WAIT_L(0); PG8_MMA(0, 1, At, B1); PG8_BAR;
            PG8_LDA(At, 1, 1); PG8_STAGE(PG8_SA(1, 0), a3, voffA);
            PG8_BAR; PG8_WAIT_L(0); PG8_MMA(1, 0, At, B0); PG8_BAR; PG8_SCHED;
            PG8_STAGE(PG8_SB(1, 1), b3 + hstep, voffB);
            PG8_WAIT_V(6); PG8_BAR; PG8_MMA(1, 1, At, B1); PG8_BAR;
            }
        }
        if constexpr (ALIGN_EPI) { if (wr == 0) PG8_BAR; }
        if constexpr (!Epi::AFTER_DRAIN) { E(acc, cur, wr, wc, fr, fq); S.done(cur); }
        if (!has_next) break;
#pragma unroll
        for (int a = 0; a < 2; ++a)
#pragma unroll
            for (int b = 0; b < 2; ++b)
#pragma unroll
                for (int m = 0; m < 4; ++m)
#pragma unroll
                    for (int n = 0; n < 2; ++n) acc[a][b][m][n] = (f32x4){0.f, 0.f, 0.f, 0.f};
        cur = nxt; cA = nA; cB = nB; ++ui;
        if constexpr (ALIGN_EPI) { if (wr == 1) PG8_BAR; }
    }
    PG8_WAIT_V(0);
    if constexpr (!ALIGN_EPI) { if (wr == 0) PG8_BAR; }
    PG8_BAR;
    if constexpr (Epi::AFTER_DRAIN) { E.fused(acc, cur, wr, wc, fr, fq, lds, wid, lane); S.done(cur); }
#undef PG8_SA
#undef PG8_SB
#undef PG8_STAGE
#undef PG8_LDA
#undef PG8_LDB
#undef PG8_MMA
#undef PG8_WAIT_V
#undef PG8_WAIT_L
#undef PG8_BAR
#undef PG8_SCHED
}
}

#define LAS __attribute__((address_space(3)))
typedef unsigned short bf16_t;
typedef short bf16x8 __attribute__((ext_vector_type(8)));
typedef short bf16x4 __attribute__((ext_vector_type(4)));
typedef float f32x4 __attribute__((ext_vector_type(4)));
typedef float f32x16 __attribute__((ext_vector_type(16)));
typedef unsigned u32x4 __attribute__((ext_vector_type(4)));
typedef unsigned u32x2 __attribute__((ext_vector_type(2)));

constexpr int M_TOK = 32768, DM = 1024, SEQ = 2048, NB = 16;
constexpr int FF = 2816;
constexpr float ALPHA = 1.681792830507429f;
constexpr float LN_EPS = 1e-5f, RMS_EPS = 1e-6f;
constexpr float QSCALE = 0.10206207261596575f * 1.4426950408889634f;

constexpr size_t MiB = 1u << 20;
constexpr size_t WS_MOD = 0, WS_LB = 3 * MiB / 2, WS_TAB = 2 * MiB;
constexpr size_t W_MWIN = 6 * MiB, W_MWQB = 11 * MiB, W_MWKVB = 31 * MiB / 2, W_MWO = 35 * MiB / 2, W_HWIN = 43 * MiB / 2, W_HWO = 75 * MiB / 2,
                 W_FWIN = 83 * MiB / 2, W_FWOUT = 171 * MiB / 2;
constexpr size_t WS_H = 108 * MiB, WS_R = 172 * MiB;
constexpr size_t R_T = WS_R, R_PROJ = WS_R, R_Q = WS_R, R_LATQ = WS_R + 132 * MiB, R_LATKV = WS_R + 180 * MiB, R_O = WS_R + 132 * MiB,
                 R_KR = WS_R + 196 * MiB, R_KN = WS_R + 198 * MiB, R_VT = WS_R + 262 * MiB;
constexpr size_t R_QS = WS_R, R_LOGF = WS_R + 64 * MiB, R_VV = WS_R + 192 * MiB, R_GS = WS_R + 256 * MiB;
constexpr size_t WS_END = WS_R + 326 * MiB;
constexpr int LDS_BYTES = 131072 + 64;
constexpr size_t WS_BAR = WS_LB + 65536;
constexpr size_t WS_RS = WS_LB + 131072;

struct Params {
    const float* x; const float* c; const int* pos;
    const float* mla_qn; const float* mla_kvn; const float* hgrn_lb; const float* hgrn_gn;
    const float* ada_w; const float* ada_b; const float* ln_g; const float* ln_b;
    float* X; unsigned char* ws;
    const float* wsrc[8];
    float invf[16];
    int ph_lo, ph_hi;
};
typedef const __attribute__((address_space(4))) Params* ParamsPtr;
struct WType { int K, N, layers, mode; size_t dst; int drows; };
constexpr WType WT[8] = {
    {1024, 1056, 2, 0, W_MWIN, 1280}, {768, 1536, 2, 0, W_MWQB, 1536}, {256, 2048, 2, 2, W_MWKVB, 2048}, {1024, 1024, 2, 0, W_MWO, 1024},
    {1024, 4096, 2, 0, W_HWIN, 4096}, {1024, 1024, 2, 0, W_HWO, 1024}, {1024, 5632, 4, 1, W_FWIN, 5632}, {2816, 1024, 4, 0, W_FWOUT, 1024} };
constexpr int wt_items(int t) { return (WT[t].K / 64) * (WT[t].N / 32); }
constexpr int wt_total() { int s = 0; for (int t = 0; t < 8; ++t) s += wt_items(t) * WT[t].layers; return s; }

__device__ __forceinline__ unsigned pk2(float lo, float hi) { unsigned r; asm volatile("v_cvt_pk_bf16_f32 %0, %1, %2" : "=v"(r) : "v"(lo), "v"(hi)); return r; }
__device__ __forceinline__ float bf2f(unsigned short h) { return __uint_as_float((unsigned)h << 16); }
__device__ __forceinline__ float wave_sum(float v) {
#pragma unroll
    for (int o = 1; o < 64; o <<= 1) v += __shfl_xor(v, o);
    return v;
}
__device__ __forceinline__ float fast_rcp(float x) { return __builtin_amdgcn_rcpf(x); }
__device__ __forceinline__ float sigmoidf_(float x) { return fast_rcp(1.f + __expf(-x)); }
__device__ __forceinline__ float siluf_(float x) { return x * sigmoidf_(x); }
__device__ __forceinline__ int crow(int r, int hi) { return (r & 3) + 8 * (r >> 2) + 4 * hi; }
__device__ __forceinline__ f32x16 mfma32(bf16x8 a, bf16x8 b, f32x16 c) { return __builtin_amdgcn_mfma_f32_32x32x16_bf16(a, b, c, 0, 0, 0); }

struct EpiProj {
    static constexpr bool PERM = false, AFTER_DRAIN = false;
    float* O; int ldc, ncols;
    __device__ __forceinline__ void operator()(const pg8::f32x4 (&acc)[2][2][4][2], const pg8::Unit& u, int wr, int wc, int fr, int fq) const {
        const int row0 = u.pm * 256 + wr * 64 + fr, col0 = u.pn * 256 + wc * 32 + 4 * fq;
#pragma unroll
        for (int ai = 0; ai < 2; ++ai)
#pragma unroll
            for (int m = 0; m < 4; ++m) { float* rp = O + (size_t)(row0 + ai * 128 + m * 16) * ldc;
#pragma unroll
                for (int bj = 0; bj < 2; ++bj)
#pragma unroll
                    for (int n = 0; n < 2; ++n) { const int c = col0 + bj * 128 + n * 16; if (c < ncols) *(f32x4*)(rp + c) = acc[ai][bj][m][n]; } }
    }
};
struct EpiQ {
    static constexpr bool PERM = false, AFTER_DRAIN = false;
    bf16_t* Q; const float* tab;
    __device__ __forceinline__ void operator()(const pg8::f32x4 (&acc)[2][2][4][2], const pg8::Unit& u, int wr, int wc, int fr, int fq) const {
        const int row0 = u.pm * 256 + wr * 64 + fr;
#pragma unroll
        for (int bj = 0; bj < 2; ++bj) {
            const int c0 = u.pn * 256 + bj * 128 + wc * 32; const bool rope = ((c0 >> 5) % 3) == 2;
#pragma unroll
            for (int ai = 0; ai < 2; ++ai)
#pragma unroll
                for (int m = 0; m < 4; ++m) { const int row = row0 + ai * 128 + m * 16;
                    f32x4 v0 = acc[ai][bj][m][0], v1 = acc[ai][bj][m][1];
                    if (rope) { const f32x4 cs = *(const f32x4*)(tab + (size_t)row * 32 + 4 * fq), sn = *(const f32x4*)(tab + (size_t)row * 32 + 16 + 4 * fq);
                        const f32x4 a = v0 * cs - v1 * sn, b = v0 * sn + v1 * cs; v0 = a; v1 = b; }
                    v0 = v0 * QSCALE; v1 = v1 * QSCALE;
                    bf16_t* qp = Q + (size_t)row * 1536 + c0 + 4 * fq;
                    u32x2 w0, w1; w0.x = pk2(v0[0], v0[1]); w0.y = pk2(v0[2], v0[3]); w1.x = pk2(v1[0], v1[1]); w1.y = pk2(v1[2], v1[3]);
                    *(u32x2*)qp = w0; *(u32x2*)(qp + 16) = w1; }
        }
    }
};
struct EpiBf16 {
    static constexpr bool PERM = true, AFTER_DRAIN = false;
    bf16_t* O; int ldc;
    __device__ __forceinline__ void operator()(const pg8::f32x4 (&acc)[2][2][4][2], const pg8::Unit& u, int wr, int wc, int fr, int fq) const {
        const int row0 = u.pm * 256 + wr * 64 + fr, col0 = u.pn * 256 + wc * 32 + 8 * fq;
#pragma unroll
        for (int ai = 0; ai < 2; ++ai)
#pragma unroll
            for (int m = 0; m < 4; ++m) { bf16_t* rp = O + (size_t)(row0 + ai * 128 + m * 16) * ldc + col0;
#pragma unroll
                for (int bj = 0; bj < 2; ++bj) { const f32x4 a0 = acc[ai][bj][m][0], a1 = acc[ai][bj][m][1];
                    u32x4 w; w.x = pk2(a0[0], a0[1]); w.y = pk2(a0[2], a0[3]); w.z = pk2(a1[0], a1[1]); w.w = pk2(a1[2], a1[3]); *(u32x4*)(rp + bj * 128) = w; } }
    }
};
struct EpiVT {
    static constexpr bool PERM = true, AFTER_DRAIN = false;
    bf16_t* VT;
    __device__ __forceinline__ void operator()(const pg8::f32x4 (&acc)[2][2][4][2], const pg8::Unit& u, int wr, int wc, int fr, int fq) const {
        const int row0 = u.pm * 256 + wr * 64 + fr, tok0 = u.pn * 256 + wc * 32 + 8 * fq;
        bf16_t* base = VT + (size_t)(tok0 >> 11) * (1024 * 2048) + (tok0 & 2047);
#pragma unroll
        for (int ai = 0; ai < 2; ++ai)
#pragma unroll
            for (int m = 0; m < 4; ++m) { bf16_t* rp = base + (size_t)(row0 + ai * 128 + m * 16) * 2048;
#pragma unroll
                for (int bj = 0; bj < 2; ++bj) { const f32x4 a0 = acc[ai][bj][m][0], a1 = acc[ai][bj][m][1];
                    u32x4 w; w.x = pk2(a0[0], a0[1]); w.y = pk2(a0[2], a0[3]); w.z = pk2(a1[0], a1[1]); w.w = pk2(a1[2], a1[3]); *(u32x4*)(rp + bj * 128) = w; } }
    }
};
struct EpiResid {
    static constexpr bool PERM = false, AFTER_DRAIN = false;
    const float* Xin; float* Xout; const float* modrow; const float* RS; const float* g; const float* bta; int raw;
    __device__ __forceinline__ void operator()(const pg8::f32x4 (&acc)[2][2][4][2], const pg8::Unit& u, int wr, int wc, int fr, int fq) const {
        const int row0 = u.pm * 256 + wr * 64 + fr, col0 = u.pn * 256 + wc * 32 + 4 * fq;
        const int b = (u.pm * 256) >> 11; const float* gp = modrow + (size_t)b * 3072 + 2048 + col0;
#pragma unroll
        for (int bj = 0; bj < 2; ++bj)
#pragma unroll
            for (int n = 0; n < 2; ++n) {
                const int c = col0 + bj * 128 + n * 16;
                const f32x4 gt = *(const f32x4*)(gp + bj * 128 + n * 16) + 1.0f;
                f32x4 g4 = (f32x4){1.f, 1.f, 1.f, 1.f}, b4 = (f32x4){0.f, 0.f, 0.f, 0.f};
                if (!raw) { g4 = *(const f32x4*)(g + c); b4 = *(const f32x4*)(bta + c); }
#pragma unroll
                for (int ai = 0; ai < 2; ++ai)
#pragma unroll
                    for (int m = 0; m < 4; ++m) { const int row = row0 + ai * 128 + m * 16;
                        f32x4 xo = *(const f32x4*)(Xin + (size_t)row * 1024 + c);
                        if (!raw) { const float mean = RS[2 * row], rstd = RS[2 * row + 1]; xo = (xo - mean) * rstd * g4 + b4; }
                        *(f32x4*)(Xout + (size_t)row * 1024 + c) = xo * ALPHA + gt * acc[ai][bj][m][n]; }
            }
    }
};
struct EpiSwiGLU {
    static constexpr bool PERM = true, AFTER_DRAIN = false;
    bf16_t* T;
    __device__ __forceinline__ void operator()(const pg8::f32x4 (&acc)[2][2][4][2], const pg8::Unit& u, int wr, int wc, int fr, int fq) const {
        const int row0 = u.pm * 256 + wr * 64 + fr, col0 = u.pn * 128 + wc * 32 + 8 * fq;
#pragma unroll
        for (int ai = 0; ai < 2; ++ai)
#pragma unroll
            for (int m = 0; m < 4; ++m) {
                const f32x4 g0 = acc[ai][0][m][0], g1 = acc[ai][0][m][1], u0 = acc[ai][1][m][0], u1 = acc[ai][1][m][1];
                u32x4 w;
                w.x = pk2(siluf_(g0[0]) * u0[0], siluf_(g0[1]) * u0[1]); w.y = pk2(siluf_(g0[2]) * u0[2], siluf_(g0[3]) * u0[3]);
                w.z = pk2(siluf_(g1[0]) * u1[0], siluf_(g1[1]) * u1[1]); w.w = pk2(siluf_(g1[2]) * u1[2], siluf_(g1[3]) * u1[3]);
                *(u32x4*)(T + (size_t)(row0 + ai * 128 + m * 16) * FF + col0) = w; }
    }
};
struct EpiHgrnIn {
    static constexpr bool PERM = true, AFTER_DRAIN = false;
    bf16_t* QS; float* LOGF; const float* lb;
    __device__ __forceinline__ void operator()(const pg8::f32x4 (&acc)[2][2][4][2], const pg8::Unit& u, int wr, int wc, int fr, int fq) const {
        const int row0 = u.pm * 256 + wr * 64 + fr, region = u.pn >> 2, col0 = (u.pn & 3) * 256 + wc * 32 + 8 * fq;
        if (region == 1) {
#pragma unroll
            for (int bj = 0; bj < 2; ++bj) { const f32x4 l0 = *(const f32x4*)(lb + col0 + bj * 128), l1 = *(const f32x4*)(lb + col0 + bj * 128 + 4);
#pragma unroll
                for (int ai = 0; ai < 2; ++ai)
#pragma unroll
                    for (int m = 0; m < 4; ++m) { float* op = LOGF + (size_t)(row0 + ai * 128 + m * 16) * 1024 + col0 + bj * 128;
                        const f32x4 a0 = acc[ai][bj][m][0], a1 = acc[ai][bj][m][1]; f32x4 r0, r1;
#pragma unroll
                        for (int e = 0; e < 4; ++e) { r0[e] = __log2f(l0[e] + (1.f - l0[e]) * sigmoidf_(a0[e])); r1[e] = __log2f(l1[e] + (1.f - l1[e]) * sigmoidf_(a1[e])); }
                        *(f32x4*)op = r0; *(f32x4*)(op + 4) = r1; } }
        } else {
            bf16_t* base = QS + (size_t)(region == 0 ? 0 : (region == 2 ? (R_VV - R_QS) / 2 : (R_GS - R_QS) / 2)); const bool act = region != 2;
#pragma unroll
            for (int ai = 0; ai < 2; ++ai)
#pragma unroll
                for (int m = 0; m < 4; ++m)
#pragma unroll
                    for (int bj = 0; bj < 2; ++bj) { f32x4 a0 = acc[ai][bj][m][0], a1 = acc[ai][bj][m][1];
                        if (act) {
#pragma unroll
                            for (int e = 0; e < 4; ++e) { a0[e] = siluf_(a0[e]); a1[e] = siluf_(a1[e]); } }
                        u32x4 w; w.x = pk2(a0[0], a0[1]); w.y = pk2(a0[2], a0[3]); w.z = pk2(a1[0], a1[1]); w.w = pk2(a1[2], a1[3]);
                        *(u32x4*)(base + (size_t)(row0 + ai * 128 + m * 16) * 1024 + col0 + bj * 128) = w; }
        }
    }
};

#define XB_TMO      128
#define XB_XCNT(j)  (256  + 64 * (j))
#define XB_XSUB(j)  (1280 + 64 * (j))
#define XB_XGEN(j)  (2304 + 64 * (j))
#define XB_TOP      3328
#define XB_TOPGEN   3392
#define XCD_BAR_WORDS 3456
#define XB_SPIN_CAP (1u << 18)

__device__ __forceinline__ unsigned xb_ld(unsigned* p)              { return __hip_atomic_load(p, __ATOMIC_RELAXED, __HIP_MEMORY_SCOPE_AGENT); }
__device__ __forceinline__ unsigned xb_add(unsigned* p, unsigned v) { return __hip_atomic_fetch_add(p, v, __ATOMIC_RELAXED, __HIP_MEMORY_SCOPE_AGENT); }
__device__ __forceinline__ unsigned xb_xcc_id() { return (unsigned)__builtin_amdgcn_s_getreg((3 << 11) | 20) & 0xFu; }
#define XB_SPIN(cond, bar) do { unsigned _sp = 0; while (cond) { __builtin_amdgcn_s_sleep(1); \
    if ((++_sp & 255u) == 0u) { if (xb_ld(&(bar)[XB_TMO])) break; if (_sp > XB_SPIN_CAP) { atomicAdd(&(bar)[XB_TMO], 1u); break; } } } } while (0)

struct XcdBarrier {
    unsigned* bar; unsigned x;
    volatile LAS unsigned* st;
};

__device__ __forceinline__ XcdBarrier xcd_barrier_post(unsigned* bar, volatile LAS unsigned* st) {
    XcdBarrier b; b.bar = bar; b.x = xb_xcc_id(); b.st = st;
    if (mk_tid() == 0) (void)xb_add(&bar[XB_XCNT(b.x)], 1u);
    return b;
}
__device__ __forceinline__ void xcd_barrier_complete(unsigned* bar, unsigned x, unsigned& nloc, unsigned& nx) {
    const unsigned G = (unsigned)mk_grid();
    unsigned sum, cnt, mine, sp = 0u;
    for (;;) {
        sum = 0u; cnt = 0u; mine = 0u;
#pragma unroll
        for (unsigned j = 0; j < 16; ++j) { const unsigned c = xb_ld(&bar[XB_XCNT(j)]); sum += c; cnt += (c > 0u) ? 1u : 0u; mine = (j == x) ? c : mine; }
        if (sum == G) break;
        __builtin_amdgcn_s_sleep(1);
        if ((++sp & 255u) == 0u) { if (xb_ld(&bar[XB_TMO])) break; if (sp > XB_SPIN_CAP) { atomicAdd(&bar[XB_TMO], 1u); break; } }
    }
    nloc = mine > 0u ? mine : 1u; nx = cnt > 0u ? cnt : 1u;
}

__device__ __forceinline__ void xcd_barrier(const XcdBarrier& b) {
    asm volatile("s_waitcnt vmcnt(0)" ::: "memory");
    __syncthreads();
    if (mk_tid() == 0) {
        unsigned* bar = b.bar;
        __builtin_amdgcn_s_waitcnt(0);
        unsigned nloc = b.st[0], nx = b.st[1];
        if (nloc == 0u) { xcd_barrier_complete(bar, b.x, nloc, nx); b.st[0] = nloc; b.st[1] = nx; }
        const unsigned old = xb_add(&bar[XB_XSUB(b.x)], 1u);
        const unsigned gen = old / nloc;
        if (old + 1u == (gen + 1u) * nloc) {
            __builtin_amdgcn_fence(__ATOMIC_RELEASE, "agent");
            asm volatile("s_waitcnt vmcnt(0)" ::: "memory");
            const unsigned og = xb_add(&bar[XB_TOP], 1u);
            const unsigned tg = og / nx;
            if (og + 1u == (tg + 1u) * nx) xb_add(&bar[XB_TOPGEN], 1u);
            else XB_SPIN(xb_ld(&bar[XB_TOPGEN]) == tg, bar);
            __builtin_amdgcn_fence(__ATOMIC_ACQUIRE, "agent");
            xb_add(&bar[XB_XGEN(b.x)], 1u);
            asm volatile("s_waitcnt vmcnt(0)" ::: "memory");
        } else {
            XB_SPIN(xb_ld(&bar[XB_XGEN(b.x)]) == gen, bar);
            __builtin_amdgcn_fence(__ATOMIC_ACQUIRE, "agent");
            asm volatile("s_waitcnt vmcnt(0)" ::: "memory");
        }
    }
    __syncthreads();
}


__device__ __forceinline__ void transpose_item(const float* W, bf16_t* dst, int K, int N, int mode, int item, LAS float* scr, int lane) {
    const int nblk = N / 32, kb = item / nblk, nb = item % nblk, k0 = 64 * kb, n0 = 32 * nb;
    int drow0 = n0;
    if (mode == 1) { const int up = n0 >= FF, j0 = up ? n0 - FF : n0; drow0 = 256 * (j0 >> 7) + (up ? 128 : 0) + (j0 & 127); }
    if (mode == 2) { const int h = n0 >> 7, r = n0 & 127; drow0 = (r < 64) ? h * 64 + r : 1024 + h * 64 + (r - 64); }
    { float t[32];
#pragma unroll
      for (int i = 0; i < 32; ++i) t[i] = W[(size_t)(k0 + 2 * i + (lane >> 5)) * N + n0 + (lane & 31)];
#pragma unroll
      for (int i = 0; i < 32; ++i) scr[(2 * i + (lane >> 5)) * 33 + (lane & 31)] = t[i]; }
    asm volatile("s_waitcnt lgkmcnt(0)" ::: "memory");
    const int c = lane & 7;
#pragma unroll
    for (int j = 0; j < 4; ++j) { const int n = (lane >> 3) + 8 * j; const LAS float* s = scr + (8 * c) * 33 + n;
        u32x4 o; o.x = pk2(s[0 * 33], s[1 * 33]); o.y = pk2(s[2 * 33], s[3 * 33]); o.z = pk2(s[4 * 33], s[5 * 33]); o.w = pk2(s[6 * 33], s[7 * 33]);
        *(u32x4*)(dst + (size_t)(drow0 + n) * K + k0 + 8 * c) = o; }
    asm volatile("s_waitcnt lgkmcnt(0)" ::: "memory");
}

__device__ __forceinline__ void prologue_phase(ParamsPtr pp, LAS unsigned char* lds) {
    const ParamsPtr p_ = pp;
#define p (*p_)
    const int tid = mk_tid(), lane = tid & 63, wave = __builtin_amdgcn_readfirstlane(tid >> 6);
    const int G = mk_grid();
    {
        LAS float* sc = (LAS float*)lds;
        LAS float* red = (LAS float*)(lds + 65536);
        for (int i = tid; i < NB * DM; i += 512) { const int b = i >> 10, k = i & 1023; const float v = p.c[i]; sc[k * 16 + b] = v / (1.f + __expf(-v)); }
        __syncthreads();
        float* MOD = (float*)(p.ws + WS_MOD);
        for (int it = mk_bid(); it < 8 * 48; it += G) {
            const int ls = it / 48, n0 = (it % 48) * 64, col = tid & 63, kg = tid >> 6;
            const float* W = p.ada_w + (size_t)ls * 1024 * 3072 + (size_t)(kg * 128) * 3072 + n0 + col;
            float acc[16];
#pragma unroll
            for (int b = 0; b < 16; ++b) acc[b] = 0.f;
#pragma unroll 16
            for (int k = 0; k < 128; ++k) { const float w = W[(size_t)k * 3072]; const LAS f32x4* s4 = (const LAS f32x4*)(sc + (kg * 128 + k) * 16);
#pragma unroll
                for (int q = 0; q < 4; ++q) { const f32x4 s = s4[q]; acc[4 * q + 0] += s[0] * w; acc[4 * q + 1] += s[1] * w; acc[4 * q + 2] += s[2] * w; acc[4 * q + 3] += s[3] * w; } }
#pragma unroll
            for (int q = 0; q < 4; ++q) *(LAS f32x4*)(red + (kg * 64 + col) * 16 + 4 * q) = (f32x4){acc[4 * q], acc[4 * q + 1], acc[4 * q + 2], acc[4 * q + 3]};
            __syncthreads();
            { const int b0 = 2 * kg;
#pragma unroll
              for (int bb = 0; bb < 2; ++bb) { float s = 0.f;
#pragma unroll
                  for (int g = 0; g < 8; ++g) s += red[(g * 64 + col) * 16 + b0 + bb];
                  MOD[((size_t)ls * 16 + b0 + bb) * 3072 + n0 + col] = s + p.ada_b[ls * 3072 + n0 + col]; } }
            __syncthreads();
        }
    }
    if (mk_bid() == 0) {
        float* LB = (float*)(p.ws + WS_LB);
        for (int cidx = tid; cidx < 1024; cidx += 512) { const float a0 = p.hgrn_lb[cidx], a1 = p.hgrn_lb[1024 + cidx], mx = fmaxf(a0, a1);
            const float e0 = expf(a0 - mx), e1 = expf(a1 - mx), s0 = e0 / (e0 + e1), s1 = e1 / (e0 + e1);
            LB[cidx] = s0 - s0; LB[1024 + cidx] = (s0 + s1) - s0; }
    }
    {
        float* TAB = (float*)(p.ws + WS_TAB);
        for (int gi = mk_bid() * 512 + tid; gi < M_TOK * 16; gi += G * 512) {
            const int m = gi >> 4, i = gi & 15; const float ang = (float)p.pos[m] * p.invf[i];
            const double r = (double)ang, q = rint(r * 0.63661977236758134308), t = fma(-q, 1.57079632679489661923, r), t2 = t * t;
            const double s = t * (1.0 + t2 * (-1.0 / 6 + t2 * (1.0 / 120 + t2 * (-1.0 / 5040 + t2 * (1.0 / 362880 + t2 * (-1.0 / 39916800 + t2 * (1.0 / 6227020800.0)))))));
            const double c = 1.0 + t2 * (-0.5 + t2 * (1.0 / 24 + t2 * (-1.0 / 720 + t2 * (1.0 / 40320 + t2 * (-1.0 / 3628800 + t2 * (1.0 / 479001600.0))))));
            const int qi = ((int)q) & 3; double cc, ss;
            if (qi == 0) { cc = c; ss = s; } else if (qi == 1) { cc = -s; ss = c; } else if (qi == 2) { cc = -c; ss = -s; } else { cc = s; ss = -c; }
            TAB[(size_t)m * 32 + i] = (float)cc; TAB[(size_t)m * 32 + 16 + i] = (float)ss; }
    }
    {
        for (int gi = mk_bid() * 512 + tid; gi < 2 * 224 * 128; gi += G * 512) { const int l = gi / (224 * 128), r = gi % (224 * 128);
            *(u32x4*)(p.ws + W_MWIN + (size_t)l * 1280 * 1024 * 2 + (size_t)1056 * 1024 * 2 + (size_t)r * 16) = (u32x4){0u, 0u, 0u, 0u}; }
    }
    __syncthreads();
    {
        LAS float* scr = (LAS float*)(lds + wave * 8448);
        const int gw = mk_bid() * 8 + wave, NGW = G * 8;
        for (int it = gw; it < wt_total(); it += NGW) {
            int r = it;
#pragma unroll
            for (int t = 0; t < 8; ++t) {
                const int ni = wt_items(t) * WT[t].layers;
                if (r >= 0 && r < ni) { const int l = r / wt_items(t), item = r % wt_items(t);
                    transpose_item(p.wsrc[t] + (size_t)l * WT[t].K * WT[t].N, (bf16_t*)(p.ws + WT[t].dst) + (size_t)l * WT[t].drows * WT[t].K, WT[t].K, WT[t].N, WT[t].mode, item, scr, lane); }
                r -= ni;
            }
        }
    }
}

#undef p
__device__ __forceinline__ void norm_phase(const float* src, float* dst, bool do_ln, bool write_x, const float* g, const float* bta, float* RS, bool do_h, const float* modrow, bf16_t* H) {
    const int tid_ = mk_tid(), lane = tid_ & 63, wave = __builtin_amdgcn_readfirstlane(tid_ >> 6); const int gw = mk_bid() * 8 + wave, NGW = mk_grid() * 8;
    for (int m0 = gw * 4; m0 < M_TOK; m0 += NGW * 4) {
        const int b = m0 >> 11;
        f32x4 v[4][4];
#pragma unroll
        for (int r = 0; r < 4; ++r) { const f32x4* xr = (const f32x4*)(src + (size_t)(m0 + r) * 1024) + lane;
#pragma unroll
            for (int j = 0; j < 4; ++j) v[r][j] = xr[64 * j]; }
        if (do_ln) {
            float s[4];
#pragma unroll
            for (int r = 0; r < 4; ++r) { s[r] = 0.f;
#pragma unroll
                for (int j = 0; j < 4; ++j) s[r] += (v[r][j][0] + v[r][j][1]) + (v[r][j][2] + v[r][j][3]); }
#pragma unroll
            for (int o = 1; o < 64; o <<= 1) {
#pragma unroll
                for (int r = 0; r < 4; ++r) s[r] += __shfl_xor(s[r], o); }
            float mean[4], s2[4];
#pragma unroll
            for (int r = 0; r < 4; ++r) { mean[r] = s[r] * (1.f / 1024.f); s2[r] = 0.f;
#pragma unroll
                for (int j = 0; j < 4; ++j) { v[r][j] = v[r][j] - mean[r]; s2[r] += (v[r][j][0] * v[r][j][0] + v[r][j][1] * v[r][j][1]) + (v[r][j][2] * v[r][j][2] + v[r][j][3] * v[r][j][3]); } }
#pragma unroll
            for (int o = 1; o < 64; o <<= 1) {
#pragma unroll
                for (int r = 0; r < 4; ++r) s2[r] += __shfl_xor(s2[r], o); }
#pragma unroll
            for (int r = 0; r < 4; ++r) { const float rstd = 1.0f / sqrtf(s2[r] * (1.f / 1024.f) + LN_EPS);
                if (lane == 0) { RS[2 * (m0 + r)] = mean[r]; RS[2 * (m0 + r) + 1] = rstd; }
#pragma unroll
                for (int j = 0; j < 4; ++j) v[r][j] = v[r][j] * rstd; }
#pragma unroll
            for (int j = 0; j < 4; ++j) { const f32x4 gg = *((const f32x4*)g + lane + 64 * j), bb = *((const f32x4*)bta + lane + 64 * j);
#pragma unroll
                for (int r = 0; r < 4; ++r) v[r][j] = v[r][j] * gg + bb; }
        }
        if (write_x) {
#pragma unroll
            for (int r = 0; r < 4; ++r) { f32x4* xo = (f32x4*)(dst + (size_t)(m0 + r) * 1024) + lane;
#pragma unroll
                for (int j = 0; j < 4; ++j) xo[64 * j] = v[r][j]; } }
        if (do_h) { const f32x4* sh = (const f32x4*)(modrow + (size_t)b * 3072) + lane; const f32x4* sc = (const f32x4*)(modrow + (size_t)b * 3072 + 1024) + lane;
#pragma unroll
            for (int j = 0; j < 4; ++j) { const f32x4 s1 = sc[64 * j] + 1.0f, s0 = sh[64 * j];
#pragma unroll
                for (int r = 0; r < 4; ++r) { const f32x4 h = v[r][j] * s1 + s0; u32x2 w; w.x = pk2(h[0], h[1]); w.y = pk2(h[2], h[3]); *((u32x2*)(H + (size_t)(m0 + r) * 1024) + lane + 64 * j) = w; } } }
    }
}

__device__ __forceinline__ void latnorm_phase(const float* PROJ, const float* qn, const float* kvn, const float* tab, bf16_t* LATQ, bf16_t* LATKV, bf16_t* KR) {
    const int tid_ = mk_tid(), lane = tid_ & 63, wave = __builtin_amdgcn_readfirstlane(tid_ >> 6); const int gw = mk_bid() * 8 + wave, NGW = mk_grid() * 8;
    for (int m0 = gw * 4; m0 < M_TOK; m0 += NGW * 4) {
        f32x4 v[4][3], kv[4]; float s[4], s2[4], x1[4], x2[4];
#pragma unroll
        for (int r = 0; r < 4; ++r) { const float* pr = PROJ + (size_t)(m0 + r) * 1056;
#pragma unroll
            for (int j = 0; j < 3; ++j) v[r][j] = *((const f32x4*)pr + lane + 64 * j);
            kv[r] = *((const f32x4*)(pr + 768) + lane); x1[r] = pr[1024 + (lane & 15)]; x2[r] = pr[1040 + (lane & 15)]; }
#pragma unroll
        for (int r = 0; r < 4; ++r) { s[r] = 0.f;
#pragma unroll
            for (int j = 0; j < 3; ++j) s[r] += (v[r][j][0] * v[r][j][0] + v[r][j][1] * v[r][j][1]) + (v[r][j][2] * v[r][j][2] + v[r][j][3] * v[r][j][3]);
            s2[r] = (kv[r][0] * kv[r][0] + kv[r][1] * kv[r][1]) + (kv[r][2] * kv[r][2] + kv[r][3] * kv[r][3]); }
#pragma unroll
        for (int o = 1; o < 64; o <<= 1) {
#pragma unroll
            for (int r = 0; r < 4; ++r) { s[r] += __shfl_xor(s[r], o); s2[r] += __shfl_xor(s2[r], o); } }
#pragma unroll
        for (int r = 0; r < 4; ++r) { const int m = m0 + r;
            const float rq = 1.0f / sqrtf(s[r] * (1.f / 768.f) + RMS_EPS), rkv = 1.0f / sqrtf(s2[r] * (1.f / 256.f) + RMS_EPS);
#pragma unroll
            for (int j = 0; j < 3; ++j) { const f32x4 gg = *((const f32x4*)qn + lane + 64 * j); const f32x4 o = v[r][j] * rq * gg; u32x2 w; w.x = pk2(o[0], o[1]); w.y = pk2(o[2], o[3]);
                *((u32x2*)(LATQ + (size_t)m * 768) + lane + 64 * j) = w; }
            { const f32x4 gg = *((const f32x4*)kvn + lane); const f32x4 o = kv[r] * rkv * gg; u32x2 w; w.x = pk2(o[0], o[1]); w.y = pk2(o[2], o[3]); *((u32x2*)(LATKV + (size_t)m * 256) + lane) = w; }
            if (lane < 16) { const float cs = tab[(size_t)m * 32 + lane], sn = tab[(size_t)m * 32 + 16 + lane];
                const unsigned w = pk2(x1[r] * cs - x2[r] * sn, x1[r] * sn + x2[r] * cs); KR[(size_t)m * 32 + lane] = (bf16_t)(w & 0xffff); KR[(size_t)m * 32 + 16 + lane] = (bf16_t)(w >> 16); } }
    }
}

__device__ __forceinline__ void attn_phase(LAS unsigned char* lds, const bf16_t* Q, const bf16_t* KN, const bf16_t* KR, const bf16_t* VT, bf16_t* O) {
    constexpr int KPB = 208, VPB = 144, KSB = 64 * KPB, VSB = 64 * VPB;
    const int tid = mk_tid(), lane = tid & 63, wave = __builtin_amdgcn_readfirstlane(tid >> 6), q = lane & 31, g = lane >> 5;
    const unsigned kn_dst = (tid >> 3) * KPB + (tid & 7) * 16, kr_dst = (tid >> 2) * KPB + 128 + (tid & 3) * 16, vt_dst = 2 * KSB + (tid >> 3) * VPB + (tid & 7) * 16;
    for (int bh = mk_bid(); bh < 256; bh += mk_grid()) {
        const int b = bh >> 4, h = bh & 15;
        const bf16_t* kn_src = KN + (size_t)(b * 2048 + (tid >> 3)) * 1024 + h * 64 + (tid & 7) * 8;
        const bf16_t* kr_src = KR + (size_t)(b * 2048 + (tid >> 2)) * 32 + (tid & 3) * 8;
        const bf16_t* vt_src = VT + (size_t)(bh * 64 + (tid >> 3)) * 2048 + (tid & 7) * 8;
#pragma unroll 1
        for (int qb = 7; qb >= 0; --qb) {
            __syncthreads();
            const int r0 = qb * 256 + wave * 32, ntile = 4 * (qb + 1);
            bf16x8 qf[6];
            { const bf16_t* qp = Q + (size_t)(b * 2048 + r0 + q) * 1536 + h * 96 + g * 8;
#pragma unroll
              for (int ks = 0; ks < 6; ++ks) qf[ks] = *(const bf16x8*)(qp + ks * 16); }
            f32x16 o0, o1;
#pragma unroll
            for (int i = 0; i < 16; ++i) { o0[i] = 0.f; o1[i] = 0.f; }
            float mrow = -INFINITY, lrow = 0.f;
            u32x4 rk, rr, rv;
            rk = *(const u32x4*)kn_src; rv = *(const u32x4*)vt_src; if (tid < 256) rr = *(const u32x4*)kr_src;
            *(LAS u32x4*)(lds + kn_dst) = rk; *(LAS u32x4*)(lds + vt_dst) = rv; if (tid < 256) *(LAS u32x4*)(lds + kr_dst) = rr;
            __syncthreads();
#pragma unroll 1
            for (int j = 0; j < ntile; ++j) {
                const int cur = j & 1; const bool more = (j + 1 < ntile);
                if (more) { rk = *(const u32x4*)(kn_src + (size_t)(j + 1) * 64 * 1024); rv = *(const u32x4*)(vt_src + (j + 1) * 64); if (tid < 256) rr = *(const u32x4*)(kr_src + (size_t)(j + 1) * 64 * 32); }
                if (64 * j <= r0 + 31) {
                    const LAS unsigned char* kb_ = lds + cur * KSB; const LAS unsigned char* vb_ = lds + 2 * KSB + cur * VSB;
                    f32x16 s0, s1;
#pragma unroll
                    for (int i = 0; i < 16; ++i) { s0[i] = 0.f; s1[i] = 0.f; }
#pragma unroll
                    for (int ks = 0; ks < 6; ++ks) {
                        const bf16x8 a0 = *(const LAS bf16x8*)(kb_ + q * KPB + (ks * 16 + g * 8) * 2), a1 = *(const LAS bf16x8*)(kb_ + (32 + q) * KPB + (ks * 16 + g * 8) * 2);
                        s0 = mfma32(a0, qf[ks], s0); s1 = mfma32(a1, qf[ks], s1); }
                    if (64 * j + 63 > r0) { const int qa = r0 + q, k0 = 64 * j + 4 * g;
#pragma unroll
                        for (int i = 0; i < 16; ++i) { const int key = k0 + (i & 3) + 8 * (i >> 2); if (key > qa) s0[i] = -INFINITY; if (key + 32 > qa) s1[i] = -INFINITY; } }
                    float mx = fmaxf(s0[0], s1[0]);
#pragma unroll
                    for (int i = 1; i < 16; ++i) mx = fmaxf(mx, fmaxf(s0[i], s1[i]));
                    mx = fmaxf(mx, __shfl_xor(mx, 32));
                    const float mnew = fmaxf(mrow, mx), alpha = __builtin_amdgcn_exp2f(mrow - mnew); mrow = mnew;
                    float sum = 0.f;
#pragma unroll
                    for (int i = 0; i < 16; ++i) { s0[i] = __builtin_amdgcn_exp2f(s0[i] - mnew); s1[i] = __builtin_amdgcn_exp2f(s1[i] - mnew); sum += s0[i] + s1[i]; }
                    lrow = lrow * alpha + sum;
#pragma unroll
                    for (int i = 0; i < 16; ++i) { o0[i] *= alpha; o1[i] *= alpha; }
#pragma unroll
                    for (int kb = 0; kb < 2; ++kb)
#pragma unroll
                        for (int t2 = 0; t2 < 2; ++t2) {
                            u32x4 pw;
                            if (kb == 0) { pw.x = pk2(s0[8 * t2 + 0], s0[8 * t2 + 1]); pw.y = pk2(s0[8 * t2 + 2], s0[8 * t2 + 3]); pw.z = pk2(s0[8 * t2 + 4], s0[8 * t2 + 5]); pw.w = pk2(s0[8 * t2 + 6], s0[8 * t2 + 7]); }
                            else         { pw.x = pk2(s1[8 * t2 + 0], s1[8 * t2 + 1]); pw.y = pk2(s1[8 * t2 + 2], s1[8 * t2 + 3]); pw.z = pk2(s1[8 * t2 + 4], s1[8 * t2 + 5]); pw.w = pk2(s1[8 * t2 + 6], s1[8 * t2 + 7]); }
                            const bf16x8 pb = __builtin_bit_cast(bf16x8, pw);
                            const int ko = (32 * kb + 16 * t2 + 4 * g) * 2;
                            { const u32x2 lo = *(const LAS u32x2*)(vb_ + q * VPB + ko), hi = *(const LAS u32x2*)(vb_ + q * VPB + ko + 16);
                              const u32x4 av = (u32x4){lo.x, lo.y, hi.x, hi.y}; o0 = mfma32(__builtin_bit_cast(bf16x8, av), pb, o0); }
                            { const u32x2 lo = *(const LAS u32x2*)(vb_ + (32 + q) * VPB + ko), hi = *(const LAS u32x2*)(vb_ + (32 + q) * VPB + ko + 16);
                              const u32x4 av = (u32x4){lo.x, lo.y, hi.x, hi.y}; o1 = mfma32(__builtin_bit_cast(bf16x8, av), pb, o1); }
                        }
                }
                if (more) { const unsigned bo = (cur ^ 1) * KSB, vo = (cur ^ 1) * VSB;
                    *(LAS u32x4*)(lds + bo + kn_dst) = rk; *(LAS u32x4*)(lds + vo + vt_dst) = rv; if (tid < 256) *(LAS u32x4*)(lds + bo + kr_dst) = rr; }
                __syncthreads();
            }
            const float lt = lrow + __shfl_xor(lrow, 32), inv = 1.0f / lt;
            bf16_t* op = O + (size_t)(b * 2048 + r0 + q) * 1024 + h * 64 + 4 * g;
#pragma unroll
            for (int qd = 0; qd < 4; ++qd) {
                u32x2 w0, w1; w0.x = pk2(o0[4 * qd] * inv, o0[4 * qd + 1] * inv); w0.y = pk2(o0[4 * qd + 2] * inv, o0[4 * qd + 3] * inv);
                w1.x = pk2(o1[4 * qd] * inv, o1[4 * qd + 1] * inv); w1.y = pk2(o1[4 * qd + 2] * inv, o1[4 * qd + 3] * inv);
                *(u32x2*)(op + 8 * qd) = w0; *(u32x2*)(op + 32 + 8 * qd) = w1; }
        }
    }
}

__device__ __forceinline__ void hgrn_phase(LAS unsigned char* lds, const bf16_t* QS, const float* LOGF, const bf16_t* VV, const bf16_t* GS, const float* gn, bf16_t* OG) {
    constexpr int QP = 0, KPN = 8704, KPT = 17408, VTT = 27648, SST = 37888, OPART = 72704, GSUM = 106496, ELAST = 108544;
    const int tid = mk_tid(), lane = tid & 63, wave = __builtin_amdgcn_readfirstlane(tid >> 6), q = lane & 31, g = lane >> 5;
    const int ch = tid & 127, tg = tid >> 7, vb = wave & 3, kh = wave >> 2;
    const int dt = tid >> 4, dpart = tid & 15;
    for (int bh = mk_bid(); bh < 128; bh += mk_grid()) {
        const int b = bh >> 3, hh = bh & 7;
        __syncthreads();
        f32x16 st0, st1;
#pragma unroll
        for (int i = 0; i < 16; ++i) { st0[i] = 0.f; st1[i] = 0.f; }
        const size_t ebase = (size_t)(b * 2048 + 8 * tg) * 1024 + hh * 128 + ch;
        const size_t dbase = (size_t)(b * 2048 + dt) * 1024 + hh * 128 + 8 * dpart;
        f32x4 gn0 = *(const f32x4*)(gn + 8 * dpart), gn1 = *(const f32x4*)(gn + 8 * dpart + 4);
        float lf[8]; unsigned short qs[8], vv[8];
#pragma unroll
        for (int i = 0; i < 8; ++i) { lf[i] = LOGF[ebase + (size_t)i * 1024]; qs[i] = QS[ebase + (size_t)i * 1024]; vv[i] = VV[ebase + (size_t)i * 1024]; }
        u32x4 gsv_next = *(const u32x4*)(GS + dbase);
#pragma unroll 1
        for (int c = 0; c < 64; ++c) {
            float cs[8]; cs[0] = lf[0];
#pragma unroll
            for (int i = 1; i < 8; ++i) cs[i] = cs[i - 1] + lf[i];
            *(LAS float*)(lds + GSUM + (tg * 128 + ch) * 4) = cs[7];
            __syncthreads();
            float off = 0.f, tot = 0.f;
#pragma unroll
            for (int t = 0; t < 4; ++t) { const float gs_ = *(const LAS float*)(lds + GSUM + (t * 128 + ch) * 4); if (t < tg) off += gs_; tot += gs_; }
            {
                unsigned kt[4], vt[4];
#pragma unroll
                for (int i = 0; i < 8; i += 2) {
                    const float b0 = off + cs[i], b1 = off + cs[i + 1];
                    const float q0 = bf2f(qs[i]) * __builtin_amdgcn_exp2f(b0), q1 = bf2f(qs[i + 1]) * __builtin_amdgcn_exp2f(b1);
                    const float k0 = (1.f - __builtin_amdgcn_exp2f(lf[i])) * __builtin_amdgcn_exp2f(-b0), k1 = (1.f - __builtin_amdgcn_exp2f(lf[i + 1])) * __builtin_amdgcn_exp2f(-b1);
                    const unsigned qw = pk2(q0, q1), kw = pk2(k0, k1);
                    *(LAS unsigned short*)(lds + QP + (8 * tg + i) * 272 + ch * 2) = (unsigned short)(qw & 0xffff);
                    *(LAS unsigned short*)(lds + QP + (8 * tg + i + 1) * 272 + ch * 2) = (unsigned short)(qw >> 16);
                    *(LAS unsigned short*)(lds + KPN + (8 * tg + i) * 272 + ch * 2) = (unsigned short)(kw & 0xffff);
                    *(LAS unsigned short*)(lds + KPN + (8 * tg + i + 1) * 272 + ch * 2) = (unsigned short)(kw >> 16);
                    kt[i >> 1] = kw; vt[i >> 1] = (unsigned)vv[i] | ((unsigned)vv[i + 1] << 16);
                }
                *(LAS u32x4*)(lds + KPT + ch * 80 + tg * 16) = (u32x4){kt[0], kt[1], kt[2], kt[3]};
                *(LAS u32x4*)(lds + VTT + ch * 80 + tg * 16) = (u32x4){vt[0], vt[1], vt[2], vt[3]};
                if (tg == 3) *(LAS float*)(lds + ELAST + ch * 4) = __builtin_amdgcn_exp2f(tot);
            }
#pragma unroll
            for (int qd = 0; qd < 4; ++qd) {
                u32x2 w0, w1; w0.x = pk2(st0[4 * qd], st0[4 * qd + 1]); w0.y = pk2(st0[4 * qd + 2], st0[4 * qd + 3]); w1.x = pk2(st1[4 * qd], st1[4 * qd + 1]); w1.y = pk2(st1[4 * qd + 2], st1[4 * qd + 3]);
                *(LAS u32x2*)(lds + SST + (32 * vb + q) * 272 + (32 * (2 * kh) + 8 * qd + 4 * g) * 2) = w0;
                *(LAS u32x2*)(lds + SST + (32 * vb + q) * 272 + (32 * (2 * kh + 1) + 8 * qd + 4 * g) * 2) = w1; }
            __syncthreads();
            const u32x4 gsv = gsv_next;
            if (c + 1 < 64) { const size_t e2 = ebase + (size_t)(c + 1) * 32 * 1024;
                gsv_next = *(const u32x4*)(GS + dbase + (size_t)(c + 1) * 32 * 1024);
#pragma unroll
                for (int i = 0; i < 8; ++i) { lf[i] = LOGF[e2 + (size_t)i * 1024]; qs[i] = QS[e2 + (size_t)i * 1024]; vv[i] = VV[e2 + (size_t)i * 1024]; } }
            {
                f32x16 oT;
#pragma unroll
                for (int i = 0; i < 16; ++i) oT[i] = 0.f;
#pragma unroll
                for (int ks = 0; ks < 4; ++ks) { const int k0 = (64 * kh + 16 * ks + 8 * g) * 2;
                    oT = mfma32(*(const LAS bf16x8*)(lds + SST + (32 * vb + q) * 272 + k0), *(const LAS bf16x8*)(lds + QP + q * 272 + k0), oT); }
                if (kh == 0) {
                    f32x16 aT;
#pragma unroll
                    for (int i = 0; i < 16; ++i) aT[i] = 0.f;
#pragma unroll
                    for (int ks = 0; ks < 8; ++ks) { const int k0 = (16 * ks + 8 * g) * 2;
                        aT = mfma32(*(const LAS bf16x8*)(lds + KPN + q * 272 + k0), *(const LAS bf16x8*)(lds + QP + q * 272 + k0), aT); }
#pragma unroll
                    for (int i = 0; i < 16; ++i) { const int s = (i & 3) + 8 * (i >> 2) + 4 * g; if (s > q) aT[i] = 0.f; }
#pragma unroll
                    for (int t2 = 0; t2 < 2; ++t2) {
                        u32x4 pw; pw.x = pk2(aT[8 * t2 + 0], aT[8 * t2 + 1]); pw.y = pk2(aT[8 * t2 + 2], aT[8 * t2 + 3]); pw.z = pk2(aT[8 * t2 + 4], aT[8 * t2 + 5]); pw.w = pk2(aT[8 * t2 + 6], aT[8 * t2 + 7]);
                        const int so = (16 * t2 + 4 * g) * 2;
                        const u32x2 lo = *(const LAS u32x2*)(lds + VTT + (32 * vb + q) * 80 + so), hi = *(const LAS u32x2*)(lds + VTT + (32 * vb + q) * 80 + so + 16);
                        const u32x4 av = (u32x4){lo.x, lo.y, hi.x, hi.y};
                        oT = mfma32(__builtin_bit_cast(bf16x8, av), __builtin_bit_cast(bf16x8, pw), oT); }
                }
#pragma unroll
                for (int qd = 0; qd < 4; ++qd) *(LAS f32x4*)(lds + OPART + kh * 16896 + q * 528 + (32 * vb + 8 * qd + 4 * g) * 4) = (f32x4){oT[4 * qd], oT[4 * qd + 1], oT[4 * qd + 2], oT[4 * qd + 3]};
            }
#pragma unroll
            for (int t2 = 0; t2 < 2; ++t2) { const int so = (16 * t2 + 8 * g) * 2; const bf16x8 bv = *(const LAS bf16x8*)(lds + VTT + (32 * vb + q) * 80 + so);
                st0 = mfma32(*(const LAS bf16x8*)(lds + KPT + (32 * (2 * kh) + q) * 80 + so), bv, st0);
                st1 = mfma32(*(const LAS bf16x8*)(lds + KPT + (32 * (2 * kh + 1) + q) * 80 + so), bv, st1); }
#pragma unroll
            for (int qd = 0; qd < 4; ++qd) { const f32x4 e0 = *(const LAS f32x4*)(lds + ELAST + (32 * (2 * kh) + 8 * qd + 4 * g) * 4), e1 = *(const LAS f32x4*)(lds + ELAST + (32 * (2 * kh + 1) + 8 * qd + 4 * g) * 4);
#pragma unroll
                for (int e = 0; e < 4; ++e) { st0[4 * qd + e] *= e0[e]; st1[4 * qd + e] *= e1[e]; } }
            __syncthreads();
            {
                const LAS float* o0p = (const LAS float*)(lds + OPART + dt * 528 + dpart * 32); const LAS float* o1p = (const LAS float*)(lds + OPART + 16896 + dt * 528 + dpart * 32);
                const f32x4 a0 = *(const LAS f32x4*)o0p + *(const LAS f32x4*)o1p, a1 = *(const LAS f32x4*)(o0p + 4) + *(const LAS f32x4*)(o1p + 4);
                float ss = (a0[0] * a0[0] + a0[1] * a0[1]) + (a0[2] * a0[2] + a0[3] * a0[3]) + (a1[0] * a1[0] + a1[1] * a1[1]) + (a1[2] * a1[2] + a1[3] * a1[3]);
                ss += __shfl_xor(ss, 1); ss += __shfl_xor(ss, 2); ss += __shfl_xor(ss, 4); ss += __shfl_xor(ss, 8);
                const float rstd = __builtin_amdgcn_rsqf(ss * (1.f / 128.f) + RMS_EPS);
                const f32x4 r0 = a0 * rstd * gn0, r1 = a1 * rstd * gn1;
                u32x4 w;
                w.x = pk2(r0[0] * bf2f((unsigned short)(gsv.x & 0xffff)), r0[1] * bf2f((unsigned short)(gsv.x >> 16)));
                w.y = pk2(r0[2] * bf2f((unsigned short)(gsv.y & 0xffff)), r0[3] * bf2f((unsigned short)(gsv.y >> 16)));
                w.z = pk2(r1[0] * bf2f((unsigned short)(gsv.z & 0xffff)), r1[1] * bf2f((unsigned short)(gsv.z >> 16)));
                w.w = pk2(r1[2] * bf2f((unsigned short)(gsv.w & 0xffff)), r1[3] * bf2f((unsigned short)(gsv.w >> 16)));
                *(u32x4*)(OG + dbase + (size_t)c * 32 * 1024) = w;
            }
        }
    }
}

constexpr int N_PHASES = 34;
template <class Epi>
__device__ __forceinline__ void run_gemm(LAS unsigned char* lds, const bf16_t* A, const bf16_t* Bt, int N, int K, const Epi& E) {
    asm volatile("" : "+s"(K), "+s"(N));
    pg8::Gemm g{A, Bt, M_TOK, N, K}; pg8::StaticOrder S; S.init(M_TOK, N, mk_grid(), mk_bid());
    pg8::gemm_phase<Epi, pg8::StaticOrder, true, true>((PG8_LAS unsigned char*)lds, g, S, E);
}

template <class Epi>
__device__ __forceinline__ void run_gemm_t(LAS unsigned char* lds, const bf16_t* A, const bf16_t* Bt, int K, const Epi& E) {
    asm volatile("" : "+s"(K));
    pg8::Gemm g{A, Bt, 1024, M_TOK, K}; pg8::StaticOrder S; S.init(1024, M_TOK, mk_grid(), mk_bid());
    pg8::gemm_phase<Epi, pg8::StaticOrder, true, true>((PG8_LAS unsigned char*)lds, g, S, E);
}

__global__ void __launch_bounds__(512, 2) fwd_megakernel(Params p) {
    extern __shared__ __attribute__((aligned(16))) unsigned char lds_raw[];
    LAS unsigned char* lds = (LAS unsigned char*)lds_raw;
    cg::grid_group grid = cg::this_grid();
    const int ph_lo = p.ph_lo, ph_hi = p.ph_hi;
    if (mk_tid() < 16) ((volatile LAS unsigned*)(lds + 131072))[mk_tid()] = 0u;
    __syncthreads();
    const XcdBarrier bar = xcd_barrier_post((unsigned*)(p.ws + WS_BAR), (volatile LAS unsigned*)(lds + 131072));
#if defined(PROBE_TIME_MASK)
    unsigned long long t_acc = 0;
#endif
#pragma unroll 1
    for (int ph = ph_lo; ph < ph_hi; ++ph) {
#if defined(PROBE_TIME_MASK)
        const unsigned long long t_ph0 = __builtin_amdgcn_s_memrealtime();
#endif
        unsigned long long kptr = (unsigned long long)__builtin_amdgcn_kernarg_segment_ptr(); asm volatile("" : "+s"(kptr));
        const ParamsPtr pp = (ParamsPtr)kptr;
#define p (*pp)
        unsigned char* ws = p.ws;
        float* MOD = (float*)(ws + WS_MOD); const float* TAB = (const float*)(ws + WS_TAB); const float* LB = (const float*)(ws + WS_LB);
        bf16_t* H = (bf16_t*)(ws + WS_H); float* RS = (float*)(ws + WS_RS);
        int kind, layer = 0;
        if (ph == 0) kind = 0; else if (ph == 1) kind = 1;
        else { const int qq = ph - 2, pair = qq >> 4, r = qq & 15;
            if (r < 9) { layer = 2 * pair; kind = (r < 6) ? 2 + r : 8 + (r - 6); if (r == 5) kind = 7; }
            else { layer = 2 * pair + 1; const int r2 = r - 9; kind = (r2 == 0) ? 11 : (r2 == 1) ? 12 : (r2 == 2) ? 6 : (r2 == 3) ? 7 : 8 + (r2 - 4); } }
        const int j = layer >> 1;
        switch (kind) {
        case 0:
#if defined(PROBE_DUP_PRO)
            prologue_phase(pp, lds); __syncthreads();
#endif
            prologue_phase(pp, lds); break;
        case 1:
#if defined(PROBE_DUP_NORM0)
            norm_phase(p.x, p.X, false, false, nullptr, nullptr, RS, true, MOD, H); norm_phase(p.x, p.X, false, false, nullptr, nullptr, RS, true, MOD, H); norm_phase(p.x, p.X, false, false, nullptr, nullptr, RS, true, MOD, H); norm_phase(p.x, p.X, false, false, nullptr, nullptr, RS, true, MOD, H);
#endif
            norm_phase(p.x, p.X, false, false, nullptr, nullptr, RS, true, MOD, H); break;
        case 2: { EpiProj E{(float*)(ws + R_PROJ), 1056, 1056}; run_gemm(lds, H, (const bf16_t*)(ws + W_MWIN) + (size_t)j * 1280 * 1024, 1280, 1024, E); } break;
        case 3: latnorm_phase((const float*)(ws + R_PROJ), p.mla_qn + j * 768, p.mla_kvn + j * 256, TAB, (bf16_t*)(ws + R_LATQ), (bf16_t*)(ws + R_LATKV), (bf16_t*)(ws + R_KR)); break;
        case 4: { EpiQ Eq{(bf16_t*)(ws + R_Q), TAB}; run_gemm(lds, (const bf16_t*)(ws + R_LATQ), (const bf16_t*)(ws + W_MWQB) + (size_t)j * 1536 * 768, 1536, 768, Eq);
                  const bf16_t* Wkv = (const bf16_t*)(ws + W_MWKVB) + (size_t)j * 2048 * 256;
                  EpiBf16 Ek{(bf16_t*)(ws + R_KN), 1024}; run_gemm(lds, (const bf16_t*)(ws + R_LATKV), Wkv, 1024, 256, Ek);
                  EpiVT Ev{(bf16_t*)(ws + R_VT)}; run_gemm_t(lds, Wkv + (size_t)1024 * 256, (const bf16_t*)(ws + R_LATKV), 256, Ev); } break;
        case 5:
#if defined(PROBE_DUP_ATTN)
            attn_phase(lds, (const bf16_t*)(ws + R_Q), (const bf16_t*)(ws + R_KN), (const bf16_t*)(ws + R_KR), (const bf16_t*)(ws + R_VT), (bf16_t*)(ws + R_O));
#endif
            attn_phase(lds, (const bf16_t*)(ws + R_Q), (const bf16_t*)(ws + R_KN), (const bf16_t*)(ws + R_KR), (const bf16_t*)(ws + R_VT), (bf16_t*)(ws + R_O)); break;
        case 6: { const bool mla = (layer & 1) == 0; const int pl = layer > 0 ? 2 * layer - 1 : 0;
                  EpiResid E{layer == 0 ? p.x : (const float*)p.X, p.X, MOD + (size_t)(2 * layer) * 16 * 3072, RS, p.ln_g + (size_t)pl * 1024, p.ln_b + (size_t)pl * 1024, layer == 0 ? 1 : 0};
                  const bf16_t* A = mla ? (const bf16_t*)(ws + R_O) : (const bf16_t*)H;
                  const bf16_t* Bt = mla ? (const bf16_t*)(ws + W_MWO) + (size_t)j * 1024 * 1024 : (const bf16_t*)(ws + W_HWO) + (size_t)j * 1024 * 1024;
                  run_gemm(lds, A, Bt, 1024, 1024, E); } break;
        case 7: norm_phase(p.X, p.X, true, false, p.ln_g + (size_t)(2 * layer) * 1024, p.ln_b + (size_t)(2 * layer) * 1024, RS, true, MOD + (size_t)(2 * layer + 1) * 16 * 3072, H); break;
        case 8: { EpiSwiGLU E{(bf16_t*)(ws + R_T)};
#if defined(PROBE_DUP_G4)
            run_gemm(lds, H, (const bf16_t*)(ws + W_FWIN) + (size_t)layer * 5632 * 1024, 5632, 1024, E);
#endif
            run_gemm(lds, H, (const bf16_t*)(ws + W_FWIN) + (size_t)layer * 5632 * 1024, 5632, 1024, E); } break;
        case 9: { EpiResid E{p.X, p.X, MOD + (size_t)(2 * layer + 1) * 16 * 3072, RS, p.ln_g + (size_t)(2 * layer) * 1024, p.ln_b + (size_t)(2 * layer) * 1024, 0}; run_gemm(lds, (const bf16_t*)(ws + R_T), (const bf16_t*)(ws + W_FWOUT) + (size_t)layer * 1024 * FF, 1024, FF, E); } break;
        case 10: norm_phase(p.X, p.X, true, layer == 3, p.ln_g + (size_t)(2 * layer + 1) * 1024, p.ln_b + (size_t)(2 * layer + 1) * 1024, RS, layer < 3, MOD + (size_t)(2 * layer + 2) * 16 * 3072, H); break;
        case 11: { EpiHgrnIn E{(bf16_t*)(ws + R_QS), (float*)(ws + R_LOGF), LB + j * 1024};
                   run_gemm(lds, H, (const bf16_t*)(ws + W_HWIN) + (size_t)j * 4096 * 1024, 4096, 1024, E); } break;
        case 12:
#if defined(PROBE_DUP_REC)
            hgrn_phase(lds, (const bf16_t*)(ws + R_QS), (const float*)(ws + R_LOGF), (const bf16_t*)(ws + R_VV), (const bf16_t*)(ws + R_GS), p.hgrn_gn + j * 128, H);
#endif
            hgrn_phase(lds, (const bf16_t*)(ws + R_QS), (const float*)(ws + R_LOGF), (const bf16_t*)(ws + R_VV), (const bf16_t*)(ws + R_GS), p.hgrn_gn + j * 128, H); break;
        default: break;
        }
        if (ph + 1 < ph_hi) { if (ph_hi > 4096) grid.sync(); else xcd_barrier(bar); }
#if defined(PROBE_TIME_MASK)
        if ((PROBE_TIME_MASK >> kind) & 1) t_acc += __builtin_amdgcn_s_memrealtime() - t_ph0;
#endif
#if defined(PROBE_DUP_SYNC)
        if (ph + 1 < ph_hi) { xcd_barrier(bar); xcd_barrier(bar); xcd_barrier(bar); xcd_barrier(bar); }
#endif
#undef p
    }
#if defined(PROBE_TIME_MASK)
    if (mk_bid() == 0) { const unsigned long long t_e = __builtin_amdgcn_s_memrealtime(); while (__builtin_amdgcn_s_memrealtime() - t_e < t_acc) __builtin_amdgcn_s_sleep(8); }
#endif
}

#ifndef MK_MULTI
#define MK_MULTI 0
#endif
extern "C" void kernel_launch(void* const* d_in, const int* in_sizes, int n_in, void* d_out, int out_size, void* d_ws, size_t ws_size, hipStream_t stream) {
    static int grid = 0;
    if (grid == 0) {
        if (n_in != 19 || out_size != M_TOK * DM || ws_size < WS_END) { fprintf(stderr, "kernel_launch: unexpected sizes: n_in %d out %d ws %zu (need %zu)\n", n_in, out_size, ws_size, (size_t)WS_END); grid = -1; return; }
        int dev = 0, cus = 0, per_cu = 0;
        hipGetDevice(&dev); hipDeviceGetAttribute(&cus, hipDeviceAttributeMultiprocessorCount, dev);
        if (hipFuncSetAttribute((const void*)fwd_megakernel, hipFuncAttributeMaxDynamicSharedMemorySize, LDS_BYTES) != hipSuccess) { fprintf(stderr, "kernel_launch: hipFuncSetAttribute failed\n"); grid = -1; return; }
        hipOccupancyMaxActiveBlocksPerMultiprocessor(&per_cu, (const void*)fwd_megakernel, 512, LDS_BYTES);
        (void)hipGetLastError();
        if (per_cu < 1) per_cu = 1;
        grid = cus * 1;
        fprintf(stderr, "kernel_launch: cus %d per_cu %d grid %d\n", cus, per_cu, grid);
    }
    if (grid < 0) return;
    if (hipMemsetAsync((char*)d_ws + WS_BAR, 0, XCD_BAR_WORDS * 4, stream) != hipSuccess) { fprintf(stderr, "kernel_launch: memset failed\n"); return; }
    Params p{};
    p.x = (const float*)d_in[0]; p.c = (const float*)d_in[1]; p.pos = (const int*)d_in[2];
    p.mla_qn = (const float*)d_in[4]; p.mla_kvn = (const float*)d_in[6]; p.hgrn_lb = (const float*)d_in[9]; p.hgrn_gn = (const float*)d_in[11];
    p.ada_w = (const float*)d_in[15]; p.ada_b = (const float*)d_in[16]; p.ln_g = (const float*)d_in[17]; p.ln_b = (const float*)d_in[18];
    p.X = (float*)d_out; p.ws = (unsigned char*)d_ws;
    p.wsrc[0] = (const float*)d_in[3]; p.wsrc[1] = (const float*)d_in[5]; p.wsrc[2] = (const float*)d_in[7]; p.wsrc[3] = (const float*)d_in[8];
    p.wsrc[4] = (const float*)d_in[10]; p.wsrc[5] = (const float*)d_in[12]; p.wsrc[6] = (const float*)d_in[13]; p.wsrc[7] = (const float*)d_in[14];
    for (int i = 0; i < 16; ++i) p.invf[i] = (float)pow(10000.0, -(double)i / 16.0);
#if MK_MULTI
    for (int ph = 0; ph < N_PHASES; ++ph) { p.ph_lo = ph; p.ph_hi = ph + 1; hipLaunchKernelGGL(fwd_megakernel, dim3(grid), dim3(512), LDS_BYTES, stream, p); }
#else
    p.ph_lo = 0; p.ph_hi = N_PHASES;
    void* args[] = {&p};
    hipError_t e = hipLaunchCooperativeKernel((const void*)fwd_megakernel, dim3(grid), dim3(512), args, LDS_BYTES, stream);
    if (e != hipSuccess) fprintf(stderr, "cooperative launch failed: %s (grid %d)\n", hipGetErrorString(e), grid);
#endif
}
```

```cpp
#include <hip/hip_runtime.h>
#include <hip/hip_cooperative_groups.h>
#include <cstdio>
#include <cstdint>
#include <cmath>
namespace cg = cooperative_groups;

__device__ __forceinline__ int mk_tid() { int t = (int)threadIdx.x; asm volatile("" : "+v"(t)); return t; }
__device__ __forceinline__ int mk_bid() { int t = (int)blockIdx.x; asm volatile("" : "+s"(t)); return t; }
__device__ __forceinline__ int mk_grid() { int t = (int)gridDim.x; asm volatile("" : "+s"(t)); return t; }
namespace pg8 {
#define PG8_LAS __attribute__((address_space(3)))
typedef unsigned short bf16_t;
typedef short bf16x8 __attribute__((ext_vector_type(8)));
typedef float f32x4 __attribute__((ext_vector_type(4)));
typedef unsigned u32x4 __attribute__((ext_vector_type(4)));
constexpr int BM = 256, BK = 64, HALF = 128, HTB = HALF * BK * 2  , STAGE_BYTES = 8 * HTB, NXCD = 8, WGM = 8;

__host__ __device__ __forceinline__ int lds_byte(int r, int c) { const int st = (r >> 4) * 2 + (c >> 5), rr = r & 15, cc = c & 31, ob = rr * 64 + cc * 2; return st * 1024 + (ob ^ (((ob >> 9) & 1) << 5)); }
__host__ __device__ __forceinline__ void stage_rc(int b, int& R, int& C) { const int st = b / 1024, sb = b % 1024, swz = sb ^ (((sb >> 9) & 1) << 5); R = (st >> 1) * 16 + swz / 64; C = (st & 1) * 32 + (swz % 64) / 2; }
__host__ __device__ __forceinline__ int perm32(int rho) { const int n = rho >> 4, i = rho & 15; return 8 * (i >> 2) + 4 * n + (i & 3); }

struct Unit { int pm, pn; };
struct Gemm { const bf16_t* A; const bf16_t* Bt; int M, N, K; };

struct StaticOrder {
    int nM, nN, nwg, G, c;
    __host__ __device__ void init(int M, int N, int G_, int c_) { nM = M / BM; nN = N / BM; nwg = nM * nN; G = G_; c = c_; }
    __host__ __device__ bool next(int i, Unit& u) const {
        const long L = (long)i * G + c; if (L >= nwg) return false;
        int wgid = (int)L; { const int q = nwg / NXCD, r = nwg % NXCD, xcd = wgid % NXCD, off = wgid / NXCD; wgid = (xcd < r ? xcd * (q + 1) : r * (q + 1) + (xcd - r) * q) + off; }
        const int nig = WGM * nN, gid = wgid / nig, fm = gid * WGM, gsz = (nM - fm) < WGM ? (nM - fm) : WGM;
        u.pm = fm + ((wgid % nig) % gsz); u.pn = (wgid % nig) / gsz; return true;
    }
    __device__ __forceinline__ void a_ready(const Unit&) const {}
    __device__ __forceinline__ void done(const Unit&) const {}
};

__device__ __forceinline__ unsigned cvt_pk_bf16(float lo, float hi) { unsigned r; asm volatile("v_cvt_pk_bf16_f32 %0, %1, %2" : "=v"(r) : "v"(lo), "v"(hi)); return r; }
template <class Epi, class Sched, bool ALIGN_EPI = false, bool SP2 = false>
__device__ __forceinline__ void gemm_phase(PG8_LAS unsigned char* lds, const Gemm g, const Sched& S, const Epi& E) {
    const int tid = mk_tid(), wid = __builtin_amdgcn_readfirstlane(tid >> 6), lane = tid & 63, wr = wid >> 2, wc = wid & 3, fr = lane & 15, fq = lane >> 4;
    const int K = g.K, nt = K / BK;
    unsigned voffA[2], voffB[2];
#pragma unroll
    for (int i = 0; i < 2; ++i) { int R, C; stage_rc(tid * 16 + i * 8192, R, C); const int Rb = Epi::PERM ? ((R & ~31) + perm32(R & 31)) : R;
        voffA[i] = (unsigned)(R * K + C) * 2u; voffB[i] = (unsigned)(Rb * K + C) * 2u; }
    const size_t kstep = (size_t)(BK * 2);
    const size_t hstep = (size_t)HALF * K * 2;
    const size_t tstep = 2 * hstep;
    const unsigned ldsw = (unsigned)wid * 1024u;
    const int aoff = lds_byte(wr * 64 + fr, fq * 8), boff = lds_byte(wc * 32 + fr, fq * 8);
#define PG8_SA(b, h) (((b) * 2 + (h)) * HTB)
#define PG8_SB(b, h) ((4 + (b) * 2 + (h)) * HTB)
#define PG8_STAGE(bufoff, gbase, voff) do { _Pragma("unroll") for (int _i = 0; _i < 2; ++_i) \
        __builtin_amdgcn_global_load_lds((const unsigned*)((const char*)(gbase) + (voff)[_i]), (PG8_LAS unsigned*)(lds + (bufoff) + ldsw + _i * 8192), 16, 0, 0); } while (0)
#define PG8_LDA(dst, b, h) do { _Pragma("unroll") for (int m = 0; m < 4; ++m) _Pragma("unroll") for (int k = 0; k < 2; ++k) dst[m][k] = *(const PG8_LAS bf16x8*)(lds + PG8_SA(b, h) + aoff + m * 2048 + k * 1024); } while (0)
#define PG8_LDB(dst, b, h) do { _Pragma("unroll") for (int n = 0; n < 2; ++n) _Pragma("unroll") for (int k = 0; k < 2; ++k) dst[n][k] = *(const PG8_LAS bf16x8*)(lds + PG8_SB(b, h) + boff + n * 2048 + k * 1024); } while (0)
#define PG8_MMA(ai, bj, At, Bt) do { __builtin_amdgcn_s_setprio(1); _Pragma("unroll") for (int m = 0; m < 4; ++m) _Pragma("unroll") for (int n = 0; n < 2; ++n) _Pragma("unroll") for (int k = 0; k < 2; ++k) \
        acc[ai][bj][m][n] = __builtin_amdgcn_mfma_f32_16x16x32_bf16(Bt[n][k], At[m][k], acc[ai][bj][m][n], 0, 0, 0); __builtin_amdgcn_s_setprio(0); } while (0)
#define PG8_WAIT_V(n) asm volatile("s_waitcnt vmcnt(" #n ")" ::: "memory")
#define PG8_WAIT_L(n) asm volatile("s_waitcnt lgkmcnt(" #n ")" ::: "memory")
#define PG8_BAR __builtin_amdgcn_s_barrier()
#define PG8_SCHED __builtin_amdgcn_sched_barrier(0)
    Unit cur, nxt; int ui = 0;
    if (!S.next(0, cur)) return;
    f32x4 acc[2][2][4][2];
#pragma unroll
    for (int a = 0; a < 2; ++a)
#pragma unroll
        for (int b = 0; b < 2; ++b)
#pragma unroll
            for (int m = 0; m < 4; ++m)
#pragma unroll
                for (int n = 0; n < 2; ++n) acc[a][b][m][n] = (f32x4){0.f, 0.f, 0.f, 0.f};
    bf16x8 At[4][2], B0[2][2], B1[2][2];
    const char* cA = (const char*)g.A + (size_t)cur.pm * tstep; const char* cB = (const char*)g.Bt + (size_t)cur.pn * tstep;
    S.a_ready(cur);
    if constexpr (SP2) {
        PG8_STAGE(PG8_SB(0, 0), cB, voffB); PG8_STAGE(PG8_SB(0, 1), cB + hstep, voffB); PG8_STAGE(PG8_SA(0, 0), cA, voffA); PG8_STAGE(PG8_SA(0, 1), cA + hstep, voffA);
        if (wr == 1) PG8_BAR;
        PG8_WAIT_V(2); PG8_BAR;
        PG8_STAGE(PG8_SB(1, 0), cB + kstep, voffB); PG8_STAGE(PG8_SA(1, 0), cA + kstep, voffA); PG8_STAGE(PG8_SB(1, 1), cB + hstep + kstep, voffB);
        PG8_WAIT_V(6); PG8_BAR;
    } else {
        PG8_STAGE(PG8_SB(0, 0), cB, voffB); PG8_STAGE(PG8_SA(0, 0), cA, voffA); PG8_STAGE(PG8_SB(0, 1), cB + hstep, voffB); PG8_STAGE(PG8_SA(0, 1), cA + hstep, voffA);
        if (wr == 1) PG8_BAR;
        PG8_WAIT_V(4); PG8_BAR;
        PG8_STAGE(PG8_SB(1, 0), cB + kstep, voffB); PG8_STAGE(PG8_SA(1, 0), cA + kstep, voffA); PG8_STAGE(PG8_SB(1, 1), cB + hstep + kstep, voffB);
        PG8_WAIT_V(6); PG8_BAR;
    }
    for (;;) {
        const bool has_next = S.next(ui + 1, nxt);
        const char* nA = has_next ? (const char*)g.A + (size_t)nxt.pm * tstep : cA; const char* nB = has_next ? (const char*)g.Bt + (size_t)nxt.pn * tstep : cB;
        for (int t = 0; t < nt; t += 2) {
            const bool last = (t == nt - 2);
            const char* a1 = cA + (size_t)(t + 1) * kstep;
            const char* a2 = last ? nA : cA + (size_t)(t + 2) * kstep; const char* b2 = last ? nB : cB + (size_t)(t + 2) * kstep;
            const char* a3 = a2 + kstep; const char* b3 = b2 + kstep;
            if (last && has_next) S.a_ready(nxt);
            if constexpr (SP2) {
            PG8_LDB(B0, 0, 0); PG8_LDB(B1, 0, 1); PG8_SCHED; PG8_LDA(At, 0, 0); PG8_STAGE(PG8_SA(1, 1), a1 + hstep, voffA);
            PG8_WAIT_V(8); PG8_WAIT_L(0); PG8_BAR; PG8_MMA(0, 0, At, B0); PG8_MMA(0, 1, At, B1); PG8_BAR; PG8_SCHED;
            PG8_LDA(At, 0, 1); PG8_STAGE(PG8_SB(0, 0), b2, voffB); PG8_STAGE(PG8_SB(0, 1), b2 + hstep, voffB); PG8_STAGE(PG8_SA(0, 0), a2, voffA);
            PG8_WAIT_V(8); PG8_WAIT_L(0); PG8_BAR; PG8_MMA(1, 0, At, B0); PG8_MMA(1, 1, At, B1); PG8_BAR; PG8_SCHED;
            PG8_LDB(B0, 1, 0); PG8_LDB(B1, 1, 1); PG8_SCHED; PG8_LDA(At, 1, 0); PG8_STAGE(PG8_SA(0, 1), a2 + hstep, voffA);
            PG8_WAIT_V(8); PG8_WAIT_L(0); PG8_BAR; PG8_MMA(0, 0, At, B0); PG8_MMA(0, 1, At, B1); PG8_BAR; PG8_SCHED;
            PG8_LDA(At, 1, 1); PG8_STAGE(PG8_SB(1, 0), b3, voffB); PG8_STAGE(PG8_SB(1, 1), b3 + hstep, voffB); PG8_STAGE(PG8_SA(1, 0), a3, voffA);
            PG8_WAIT_V(8); PG8_WAIT_L(0); PG8_BAR; PG8_MMA(1, 0, At, B0); PG8_MMA(1, 1, At, B1); PG8_BAR; PG8_SCHED;
            } else {
            PG8_LDB(B0, 0, 0); PG8_SCHED; PG8_LDA(At, 0, 0); PG8_STAGE(PG8_SA(1, 1), a1 + hstep, voffA);
            PG8_WAIT_L(8); PG8_BAR; PG8_WAIT_L(0); PG8_MMA(0, 0, At, B0); PG8_BAR; PG8_SCHED;
            PG8_LDB(B1, 0, 1); PG8_STAGE(PG8_SB(0, 0), b2, voffB);
            PG8_BAR; PG8_WAIT_L(0); PG8_MMA(0, 1, At, B1); PG8_BAR;
            PG8_LDA(At, 0, 1); PG8_STAGE(PG8_SA(0, 0), a2, voffA);
            PG8_BAR; PG8_WAIT_L(0); PG8_MMA(1, 0, At, B0); PG8_BAR; PG8_SCHED;
            PG8_STAGE(PG8_SB(0, 1), b2 + hstep, voffB);
            PG8_WAIT_V(6); PG8_BAR; PG8_MMA(1, 1, At, B1); PG8_BAR;
            PG8_LDB(B0, 1, 0); PG8_SCHED; PG8_LDA(At, 1, 0); PG8_STAGE(PG8_SA(0, 1), a2 + hstep, voffA);
            PG8_WAIT_L(8); PG8_BAR; PG8_WAIT_L(0); PG8_MMA(0, 0, At, B0); PG8_BAR; PG8_SCHED;
            PG8_LDB(B1, 1, 1); PG8_STAGE(PG8_SB(1, 0), b3, voffB);
            PG8_BAR; PG8_WAIT_L(0); PG8_MMA(0, 1, At, B1); PG8_BAR;
            PG8_LDA(At, 1, 1); PG8_STAGE(PG8_SA(1, 0), a3, voffA);
            PG8_BAR; PG8_WAIT_L(0); PG8_MMA(1, 0, At, B0); PG8_BAR; PG8_SCHED;
            PG8_STAGE(PG8_SB(1, 1), b3 + hstep, voffB);
            PG8_WAIT_V(6); PG8_BAR; PG8_MMA(1, 1, At, B1); PG8_BAR;
            }
        }
        if constexpr (ALIGN_EPI) { if (wr == 0) PG8_BAR; }
        if constexpr (!Epi::AFTER_DRAIN) { E(acc, cur, wr, wc, fr, fq); S.done(cur); }
        if (!has_next) break;
#pragma unroll
        for (int a = 0; a < 2; ++a)
#pragma unroll
            for (int b = 0; b < 2; ++b)
#pragma unroll
                for (int m = 0; m < 4; ++m)
#pragma unroll
                    for (int n = 0; n < 2; ++n) acc[a][b][m][n] = (f32x4){0.f, 0.f, 0.f, 0.f};
        cur = nxt; cA = nA; cB = nB; ++ui;
        if constexpr (ALIGN_EPI) { if (wr == 1) PG8_BAR; }
    }
    PG8_WAIT_V(0);
    if constexpr (!ALIGN_EPI) { if (wr == 0) PG8_BAR; }
    PG8_BAR;
    if constexpr (Epi::AFTER_DRAIN) { E.fused(acc, cur, wr, wc, fr, fq, lds, wid, lane); S.done(cur); }
#undef PG8_SA
#undef PG8_SB
#undef PG8_STAGE
#undef PG8_LDA
#undef PG8_LDB
#undef PG8_MMA
#undef PG8_WAIT_V
#undef PG8_WAIT_L
#undef PG8_BAR
#undef PG8_SCHED
}
}

#define LAS __attribute__((address_space(3)))
typedef unsigned short bf16_t;
typedef short bf16x8 __attribute__((ext_vector_type(8)));
typedef short bf16x4 __attribute__((ext_vector_type(4)));
typedef float f32x4 __attribute__((ext_vector_type(4)));
typedef float f32x16 __attribute__((ext_vector_type(16)));
typedef unsigned u32x4 __attribute__((ext_vector_type(4)));
typedef unsigned u32x2 __attribute__((ext_vector_type(2)));

constexpr int M_TOK = 32768, DM = 1024, SEQ = 2048, NB = 16;
constexpr int FF = 2816;
constexpr float ALPHA = 1.681792830507429f;
constexpr float LN_EPS = 1e-5f, RMS_EPS = 1e-6f;
constexpr float QSCALE = 0.10206207261596575f * 1.4426950408889634f;

constexpr size_t MiB = 1u << 20;
constexpr size_t WS_MOD = 0, WS_LB = 3 * MiB / 2, WS_TAB = 2 * MiB;
constexpr size_t W_MWIN = 6 * MiB, W_MWQB = 11 * MiB, W_MWKVB = 31 * MiB / 2, W_MWO = 35 * MiB / 2, W_HWIN = 43 * MiB / 2, W_HWO = 75 * MiB / 2,
                 W_FWIN = 83 * MiB / 2, W_FWOUT = 171 * MiB / 2;
constexpr size_t WS_H = 108 * MiB, WS_R = 172 * MiB;
constexpr size_t R_T = WS_R, R_PROJ = WS_R, R_Q = WS_R, R_LATQ = WS_R + 132 * MiB, R_LATKV = WS_R + 180 * MiB, R_O = WS_R + 132 * MiB,
                 R_KR = WS_R + 196 * MiB, R_KN = WS_R + 198 * MiB, R_VT = WS_R + 262 * MiB;
constexpr size_t R_KP = WS_R + 64 * MiB, R_EL = WS_R + 128 * MiB;
constexpr size_t R_QS = WS_R, R_LOGF = WS_R + 64 * MiB, R_VV = WS_R + 192 * MiB, R_GS = WS_R + 256 * MiB;
constexpr size_t WS_END = WS_R + 326 * MiB;
constexpr int LDS_BYTES = 131072 + 64;
constexpr size_t WS_BAR = WS_LB + 65536;
constexpr size_t WS_RS = WS_LB + 131072;

struct Params {
    const float* x; const float* c; const int* pos;
    const float* mla_qn; const float* mla_kvn; const float* hgrn_lb; const float* hgrn_gn;
    const float* ada_w; const float* ada_b; const float* ln_g; const float* ln_b;
    float* X; unsigned char* ws;
    const float* wsrc[8];
    float invf[16];
    int ph_lo, ph_hi;
};
typedef const __attribute__((address_space(4))) Params* ParamsPtr;
struct WType { int K, N, layers, mode; size_t dst; int drows; };
constexpr WType WT[8] = {
    {1024, 1056, 2, 0, W_MWIN, 1280}, {768, 1536, 2, 0, W_MWQB, 1536}, {256, 2048, 2, 2, W_MWKVB, 2048}, {1024, 1024, 2, 0, W_MWO, 1024},
    {1024, 4096, 2, 3, W_HWIN, 4096}, {1024, 1024, 2, 0, W_HWO, 1024}, {1024, 5632, 4, 1, W_FWIN, 5632}, {2816, 1024, 4, 0, W_FWOUT, 1024} };
constexpr int wt_items(int t) { return (WT[t].K / 64) * (WT[t].N / 32); }
constexpr int wt_total() { int s = 0; for (int t = 0; t < 8; ++t) s += wt_items(t) * WT[t].layers; return s; }

__device__ __forceinline__ unsigned pk2(float lo, float hi) { unsigned r; asm volatile("v_cvt_pk_bf16_f32 %0, %1, %2" : "=v"(r) : "v"(lo), "v"(hi)); return r; }
__device__ __forceinline__ float bf2f(unsigned short h) { return __uint_as_float((unsigned)h << 16); }
__device__ __forceinline__ float wave_sum(float v) {
#pragma unroll
    for (int o = 1; o < 64; o <<= 1) v += __shfl_xor(v, o);
    return v;
}
__device__ __forceinline__ float fast_rcp(float x) { return __builtin_amdgcn_rcpf(x); }
__device__ __forceinline__ float sigmoidf_(float x) { return fast_rcp(1.f + __expf(-x)); }
__device__ __forceinline__ float siluf_(float x) { return x * sigmoidf_(x); }
__device__ __forceinline__ int crow(int r, int hi) { return (r & 3) + 8 * (r >> 2) + 4 * hi; }
__device__ __forceinline__ f32x16 mfma32(bf16x8 a, bf16x8 b, f32x16 c) { return __builtin_amdgcn_mfma_f32_32x32x16_bf16(a, b, c, 0, 0, 0); }

struct EpiProj {
    static constexpr bool PERM = false, AFTER_DRAIN = false;
    float* O; int ldc, ncols;
    __device__ __forceinline__ void operator()(const pg8::f32x4 (&acc)[2][2][4][2], const pg8::Unit& u, int wr, int wc, int fr, int fq) const {
        const int row0 = u.pm * 256 + wr * 64 + fr, col0 = u.pn * 256 + wc * 32 + 4 * fq;
#pragma unroll
        for (int ai = 0; ai < 2; ++ai)
#pragma unroll
            for (int m = 0; m < 4; ++m) { float* rp = O + (size_t)(row0 + ai * 128 + m * 16) * ldc;
#pragma unroll
                for (int bj = 0; bj < 2; ++bj)
#pragma unroll
                    for (int n = 0; n < 2; ++n) { const int c = col0 + bj * 128 + n * 16; if (c < ncols) *(f32x4*)(rp + c) = acc[ai][bj][m][n]; } }
    }
};
struct EpiQ {
    static constexpr bool PERM = false, AFTER_DRAIN = false;
    bf16_t* Q; const float* tab;
    __device__ __forceinline__ void operator()(const pg8::f32x4 (&acc)[2][2][4][2], const pg8::Unit& u, int wr, int wc, int fr, int fq) const {
        const int row0 = u.pm * 256 + wr * 64 + fr;
#pragma unroll
        for (int bj = 0; bj < 2; ++bj) {
            const int c0 = u.pn * 256 + bj * 128 + wc * 32; const bool rope = ((c0 >> 5) % 3) == 2;
#pragma unroll
            for (int ai = 0; ai < 2; ++ai)
#pragma unroll
                for (int m = 0; m < 4; ++m) { const int row = row0 + ai * 128 + m * 16;
                    f32x4 v0 = acc[ai][bj][m][0], v1 = acc[ai][bj][m][1];
                    if (rope) { const f32x4 cs = *(const f32x4*)(tab + (size_t)row * 32 + 4 * fq), sn = *(const f32x4*)(tab + (size_t)row * 32 + 16 + 4 * fq);
                        const f32x4 a = v0 * cs - v1 * sn, b = v0 * sn + v1 * cs; v0 = a; v1 = b; }
                    v0 = v0 * QSCALE; v1 = v1 * QSCALE;
                    bf16_t* qp = Q + (size_t)row * 1536 + c0 + 4 * fq;
                    u32x2 w0, w1; w0.x = pk2(v0[0], v0[1]); w0.y = pk2(v0[2], v0[3]); w1.x = pk2(v1[0], v1[1]); w1.y = pk2(v1[2], v1[3]);
                    *(u32x2*)qp = w0; *(u32x2*)(qp + 16) = w1; }
        }
    }
};
struct EpiBf16 {
    static constexpr bool PERM = true, AFTER_DRAIN = false;
    bf16_t* O; int ldc;
    __device__ __forceinline__ void operator()(const pg8::f32x4 (&acc)[2][2][4][2], const pg8::Unit& u, int wr, int wc, int fr, int fq) const {
        const int row0 = u.pm * 256 + wr * 64 + fr, col0 = u.pn * 256 + wc * 32 + 8 * fq;
#pragma unroll
        for (int ai = 0; ai < 2; ++ai)
#pragma unroll
            for (int m = 0; m < 4; ++m) { bf16_t* rp = O + (size_t)(row0 + ai * 128 + m * 16) * ldc + col0;
#pragma unroll
                for (int bj = 0; bj < 2; ++bj) { const f32x4 a0 = acc[ai][bj][m][0], a1 = acc[ai][bj][m][1];
                    u32x4 w; w.x = pk2(a0[0], a0[1]); w.y = pk2(a0[2], a0[3]); w.z = pk2(a1[0], a1[1]); w.w = pk2(a1[2], a1[3]); *(u32x4*)(rp + bj * 128) = w; } }
    }
};
struct EpiVT {
    static constexpr bool PERM = true, AFTER_DRAIN = false;
    bf16_t* VT;
    __device__ __forceinline__ void operator()(const pg8::f32x4 (&acc)[2][2][4][2], const pg8::Unit& u, int wr, int wc, int fr, int fq) const {
        const int row0 = u.pm * 256 + wr * 64 + fr, tok0 = u.pn * 256 + wc * 32 + 8 * fq;
        bf16_t* base = VT + (size_t)(tok0 >> 11) * (1024 * 2048) + (tok0 & 2047);
#pragma unroll
        for (int ai = 0; ai < 2; ++ai)
#pragma unroll
            for (int m = 0; m < 4; ++m) { bf16_t* rp = base + (size_t)(row0 + ai * 128 + m * 16) * 2048;
#pragma unroll
                for (int bj = 0; bj < 2; ++bj) { const f32x4 a0 = acc[ai][bj][m][0], a1 = acc[ai][bj][m][1];
                    u32x4 w; w.x = pk2(a0[0], a0[1]); w.y = pk2(a0[2], a0[3]); w.z = pk2(a1[0], a1[1]); w.w = pk2(a1[2], a1[3]); *(u32x4*)(rp + bj * 128) = w; } }
    }
};
struct EpiResid {
    static constexpr bool PERM = false, AFTER_DRAIN = false;
    const float* Xin; float* Xout; const float* modrow; const float* RS; const float* g; const float* bta; int raw;
    __device__ __forceinline__ void operator()(const pg8::f32x4 (&acc)[2][2][4][2], const pg8::Unit& u, int wr, int wc, int fr, int fq) const {
        const int row0 = u.pm * 256 + wr * 64 + fr, col0 = u.pn * 256 + wc * 32 + 4 * fq;
        const int b = (u.pm * 256) >> 11; const float* gp = modrow + (size_t)b * 3072 + 2048 + col0;
#pragma unroll
        for (int bj = 0; bj < 2; ++bj)
#pragma unroll
            for (int n = 0; n < 2; ++n) {
                const int c = col0 + bj * 128 + n * 16;
                const f32x4 gt = *(const f32x4*)(gp + bj * 128 + n * 16) + 1.0f;
                f32x4 g4 = (f32x4){1.f, 1.f, 1.f, 1.f}, b4 = (f32x4){0.f, 0.f, 0.f, 0.f};
                if (!raw) { g4 = *(const f32x4*)(g + c); b4 = *(const f32x4*)(bta + c); }
#pragma unroll
                for (int ai = 0; ai < 2; ++ai)
#pragma unroll
                    for (int m = 0; m < 4; ++m) { const int row = row0 + ai * 128 + m * 16;
                        f32x4 xo = *(const f32x4*)(Xin + (size_t)row * 1024 + c);
                        if (!raw) { const float mean = RS[2 * row], rstd = RS[2 * row + 1]; xo = (xo - mean) * rstd * g4 + b4; }
                        *(f32x4*)(Xout + (size_t)row * 1024 + c) = xo * ALPHA + gt * acc[ai][bj][m][n]; }
            }
    }
};
struct EpiSwiGLU {
    static constexpr bool PERM = true, AFTER_DRAIN = false;
    bf16_t* T;
    __device__ __forceinline__ void operator()(const pg8::f32x4 (&acc)[2][2][4][2], const pg8::Unit& u, int wr, int wc, int fr, int fq) const {
        const int row0 = u.pm * 256 + wr * 64 + fr, col0 = u.pn * 128 + wc * 32 + 8 * fq;
#pragma unroll
        for (int ai = 0; ai < 2; ++ai)
#pragma unroll
            for (int m = 0; m < 4; ++m) {
                const f32x4 g0 = acc[ai][0][m][0], g1 = acc[ai][0][m][1], u0 = acc[ai][1][m][0], u1 = acc[ai][1][m][1];
                u32x4 w;
                w.x = pk2(siluf_(g0[0]) * u0[0], siluf_(g0[1]) * u0[1]); w.y = pk2(siluf_(g0[2]) * u0[2], siluf_(g0[3]) * u0[3]);
                w.z = pk2(siluf_(g1[0]) * u1[0], siluf_(g1[1]) * u1[1]); w.w = pk2(siluf_(g1[2]) * u1[2], siluf_(g1[3]) * u1[3]);
                *(u32x4*)(T + (size_t)(row0 + ai * 128 + m * 16) * FF + col0) = w; }
    }
};
template <int N> __device__ __forceinline__ float row_shr(float x) { return __builtin_bit_cast(float, __builtin_amdgcn_update_dpp(0, __builtin_bit_cast(int, x), 0x110 | N, 0xf, 0xf, true)); }
__device__ __forceinline__ float scan16(float x) { x += row_shr<1>(x); x += row_shr<2>(x); x += row_shr<4>(x); x += row_shr<8>(x); return x; }
__device__ __forceinline__ float bcast15(float x, int lane) { return __builtin_bit_cast(float, __builtin_amdgcn_ds_bpermute(((lane | 15) << 2), __builtin_bit_cast(int, x))); }
struct EpiHgrnIn {
    static constexpr bool PERM = true, AFTER_DRAIN = false;
    bf16_t* QP; bf16_t* KP; float* EL; const float* lb;
    __device__ __forceinline__ void operator()(const pg8::f32x4 (&acc)[2][2][4][2], const pg8::Unit& u, int wr, int wc, int fr, int fq) const {
        const int row0 = u.pm * 256 + wr * 64 + fr;
        if (u.pn < 8) {
            const int c0 = u.pn * 128 + wc * 32 + 8 * fq, lane = fr + 16 * fq;
            const f32x4 l0 = *(const f32x4*)(lb + c0), l1 = *(const f32x4*)(lb + c0 + 4);
#pragma unroll
            for (int ai = 0; ai < 2; ++ai)
#pragma unroll
                for (int mp = 0; mp < 2; ++mp) {
                    const int rowA = row0 + ai * 128 + (2 * mp) * 16, rowB = rowA + 16;
                    float qa[8], ka[8], qb[8], kb[8];
#pragma unroll
                    for (int n = 0; n < 2; ++n)
#pragma unroll
                        for (int e = 0; e < 4; ++e) {
                            const float lbv = n ? l1[e] : l0[e];
                            const float fA = lbv + (1.f - lbv) * sigmoidf_(acc[ai][1][2 * mp][n][e]), fB = lbv + (1.f - lbv) * sigmoidf_(acc[ai][1][2 * mp + 1][n][e]);
                            float xA = scan16(__log2f(fA)), xB = scan16(__log2f(fB));
                            xB += bcast15(xA, lane);
                            qa[4 * n + e] = siluf_(acc[ai][0][2 * mp][n][e]) * __builtin_amdgcn_exp2f(xA); ka[4 * n + e] = (1.f - fA) * __builtin_amdgcn_exp2f(-xA);
                            const float eB = __builtin_amdgcn_exp2f(xB);
                            qb[4 * n + e] = siluf_(acc[ai][0][2 * mp + 1][n][e]) * eB; kb[4 * n + e] = (1.f - fB) * __builtin_amdgcn_exp2f(-xB);
                            if (fr == 15) EL[(size_t)(rowB >> 5) * 1024 + c0 + 4 * n + e] = eB;
                        }
                    u32x4 w;
                    w.x = pk2(qa[0], qa[1]); w.y = pk2(qa[2], qa[3]); w.z = pk2(qa[4], qa[5]); w.w = pk2(qa[6], qa[7]); *(u32x4*)(QP + (size_t)rowA * 1024 + c0) = w;
                    w.x = pk2(ka[0], ka[1]); w.y = pk2(ka[2], ka[3]); w.z = pk2(ka[4], ka[5]); w.w = pk2(ka[6], ka[7]); *(u32x4*)(KP + (size_t)rowA * 1024 + c0) = w;
                    w.x = pk2(qb[0], qb[1]); w.y = pk2(qb[2], qb[3]); w.z = pk2(qb[4], qb[5]); w.w = pk2(qb[6], qb[7]); *(u32x4*)(QP + (size_t)rowB * 1024 + c0) = w;
                    w.x = pk2(kb[0], kb[1]); w.y = pk2(kb[2], kb[3]); w.z = pk2(kb[4], kb[5]); w.w = pk2(kb[6], kb[7]); *(u32x4*)(KP + (size_t)rowB * 1024 + c0) = w;
                }
        } else {
            const bool act = u.pn >= 12; const int col0 = (u.pn & 3) * 256 + wc * 32 + 8 * fq;
            bf16_t* base = QP + (size_t)(act ? (R_GS - R_QS) / 2 : (R_VV - R_QS) / 2);
#pragma unroll
            for (int ai = 0; ai < 2; ++ai)
#pragma unroll
                for (int m = 0; m < 4; ++m)
#pragma unroll
                    for (int bj = 0; bj < 2; ++bj) { f32x4 a0 = acc[ai][bj][m][0], a1 = acc[ai][bj][m][1];
                        if (act) {
#pragma unroll
                            for (int e = 0; e < 4; ++e) { a0[e] = siluf_(a0[e]); a1[e] = siluf_(a1[e]); } }
                        u32x4 w; w.x = pk2(a0[0], a0[1]); w.y = pk2(a0[2], a0[3]); w.z = pk2(a1[0], a1[1]); w.w = pk2(a1[2], a1[3]);
                        *(u32x4*)(base + (size_t)(row0 + ai * 128 + m * 16) * 1024 + col0 + bj * 128) = w; }
        }
    }
};

#define XB_TMO      128
#define XB_XCNT(j)  (256  + 64 * (j))
#define XB_XSUB(j)  (1280 + 64 * (j))
#define XB_XGEN(j)  (2304 + 64 * (j))
#define XB_TOP      3328
#define XB_TOPGEN   3392
#define XCD_BAR_WORDS 3456
#define XB_SPIN_CAP (1u << 18)

__device__ __forceinline__ unsigned xb_ld(unsigned* p)              { return __hip_atomic_load(p, __ATOMIC_RELAXED, __HIP_MEMORY_SCOPE_AGENT); }
__device__ __forceinline__ unsigned xb_add(unsigned* p, unsigned v) { return __hip_atomic_fetch_add(p, v, __ATOMIC_RELAXED, __HIP_MEMORY_SCOPE_AGENT); }
__device__ __forceinline__ unsigned xb_xcc_id() { return (unsigned)__builtin_amdgcn_s_getreg((3 << 11) | 20) & 0xFu; }
#define XB_SPIN(cond, bar) do { unsigned _sp = 0; while (cond) { __builtin_amdgcn_s_sleep(1); \
    if ((++_sp & 255u) == 0u) { if (xb_ld(&(bar)[XB_TMO])) break; if (_sp > XB_SPIN_CAP) { atomicAdd(&(bar)[XB_TMO], 1u); break; } } } } while (0)

struct XcdBarrier {
    unsigned* bar; unsigned x;
    volatile LAS unsigned* st;
};

__device__ __forceinline__ XcdBarrier xcd_barrier_post(unsigned* bar, volatile LAS unsigned* st) {
    XcdBarrier b; b.bar = bar; b.x = xb_xcc_id(); b.st = st;
    if (mk_tid() == 0) (void)xb_add(&bar[XB_XCNT(b.x)], 1u);
    return b;
}
__device__ __forceinline__ void xcd_barrier_complete(unsigned* bar, unsigned x, unsigned& nloc, unsigned& nx) {
    const unsigned G = (unsigned)mk_grid();
    unsigned sum, cnt, mine, sp = 0u;
    for (;;) {
        sum = 0u; cnt = 0u; mine = 0u;
#pragma unroll
        for (unsigned j = 0; j < 16; ++j) { const unsigned c = xb_ld(&bar[XB_XCNT(j)]); sum += c; cnt += (c > 0u) ? 1u : 0u; mine = (j == x) ? c : mine; }
        if (sum == G) break;
        __builtin_amdgcn_s_sleep(1);
        if ((++sp & 255u) == 0u) { if (xb_ld(&bar[XB_TMO])) break; if (sp > XB_SPIN_CAP) { atomicAdd(&bar[XB_TMO], 1u); break; } }
    }
    nloc = mine > 0u ? mine : 1u; nx = cnt > 0u ? cnt : 1u;
}

__device__ __forceinline__ void xcd_barrier(const XcdBarrier& b) {
    asm volatile("s_waitcnt vmcnt(0)" ::: "memory");
    __syncthreads();
    if (mk_tid() == 0) {
        unsigned* bar = b.bar;
        __builtin_amdgcn_s_waitcnt(0);
        unsigned nloc = b.st[0], nx = b.st[1];
        if (nloc == 0u) { xcd_barrier_complete(bar, b.x, nloc, nx); b.st[0] = nloc; b.st[1] = nx; }
        const unsigned old = xb_add(&bar[XB_XSUB(b.x)], 1u);
        const unsigned gen = old / nloc;
        if (old + 1u == (gen + 1u) * nloc) {
            __builtin_amdgcn_fence(__ATOMIC_RELEASE, "agent");
            asm volatile("s_waitcnt vmcnt(0)" ::: "memory");
            const unsigned og = xb_add(&bar[XB_TOP], 1u);
            const unsigned tg = og / nx;
            if (og + 1u == (tg + 1u) * nx) xb_add(&bar[XB_TOPGEN], 1u);
            else XB_SPIN(xb_ld(&bar[XB_TOPGEN]) == tg, bar);
            __builtin_amdgcn_fence(__ATOMIC_ACQUIRE, "agent");
            xb_add(&bar[XB_XGEN(b.x)], 1u);
            asm volatile("s_waitcnt vmcnt(0)" ::: "memory");
        } else {
            XB_SPIN(xb_ld(&bar[XB_XGEN(b.x)]) == gen, bar);
            __builtin_amdgcn_fence(__ATOMIC_ACQUIRE, "agent");
            asm volatile("s_waitcnt vmcnt(0)" ::: "memory");
        }
    }
    __syncthreads();
}


__device__ __forceinline__ void transpose_item(const float* W, bf16_t* dst, int K, int N, int mode, int item, LAS float* scr, int lane) {
    const int nblk = N / 32, kb = item / nblk, nb = item % nblk, k0 = 64 * kb, n0 = 32 * nb;
    int drow0 = n0;
    if (mode == 1) { const int up = n0 >= FF, j0 = up ? n0 - FF : n0; drow0 = 256 * (j0 >> 7) + (up ? 128 : 0) + (j0 & 127); }
    if (mode == 2) { const int h = n0 >> 7, r = n0 & 127; drow0 = (r < 64) ? h * 64 + r : 1024 + h * 64 + (r - 64); }
    if (mode == 3 && n0 < 2048) { const int fxh = n0 >= 1024, c = n0 & 1023; drow0 = 256 * (c >> 7) + (fxh ? 128 : 0) + (c & 127); }
    { float t[32];
#pragma unroll
      for (int i = 0; i < 32; ++i) t[i] = W[(size_t)(k0 + 2 * i + (lane >> 5)) * N + n0 + (lane & 31)];
#pragma unroll
      for (int i = 0; i < 32; ++i) scr[(2 * i + (lane >> 5)) * 33 + (lane & 31)] = t[i]; }
    asm volatile("s_waitcnt lgkmcnt(0)" ::: "memory");
    const int c = lane & 7;
#pragma unroll
    for (int j = 0; j < 4; ++j) { const int n = (lane >> 3) + 8 * j; const LAS float* s = scr + (8 * c) * 33 + n;
        u32x4 o; o.x = pk2(s[0 * 33], s[1 * 33]); o.y = pk2(s[2 * 33], s[3 * 33]); o.z = pk2(s[4 * 33], s[5 * 33]); o.w = pk2(s[6 * 33], s[7 * 33]);
        *(u32x4*)(dst + (size_t)(drow0 + n) * K + k0 + 8 * c) = o; }
    asm volatile("s_waitcnt lgkmcnt(0)" ::: "memory");
}

__device__ __forceinline__ void prologue_phase(ParamsPtr pp, LAS unsigned char* lds) {
    const ParamsPtr p_ = pp;
#define p (*p_)
    const int tid = mk_tid(), lane = tid & 63, wave = __builtin_amdgcn_readfirstlane(tid >> 6);
    const int G = mk_grid();
    {
        LAS float* sc = (LAS float*)lds;
        LAS float* red = (LAS float*)(lds + 65536);
        for (int i = tid; i < NB * DM; i += 512) { const int b = i >> 10, k = i & 1023; const float v = p.c[i]; sc[k * 16 + b] = v / (1.f + __expf(-v)); }
        __syncthreads();
        float* MOD = (float*)(p.ws + WS_MOD);
        for (int it = mk_bid(); it < 8 * 48; it += G) {
            const int ls = it / 48, n0 = (it % 48) * 64, col = tid & 63, kg = tid >> 6;
            const float* W = p.ada_w + (size_t)ls * 1024 * 3072 + (size_t)(kg * 128) * 3072 + n0 + col;
            float acc[16];
#pragma unroll
            for (int b = 0; b < 16; ++b) acc[b] = 0.f;
#pragma unroll 16
            for (int k = 0; k < 128; ++k) { const float w = W[(size_t)k * 3072]; const LAS f32x4* s4 = (const LAS f32x4*)(sc + (kg * 128 + k) * 16);
#pragma unroll
                for (int q = 0; q < 4; ++q) { const f32x4 s = s4[q]; acc[4 * q + 0] += s[0] * w; acc[4 * q + 1] += s[1] * w; acc[4 * q + 2] += s[2] * w; acc[4 * q + 3] += s[3] * w; } }
#pragma unroll
            for (int q = 0; q < 4; ++q) *(LAS f32x4*)(red + (kg * 64 + col) * 16 + 4 * q) = (f32x4){acc[4 * q], acc[4 * q + 1], acc[4 * q + 2], acc[4 * q + 3]};
            __syncthreads();
            { const int b0 = 2 * kg;
#pragma unroll
              for (int bb = 0; bb < 2; ++bb) { float s = 0.f;
#pragma unroll
                  for (int g = 0; g < 8; ++g) s += red[(g * 64 + col) * 16 + b0 + bb];
                  MOD[((size_t)ls * 16 + b0 + bb) * 3072 + n0 + col] = s + p.ada_b[ls * 3072 + n0 + col]; } }
            __syncthreads();
        }
    }
    if (mk_bid() == 0) {
        float* LB = (float*)(p.ws + WS_LB);
        for (int cidx = tid; cidx < 1024; cidx += 512) { const float a0 = p.hgrn_lb[cidx], a1 = p.hgrn_lb[1024 + cidx], mx = fmaxf(a0, a1);
            const float e0 = expf(a0 - mx), e1 = expf(a1 - mx), s0 = e0 / (e0 + e1), s1 = e1 / (e0 + e1);
            LB[cidx] = s0 - s0; LB[1024 + cidx] = (s0 + s1) - s0; }
    }
    {
        float* TAB = (float*)(p.ws + WS_TAB);
        for (int gi = mk_bid() * 512 + tid; gi < M_TOK * 16; gi += G * 512) {
            const int m = gi >> 4, i = gi & 15; const float ang = (float)p.pos[m] * p.invf[i];
            const double r = (double)ang, q = rint(r * 0.63661977236758134308), t = fma(-q, 1.57079632679489661923, r), t2 = t * t;
            const double s = t * (1.0 + t2 * (-1.0 / 6 + t2 * (1.0 / 120 + t2 * (-1.0 / 5040 + t2 * (1.0 / 362880 + t2 * (-1.0 / 39916800 + t2 * (1.0 / 6227020800.0)))))));
            const double c = 1.0 + t2 * (-0.5 + t2 * (1.0 / 24 + t2 * (-1.0 / 720 + t2 * (1.0 / 40320 + t2 * (-1.0 / 3628800 + t2 * (1.0 / 479001600.0))))));
            const int qi = ((int)q) & 3; double cc, ss;
            if (qi == 0) { cc = c; ss = s; } else if (qi == 1) { cc = -s; ss = c; } else if (qi == 2) { cc = -c; ss = -s; } else { cc = s; ss = -c; }
            TAB[(size_t)m * 32 + i] = (float)cc; TAB[(size_t)m * 32 + 16 + i] = (float)ss; }
    }
    {
        for (int gi = mk_bid() * 512 + tid; gi < 2 * 224 * 128; gi += G * 512) { const int l = gi / (224 * 128), r = gi % (224 * 128);
            *(u32x4*)(p.ws + W_MWIN + (size_t)l * 1280 * 1024 * 2 + (size_t)1056 * 1024 * 2 + (size_t)r * 16) = (u32x4){0u, 0u, 0u, 0u}; }
    }
    __syncthreads();
    {
        LAS float* scr = (LAS float*)(lds + wave * 8448);
        const int gw = mk_bid() * 8 + wave, NGW = G * 8;
        for (int it = gw; it < wt_total(); it += NGW) {
            int r = it;
#pragma unroll
            for (int t = 0; t < 8; ++t) {
                const int ni = wt_items(t) * WT[t].layers;
                if (r >= 0 && r < ni) { const int l = r / wt_items(t), item = r % wt_items(t);
                    transpose_item(p.wsrc[t] + (size_t)l * WT[t].K * WT[t].N, (bf16_t*)(p.ws + WT[t].dst) + (size_t)l * WT[t].drows * WT[t].K, WT[t].K, WT[t].N, WT[t].mode, item, scr, lane); }
                r -= ni;
            }
        }
    }
}

#undef p
__device__ __forceinline__ void norm_phase(const float* src, float* dst, bool do_ln, bool write_x, const float* g, const float* bta, float* RS, bool do_h, const float* modrow, bf16_t* H) {
    const int tid_ = mk_tid(), lane = tid_ & 63, wave = __builtin_amdgcn_readfirstlane(tid_ >> 6); const int gw = mk_bid() * 8 + wave, NGW = mk_grid() * 8;
    for (int m0 = gw * 4; m0 < M_TOK; m0 += NGW * 4) {
        const int b = m0 >> 11;
        f32x4 v[4][4];
#pragma unroll
        for (int r = 0; r < 4; ++r) { const f32x4* xr = (const f32x4*)(src + (size_t)(m0 + r) * 1024) + lane;
#pragma unroll
            for (int j = 0; j < 4; ++j) v[r][j] = xr[64 * j]; }
        if (do_ln) {
            float s[4];
#pragma unroll
            for (int r = 0; r < 4; ++r) { s[r] = 0.f;
#pragma unroll
                for (int j = 0; j < 4; ++j) s[r] += (v[r][j][0] + v[r][j][1]) + (v[r][j][2] + v[r][j][3]); }
#pragma unroll
            for (int o = 1; o < 64; o <<= 1) {
#pragma unroll
                for (int r = 0; r < 4; ++r) s[r] += __shfl_xor(s[r], o); }
            float mean[4], s2[4];
#pragma unroll
            for (int r = 0; r < 4; ++r) { mean[r] = s[r] * (1.f / 1024.f); s2[r] = 0.f;
#pragma unroll
                for (int j = 0; j < 4; ++j) { v[r][j] = v[r][j] - mean[r]; s2[r] += (v[r][j][0] * v[r][j][0] + v[r][j][1] * v[r][j][1]) + (v[r][j][2] * v[r][j][2] + v[r][j][3] * v[r][j][3]); } }
#pragma unroll
            for (int o = 1; o < 64; o <<= 1) {
#pragma unroll
                for (int r = 0; r < 4; ++r) s2[r] += __shfl_xor(s2[r], o); }
#pragma unroll
            for (int r = 0; r < 4; ++r) { const float rstd = 1.0f / sqrtf(s2[r] * (1.f / 1024.f) + LN_EPS);
                if (lane == 0) { RS[2 * (m0 + r)] = mean[r]; RS[2 * (m0 + r) + 1] = rstd; }
#pragma unroll
                for (int j = 0; j < 4; ++j) v[r][j] = v[r][j] * rstd; }
#pragma unroll
            for (int j = 0; j < 4; ++j) { const f32x4 gg = *((const f32x4*)g + lane + 64 * j), bb = *((const f32x4*)bta + lane + 64 * j);
#pragma unroll
                for (int r = 0; r < 4; ++r) v[r][j] = v[r][j] * gg + bb; }
        }
        if (write_x) {
#pragma unroll
            for (int r = 0; r < 4; ++r) { f32x4* xo = (f32x4*)(dst + (size_t)(m0 + r) * 1024) + lane;
#pragma unroll
                for (int j = 0; j < 4; ++j) xo[64 * j] = v[r][j]; } }
        if (do_h) { const f32x4* sh = (const f32x4*)(modrow + (size_t)b * 3072) + lane; const f32x4* sc = (const f32x4*)(modrow + (size_t)b * 3072 + 1024) + lane;
#pragma unroll
            for (int j = 0; j < 4; ++j) { const f32x4 s1 = sc[64 * j] + 1.0f, s0 = sh[64 * j];
#pragma unroll
                for (int r = 0; r < 4; ++r) { const f32x4 h = v[r][j] * s1 + s0; u32x2 w; w.x = pk2(h[0], h[1]); w.y = pk2(h[2], h[3]); *((u32x2*)(H + (size_t)(m0 + r) * 1024) + lane + 64 * j) = w; } } }
    }
}

__device__ __forceinline__ void latnorm_phase(const float* PROJ, const float* qn, const float* kvn, const float* tab, bf16_t* LATQ, bf16_t* LATKV, bf16_t* KR) {
    const int tid_ = mk_tid(), lane = tid_ & 63, wave = __builtin_amdgcn_readfirstlane(tid_ >> 6); const int gw = mk_bid() * 8 + wave, NGW = mk_grid() * 8;
    for (int m0 = gw * 4; m0 < M_TOK; m0 += NGW * 4) {
        f32x4 v[4][3], kv[4]; float s[4], s2[4], x1[4], x2[4];
#pragma unroll
        for (int r = 0; r < 4; ++r) { const float* pr = PROJ + (size_t)(m0 + r) * 1056;
#pragma unroll
            for (int j = 0; j < 3; ++j) v[r][j] = *((const f32x4*)pr + lane + 64 * j);
            kv[r] = *((const f32x4*)(pr + 768) + lane); x1[r] = pr[1024 + (lane & 15)]; x2[r] = pr[1040 + (lane & 15)]; }
#pragma unroll
        for (int r = 0; r < 4; ++r) { s[r] = 0.f;
#pragma unroll
            for (int j = 0; j < 3; ++j) s[r] += (v[r][j][0] * v[r][j][0] + v[r][j][1] * v[r][j][1]) + (v[r][j][2] * v[r][j][2] + v[r][j][3] * v[r][j][3]);
            s2[r] = (kv[r][0] * kv[r][0] + kv[r][1] * kv[r][1]) + (kv[r][2] * kv[r][2] + kv[r][3] * kv[r][3]); }
#pragma unroll
        for (int o = 1; o < 64; o <<= 1) {
#pragma unroll
            for (int r = 0; r < 4; ++r) { s[r] += __shfl_xor(s[r], o); s2[r] += __shfl_xor(s2[r], o); } }
#pragma unroll
        for (int r = 0; r < 4; ++r) { const int m = m0 + r;
            const float rq = 1.0f / sqrtf(s[r] * (1.f / 768.f) + RMS_EPS), rkv = 1.0f / sqrtf(s2[r] * (1.f / 256.f) + RMS_EPS);
#pragma unroll
            for (int j = 0; j < 3; ++j) { const f32x4 gg = *((const f32x4*)qn + lane + 64 * j); const f32x4 o = v[r][j] * rq * gg; u32x2 w; w.x = pk2(o[0], o[1]); w.y = pk2(o[2], o[3]);
                *((u32x2*)(LATQ + (size_t)m * 768) + lane + 64 * j) = w; }
            { const f32x4 gg = *((const f32x4*)kvn + lane); const f32x4 o = kv[r] * rkv * gg; u32x2 w; w.x = pk2(o[0], o[1]); w.y = pk2(o[2], o[3]); *((u32x2*)(LATKV + (size_t)m * 256) + lane) = w; }
            if (lane < 16) { const float cs = tab[(size_t)m * 32 + lane], sn = tab[(size_t)m * 32 + 16 + lane];
                const unsigned w = pk2(x1[r] * cs - x2[r] * sn, x1[r] * sn + x2[r] * cs); KR[(size_t)m * 32 + lane] = (bf16_t)(w & 0xffff); KR[(size_t)m * 32 + 16 + lane] = (bf16_t)(w >> 16); } }
    }
}

__device__ __forceinline__ void attn_phase(LAS unsigned char* lds, const bf16_t* Q, const bf16_t* KN, const bf16_t* KR, const bf16_t* VT, bf16_t* O) {
    constexpr int KPB = 208, VPB = 144, KSB = 64 * KPB, VSB = 64 * VPB;
    const int tid = mk_tid(), lane = tid & 63, wave = __builtin_amdgcn_readfirstlane(tid >> 6), q = lane & 31, g = lane >> 5;
    const unsigned kn_dst = (tid >> 3) * KPB + (tid & 7) * 16, kr_dst = (tid >> 2) * KPB + 128 + (tid & 3) * 16, vt_dst = 2 * KSB + (tid >> 3) * VPB + (tid & 7) * 16;
    for (int bh = mk_bid(); bh < 256; bh += mk_grid()) {
        const int b = bh >> 4, h = bh & 15;
        const bf16_t* kn_src = KN + (size_t)(b * 2048 + (tid >> 3)) * 1024 + h * 64 + (tid & 7) * 8;
        const bf16_t* kr_src = KR + (size_t)(b * 2048 + (tid >> 2)) * 32 + (tid & 3) * 8;
        const bf16_t* vt_src = VT + (size_t)(bh * 64 + (tid >> 3)) * 2048 + (tid & 7) * 8;
#pragma unroll 1
        for (int qb = 7; qb >= 0; --qb) {
            __syncthreads();
            const int r0 = qb * 256 + wave * 32, ntile = 4 * (qb + 1);
            bf16x8 qf[6];
            { const bf16_t* qp = Q + (size_t)(b * 2048 + r0 + q) * 1536 + h * 96 + g * 8;
#pragma unroll
              for (int ks = 0; ks < 6; ++ks) qf[ks] = *(const bf16x8*)(qp + ks * 16); }
            f32x16 o0, o1;
#pragma unroll
            for (int i = 0; i < 16; ++i) { o0[i] = 0.f; o1[i] = 0.f; }
            float mrow = -INFINITY, lrow = 0.f;
            u32x4 rk, rr, rv;
            rk = *(const u32x4*)kn_src; rv = *(const u32x4*)vt_src; if (tid < 256) rr = *(const u32x4*)kr_src;
            *(LAS u32x4*)(lds + kn_dst) = rk; *(LAS u32x4*)(lds + vt_dst) = rv; if (tid < 256) *(LAS u32x4*)(lds + kr_dst) = rr;
            __syncthreads();
#pragma unroll 1
            for (int j = 0; j < ntile; ++j) {
                const int cur = j & 1; const bool more = (j + 1 < ntile);
                if (more) { rk = *(const u32x4*)(kn_src + (size_t)(j + 1) * 64 * 1024); rv = *(const u32x4*)(vt_src + (j + 1) * 64); if (tid < 256) rr = *(const u32x4*)(kr_src + (size_t)(j + 1) * 64 * 32); }
                if (64 * j <= r0 + 31) {
                    const LAS unsigned char* kb_ = lds + cur * KSB; const LAS unsigned char* vb_ = lds + 2 * KSB + cur * VSB;
                    f32x16 s0, s1;
#pragma unroll
                    for (int i = 0; i < 16; ++i) { s0[i] = 0.f; s1[i] = 0.f; }
#pragma unroll
                    for (int ks = 0; ks < 6; ++ks) {
                        const bf16x8 a0 = *(const LAS bf16x8*)(kb_ + q * KPB + (ks * 16 + g * 8) * 2), a1 = *(const LAS bf16x8*)(kb_ + (32 + q) * KPB + (ks * 16 + g * 8) * 2);
                        s0 = mfma32(a0, qf[ks], s0); s1 = mfma32(a1, qf[ks], s1); }
                    if (64 * j + 63 > r0) { const int qa = r0 + q, k0 = 64 * j + 4 * g;
#pragma unroll
                        for (int i = 0; i < 16; ++i) { const int key = k0 + (i & 3) + 8 * (i >> 2); if (key > qa) s0[i] = -INFINITY; if (key + 32 > qa) s1[i] = -INFINITY; } }
                    float mx = fmaxf(s0[0], s1[0]);
#pragma unroll
                    for (int i = 1; i < 16; ++i) mx = fmaxf(mx, fmaxf(s0[i], s1[i]));
                    mx = fmaxf(mx, __shfl_xor(mx, 32));
                    const float mnew = fmaxf(mrow, mx), alpha = __builtin_amdgcn_exp2f(mrow - mnew); mrow = mnew;
                    float sum = 0.f;
#pragma unroll
                    for (int i = 0; i < 16; ++i) { s0[i] = __builtin_amdgcn_exp2f(s0[i] - mnew); s1[i] = __builtin_amdgcn_exp2f(s1[i] - mnew); sum += s0[i] + s1[i]; }
                    lrow = lrow * alpha + sum;
#pragma unroll
                    for (int i = 0; i < 16; ++i) { o0[i] *= alpha; o1[i] *= alpha; }
#pragma unroll
                    for (int kb = 0; kb < 2; ++kb)
#pragma unroll
                        for (int t2 = 0; t2 < 2; ++t2) {
                            u32x4 pw;
                            if (kb == 0) { pw.x = pk2(s0[8 * t2 + 0], s0[8 * t2 + 1]); pw.y = pk2(s0[8 * t2 + 2], s0[8 * t2 + 3]); pw.z = pk2(s0[8 * t2 + 4], s0[8 * t2 + 5]); pw.w = pk2(s0[8 * t2 + 6], s0[8 * t2 + 7]); }
                            else         { pw.x = pk2(s1[8 * t2 + 0], s1[8 * t2 + 1]); pw.y = pk2(s1[8 * t2 + 2], s1[8 * t2 + 3]); pw.z = pk2(s1[8 * t2 + 4], s1[8 * t2 + 5]); pw.w = pk2(s1[8 * t2 + 6], s1[8 * t2 + 7]); }
                            const bf16x8 pb = __builtin_bit_cast(bf16x8, pw);
                            const int ko = (32 * kb + 16 * t2 + 4 * g) * 2;
                            { const u32x2 lo = *(const LAS u32x2*)(vb_ + q * VPB + ko), hi = *(const LAS u32x2*)(vb_ + q * VPB + ko + 16);
                              const u32x4 av = (u32x4){lo.x, lo.y, hi.x, hi.y}; o0 = mfma32(__builtin_bit_cast(bf16x8, av), pb, o0); }
                            { const u32x2 lo = *(const LAS u32x2*)(vb_ + (32 + q) * VPB + ko), hi = *(const LAS u32x2*)(vb_ + (32 + q) * VPB + ko + 16);
                              const u32x4 av = (u32x4){lo.x, lo.y, hi.x, hi.y}; o1 = mfma32(__builtin_bit_cast(bf16x8, av), pb, o1); }
                        }
                }
                if (more) { const unsigned bo = (cur ^ 1) * KSB, vo = (cur ^ 1) * VSB;
                    *(LAS u32x4*)(lds + bo + kn_dst) = rk; *(LAS u32x4*)(lds + vo + vt_dst) = rv; if (tid < 256) *(LAS u32x4*)(lds + bo + kr_dst) = rr; }
                __syncthreads();
            }
            const float lt = lrow + __shfl_xor(lrow, 32), inv = 1.0f / lt;
            bf16_t* op = O + (size_t)(b * 2048 + r0 + q) * 1024 + h * 64 + 4 * g;
#pragma unroll
            for (int qd = 0; qd < 4; ++qd) {
                u32x2 w0, w1; w0.x = pk2(o0[4 * qd] * inv, o0[4 * qd + 1] * inv); w0.y = pk2(o0[4 * qd + 2] * inv, o0[4 * qd + 3] * inv);
                w1.x = pk2(o1[4 * qd] * inv, o1[4 * qd + 1] * inv); w1.y = pk2(o1[4 * qd + 2] * inv, o1[4 * qd + 3] * inv);
                *(u32x2*)(op + 8 * qd) = w0; *(u32x2*)(op + 32 + 8 * qd) = w1; }
        }
    }
}

__device__ __forceinline__ void hgrn_phase(LAS unsigned char* lds, const bf16_t* QP, const bf16_t* KP, const float* EL, const bf16_t* VV, const bf16_t* GS, const float* gn, bf16_t* OG) {
    constexpr int QPO = 0, KPN = 8704, KPT = 17408, VTT = 27648, SST = 37888, OPART = 72704, ELAST = 108544;
    const int tid = mk_tid(), lane = tid & 63, wave = __builtin_amdgcn_readfirstlane(tid >> 6), q = lane & 31, g = lane >> 5;
    const int ch = tid & 127, tg = tid >> 7, vb = wave & 3, kh = wave >> 2;
    const int dt = tid >> 4, dpart = tid & 15;
    for (int bh = mk_bid(); bh < 128; bh += mk_grid()) {
        const int b = bh >> 3, hh = bh & 7;
        __syncthreads();
        f32x16 st0, st1;
#pragma unroll
        for (int i = 0; i < 16; ++i) { st0[i] = 0.f; st1[i] = 0.f; }
        const size_t ebase = (size_t)(b * 2048 + 8 * tg) * 1024 + hh * 128 + ch;
        const size_t dbase = (size_t)(b * 2048 + dt) * 1024 + hh * 128 + 8 * dpart;
        const size_t lbase = (size_t)(b * 64) * 1024 + hh * 128 + ch;
        f32x4 gn0 = *(const f32x4*)(gn + 8 * dpart), gn1 = *(const f32x4*)(gn + 8 * dpart + 4);
        unsigned short qp[8], kp[8], vv[8]; float el = 0.f;
#pragma unroll
        for (int i = 0; i < 8; ++i) { qp[i] = QP[ebase + (size_t)i * 1024]; kp[i] = KP[ebase + (size_t)i * 1024]; vv[i] = VV[ebase + (size_t)i * 1024]; }
        if (tg == 3) el = EL[lbase];
        u32x4 gsv_next = *(const u32x4*)(GS + dbase);
#pragma unroll 1
        for (int c = 0; c < 64; ++c) {
            {
                unsigned kt[4], vt[4];
#pragma unroll
                for (int i = 0; i < 8; i += 2) {
                    *(LAS unsigned short*)(lds + QPO + (8 * tg + i) * 272 + ch * 2) = qp[i];
                    *(LAS unsigned short*)(lds + QPO + (8 * tg + i + 1) * 272 + ch * 2) = qp[i + 1];
                    *(LAS unsigned short*)(lds + KPN + (8 * tg + i) * 272 + ch * 2) = kp[i];
                    *(LAS unsigned short*)(lds + KPN + (8 * tg + i + 1) * 272 + ch * 2) = kp[i + 1];
                    kt[i >> 1] = (unsigned)kp[i] | ((unsigned)kp[i + 1] << 16); vt[i >> 1] = (unsigned)vv[i] | ((unsigned)vv[i + 1] << 16);
                }
                *(LAS u32x4*)(lds + KPT + ch * 80 + tg * 16) = (u32x4){kt[0], kt[1], kt[2], kt[3]};
                *(LAS u32x4*)(lds + VTT + ch * 80 + tg * 16) = (u32x4){vt[0], vt[1], vt[2], vt[3]};
                if (tg == 3) *(LAS float*)(lds + ELAST + ch * 4) = el;
            }
#pragma unroll
            for (int qd = 0; qd < 4; ++qd) {
                u32x2 w0, w1; w0.x = pk2(st0[4 * qd], st0[4 * qd + 1]); w0.y = pk2(st0[4 * qd + 2], st0[4 * qd + 3]); w1.x = pk2(st1[4 * qd], st1[4 * qd + 1]); w1.y = pk2(st1[4 * qd + 2], st1[4 * qd + 3]);
                *(LAS u32x2*)(lds + SST + (32 * vb + q) * 272 + (32 * (2 * kh) + 8 * qd + 4 * g) * 2) = w0;
                *(LAS u32x2*)(lds + SST + (32 * vb + q) * 272 + (32 * (2 * kh + 1) + 8 * qd + 4 * g) * 2) = w1; }
            __syncthreads();
            const u32x4 gsv = gsv_next;
            if (c + 1 < 64) { const size_t e2 = ebase + (size_t)(c + 1) * 32 * 1024;
                gsv_next = *(const u32x4*)(GS + dbase + (size_t)(c + 1) * 32 * 1024);
#pragma unroll
                for (int i = 0; i < 8; ++i) { qp[i] = QP[e2 + (size_t)i * 1024]; kp[i] = KP[e2 + (size_t)i * 1024]; vv[i] = VV[e2 + (size_t)i * 1024]; }
                if (tg == 3) el = EL[lbase + (size_t)(c + 1) * 1024]; }
            {
                f32x16 oT;
#pragma unroll
                for (int i = 0; i < 16; ++i) oT[i] = 0.f;
#pragma unroll
                for (int ks = 0; ks < 4; ++ks) { const int k0 = (64 * kh + 16 * ks + 8 * g) * 2;
                    oT = mfma32(*(const LAS bf16x8*)(lds + SST + (32 * vb + q) * 272 + k0), *(const LAS bf16x8*)(lds + QPO + q * 272 + k0), oT); }
                if (kh == 0) {
                    f32x16 aT;
#pragma unroll
                    for (int i = 0; i < 16; ++i) aT[i] = 0.f;
#pragma unroll
                    for (int ks = 0; ks < 8; ++ks) { const int k0 = (16 * ks + 8 * g) * 2;
                        aT = mfma32(*(const LAS bf16x8*)(lds + KPN + q * 272 + k0), *(const LAS bf16x8*)(lds + QPO + q * 272 + k0), aT); }
#pragma unroll
                    for (int i = 0; i < 16; ++i) { const int s = (i & 3) + 8 * (i >> 2) + 4 * g; if (s > q) aT[i] = 0.f; }
#pragma unroll
                    for (int t2 = 0; t2 < 2; ++t2) {
                        u32x4 pw; pw.x = pk2(aT[8 * t2 + 0], aT[8 * t2 + 1]); pw.y = pk2(aT[8 * t2 + 2], aT[8 * t2 + 3]); pw.z = pk2(aT[8 * t2 + 4], aT[8 * t2 + 5]); pw.w = pk2(aT[8 * t2 + 6], aT[8 * t2 + 7]);
                        const int so = (16 * t2 + 4 * g) * 2;
                        const u32x2 lo = *(const LAS u32x2*)(lds + VTT + (32 * vb + q) * 80 + so), hi = *(const LAS u32x2*)(lds + VTT + (32 * vb + q) * 80 + so + 16);
                        const u32x4 av = (u32x4){lo.x, lo.y, hi.x, hi.y};
                        oT = mfma32(__builtin_bit_cast(bf16x8, av), __builtin_bit_cast(bf16x8, pw), oT); }
                }
#pragma unroll
                for (int qd = 0; qd < 4; ++qd) *(LAS f32x4*)(lds + OPART + kh * 16896 + q * 528 + (32 * vb + 8 * qd + 4 * g) * 4) = (f32x4){oT[4 * qd], oT[4 * qd + 1], oT[4 * qd + 2], oT[4 * qd + 3]};
            }
#pragma unroll
            for (int t2 = 0; t2 < 2; ++t2) { const int so = (16 * t2 + 8 * g) * 2; const bf16x8 bv = *(const LAS bf16x8*)(lds + VTT + (32 * vb + q) * 80 + so);
                st0 = mfma32(*(const LAS bf16x8*)(lds + KPT + (32 * (2 * kh) + q) * 80 + so), bv, st0);
                st1 = mfma32(*(const LAS bf16x8*)(lds + KPT + (32 * (2 * kh + 1) + q) * 80 + so), bv, st1); }
#pragma unroll
            for (int qd = 0; qd < 4; ++qd) { const f32x4 e0 = *(const LAS f32x4*)(lds + ELAST + (32 * (2 * kh) + 8 * qd + 4 * g) * 4), e1 = *(const LAS f32x4*)(lds + ELAST + (32 * (2 * kh + 1) + 8 * qd + 4 * g) * 4);
#pragma unroll
                for (int e = 0; e < 4; ++e) { st0[4 * qd + e] *= e0[e]; st1[4 * qd + e] *= e1[e]; } }
            __syncthreads();
            {
                const LAS float* o0p = (const LAS float*)(lds + OPART + dt * 528 + dpart * 32); const LAS float* o1p = (const LAS float*)(lds + OPART + 16896 + dt * 528 + dpart * 32);
                const f32x4 a0 = *(const LAS f32x4*)o0p + *(const LAS f32x4*)o1p, a1 = *(const LAS f32x4*)(o0p + 4) + *(const LAS f32x4*)(o1p + 4);
                float ss = (a0[0] * a0[0] + a0[1] * a0[1]) + (a0[2] * a0[2] + a0[3] * a0[3]) + (a1[0] * a1[0] + a1[1] * a1[1]) + (a1[2] * a1[2] + a1[3] * a1[3]);
                ss += __shfl_xor(ss, 1); ss += __shfl_xor(ss, 2); ss += __shfl_xor(ss, 4); ss += __shfl_xor(ss, 8);
                const float rstd = __builtin_amdgcn_rsqf(ss * (1.f / 128.f) + RMS_EPS);
                const f32x4 r0 = a0 * rstd * gn0, r1 = a1 * rstd * gn1;
                u32x4 w;
                w.x = pk2(r0[0] * bf2f((unsigned short)(gsv.x & 0xffff)), r0[1] * bf2f((unsigned short)(gsv.x >> 16)));
                w.y = pk2(r0[2] * bf2f((unsigned short)(gsv.y & 0xffff)), r0[3] * bf2f((unsigned short)(gsv.y >> 16)));
                w.z = pk2(r1[0] * bf2f((unsigned short)(gsv.z & 0xffff)), r1[1] * bf2f((unsigned short)(gsv.z >> 16)));
                w.w = pk2(r1[2] * bf2f((unsigned short)(gsv.w & 0xffff)), r1[3] * bf2f((unsigned short)(gsv.w >> 16)));
                *(u32x4*)(OG + dbase + (size_t)c * 32 * 1024) = w;
            }
        }
    }
}

constexpr int N_PHASES = 34;
template <class Epi>
__device__ __forceinline__ void run_gemm(LAS unsigned char* lds, const bf16_t* A, const bf16_t* Bt, int N, int K, const Epi& E) {
    asm volatile("" : "+s"(K), "+s"(N));
    pg8::Gemm g{A, Bt, M_TOK, N, K}; pg8::StaticOrder S; S.init(M_TOK, N, mk_grid(), mk_bid());
    pg8::gemm_phase<Epi, pg8::StaticOrder, true, true>((PG8_LAS unsigned char*)lds, g, S, E);
}

template <class Epi>
__device__ __forceinline__ void run_gemm_t(LAS unsigned char* lds, const bf16_t* A, const bf16_t* Bt, int K, const Epi& E) {
    asm volatile("" : "+s"(K));
    pg8::Gemm g{A, Bt, 1024, M_TOK, K}; pg8::StaticOrder S; S.init(1024, M_TOK, mk_grid(), mk_bid());
    pg8::gemm_phase<Epi, pg8::StaticOrder, true, true>((PG8_LAS unsigned char*)lds, g, S, E);
}

__global__ void __launch_bounds__(512, 2) fwd_megakernel(Params p) {
    extern __shared__ __attribute__((aligned(16))) unsigned char lds_raw[];
    LAS unsigned char* lds = (LAS unsigned char*)lds_raw;
    cg::grid_group grid = cg::this_grid();
    const int ph_lo = p.ph_lo, ph_hi = p.ph_hi;
    if (mk_tid() < 16) ((volatile LAS unsigned*)(lds + 131072))[mk_tid()] = 0u;
    __syncthreads();
    const XcdBarrier bar = xcd_barrier_post((unsigned*)(p.ws + WS_BAR), (volatile LAS unsigned*)(lds + 131072));
#if defined(PROBE_TIME_MASK)
    unsigned long long t_acc = 0;
#endif
#pragma unroll 1
    for (int ph = ph_lo; ph < ph_hi; ++ph) {
#if defined(PROBE_TIME_MASK)
        const unsigned long long t_ph0 = __builtin_amdgcn_s_memrealtime();
#endif
        unsigned long long kptr = (unsigned long long)__builtin_amdgcn_kernarg_segment_ptr(); asm volatile("" : "+s"(kptr));
        const ParamsPtr pp = (ParamsPtr)kptr;
#define p (*pp)
        unsigned char* ws = p.ws;
        float* MOD = (float*)(ws + WS_MOD); const float* TAB = (const float*)(ws + WS_TAB); const float* LB = (const float*)(ws + WS_LB);
        bf16_t* H = (bf16_t*)(ws + WS_H); float* RS = (float*)(ws + WS_RS);
        int kind, layer = 0;
        if (ph == 0) kind = 0; else if (ph == 1) kind = 1;
        else { const int qq = ph - 2, pair = qq >> 4, r = qq & 15;
            if (r < 9) { layer = 2 * pair; kind = (r < 6) ? 2 + r : 8 + (r - 6); if (r == 5) kind = 7; }
            else { layer = 2 * pair + 1; const int r2 = r - 9; kind = (r2 == 0) ? 11 : (r2 == 1) ? 12 : (r2 == 2) ? 6 : (r2 == 3) ? 7 : 8 + (r2 - 4); } }
        const int j = layer >> 1;
        switch (kind) {
        case 0:
#if defined(PROBE_DUP_PRO)
            prologue_phase(pp, lds); __syncthreads();
#endif
            prologue_phase(pp, lds); break;
        case 1:
#if defined(PROBE_DUP_NORM0)
            norm_phase(p.x, p.X, false, false, nullptr, nullptr, RS, true, MOD, H); norm_phase(p.x, p.X, false, false, nullptr, nullptr, RS, true, MOD, H); norm_phase(p.x, p.X, false, false, nullptr, nullptr, RS, true, MOD, H); norm_phase(p.x, p.X, false, false, nullptr, nullptr, RS, true, MOD, H);
#endif
            norm_phase(p.x, p.X, false, false, nullptr, nullptr, RS, true, MOD, H); break;
        case 2: { EpiProj E{(float*)(ws + R_PROJ), 1056, 1056}; run_gemm(lds, H, (const bf16_t*)(ws + W_MWIN) + (size_t)j * 1280 * 1024, 1280, 1024, E); } break;
        case 3: latnorm_phase((const float*)(ws + R_PROJ), p.mla_qn + j * 768, p.mla_kvn + j * 256, TAB, (bf16_t*)(ws + R_LATQ), (bf16_t*)(ws + R_LATKV), (bf16_t*)(ws + R_KR)); break;
        case 4: { EpiQ Eq{(bf16_t*)(ws + R_Q), TAB}; run_gemm(lds, (const bf16_t*)(ws + R_LATQ), (const bf16_t*)(ws + W_MWQB) + (size_t)j * 1536 * 768, 1536, 768, Eq);
                  const bf16_t* Wkv = (const bf16_t*)(ws + W_MWKVB) + (size_t)j * 2048 * 256;
                  EpiBf16 Ek{(bf16_t*)(ws + R_KN), 1024}; run_gemm(lds, (const bf16_t*)(ws + R_LATKV), Wkv, 1024, 256, Ek);
                  EpiVT Ev{(bf16_t*)(ws + R_VT)}; run_gemm_t(lds, Wkv + (size_t)1024 * 256, (const bf16_t*)(ws + R_LATKV), 256, Ev); } break;
        case 5:
#if defined(PROBE_DUP_ATTN)
            attn_phase(lds, (const bf16_t*)(ws + R_Q), (const bf16_t*)(ws + R_KN), (const bf16_t*)(ws + R_KR), (const bf16_t*)(ws + R_VT), (bf16_t*)(ws + R_O));
#endif
            attn_phase(lds, (const bf16_t*)(ws + R_Q), (const bf16_t*)(ws + R_KN), (const bf16_t*)(ws + R_KR), (const bf16_t*)(ws + R_VT), (bf16_t*)(ws + R_O)); break;
        case 6: { const bool mla = (layer & 1) == 0; const int pl = layer > 0 ? 2 * layer - 1 : 0;
                  EpiResid E{layer == 0 ? p.x : (const float*)p.X, p.X, MOD + (size_t)(2 * layer) * 16 * 3072, RS, p.ln_g + (size_t)pl * 1024, p.ln_b + (size_t)pl * 1024, layer == 0 ? 1 : 0};
                  const bf16_t* A = mla ? (const bf16_t*)(ws + R_O) : (const bf16_t*)H;
                  const bf16_t* Bt = mla ? (const bf16_t*)(ws + W_MWO) + (size_t)j * 1024 * 1024 : (const bf16_t*)(ws + W_HWO) + (size_t)j * 1024 * 1024;
                  run_gemm(lds, A, Bt, 1024, 1024, E); } break;
        case 7: norm_phase(p.X, p.X, true, false, p.ln_g + (size_t)(2 * layer) * 1024, p.ln_b + (size_t)(2 * layer) * 1024, RS, true, MOD + (size_t)(2 * layer + 1) * 16 * 3072, H); break;
        case 8: { EpiSwiGLU E{(bf16_t*)(ws + R_T)};
#if defined(PROBE_DUP_G4)
            run_gemm(lds, H, (const bf16_t*)(ws + W_FWIN) + (size_t)layer * 5632 * 1024, 5632, 1024, E);
#endif
            run_gemm(lds, H, (const bf16_t*)(ws + W_FWIN) + (size_t)layer * 5632 * 1024, 5632, 1024, E); } break;
        case 9: { EpiResid E{p.X, p.X, MOD + (size_t)(2 * layer + 1) * 16 * 3072, RS, p.ln_g + (size_t)(2 * layer) * 1024, p.ln_b + (size_t)(2 * layer) * 1024, 0}; run_gemm(lds, (const bf16_t*)(ws + R_T), (const bf16_t*)(ws + W_FWOUT) + (size_t)layer * 1024 * FF, 1024, FF, E); } break;
        case 10: norm_phase(p.X, p.X, true, layer == 3, p.ln_g + (size_t)(2 * layer + 1) * 1024, p.ln_b + (size_t)(2 * layer + 1) * 1024, RS, layer < 3, MOD + (size_t)(2 * layer + 2) * 16 * 3072, H); break;
        case 11: { EpiHgrnIn E{(bf16_t*)(ws + R_QS), (bf16_t*)(ws + R_KP), (float*)(ws + R_EL), LB + j * 1024};
                   run_gemm(lds, H, (const bf16_t*)(ws + W_HWIN) + (size_t)j * 4096 * 1024, 4096, 1024, E); } break;
        case 12:
#if defined(PROBE_DUP_REC)
            hgrn_phase(lds, (const bf16_t*)(ws + R_QS), (const bf16_t*)(ws + R_KP), (const float*)(ws + R_EL), (const bf16_t*)(ws + R_VV), (const bf16_t*)(ws + R_GS), p.hgrn_gn + j * 128, H);
#endif
            hgrn_phase(lds, (const bf16_t*)(ws + R_QS), (const bf16_t*)(ws + R_KP), (const float*)(ws + R_EL), (const bf16_t*)(ws + R_VV), (const bf16_t*)(ws + R_GS), p.hgrn_gn + j * 128, H); break;
        default: break;
        }
        if (ph + 1 < ph_hi) { if (ph_hi > 4096) grid.sync(); else xcd_barrier(bar); }
#if defined(PROBE_TIME_MASK)
        if ((PROBE_TIME_MASK >> kind) & 1) t_acc += __builtin_amdgcn_s_memrealtime() - t_ph0;
#endif
#if defined(PROBE_DUP_SYNC)
        if (ph + 1 < ph_hi) { xcd_barrier(bar); xcd_barrier(bar); xcd_barrier(bar); xcd_barrier(bar); }
#endif
#undef p
    }
#if defined(PROBE_TIME_MASK)
    if (mk_bid() == 0) { const unsigned long long t_e = __builtin_amdgcn_s_memrealtime(); while (__builtin_amdgcn_s_memrealtime() - t_e < t_acc) __builtin_amdgcn_s_sleep(8); }
#endif
}

#ifndef MK_MULTI
#define MK_MULTI 0
#endif
extern "C" void kernel_launch(void* const* d_in, const int* in_sizes, int n_in, void* d_out, int out_size, void* d_ws, size_t ws_size, hipStream_t stream) {
    static int grid = 0;
    if (grid == 0) {
        if (n_in != 19 || out_size != M_TOK * DM || ws_size < WS_END) { fprintf(stderr, "kernel_launch: unexpected sizes: n_in %d out %d ws %zu (need %zu)\n", n_in, out_size, ws_size, (size_t)WS_END); grid = -1; return; }
        int dev = 0, cus = 0, per_cu = 0;
        hipGetDevice(&dev); hipDeviceGetAttribute(&cus, hipDeviceAttributeMultiprocessorCount, dev);
        if (hipFuncSetAttribute((const void*)fwd_megakernel, hipFuncAttributeMaxDynamicSharedMemorySize, LDS_BYTES) != hipSuccess) { fprintf(stderr, "kernel_launch: hipFuncSetAttribute failed\n"); grid = -1; return; }
        hipOccupancyMaxActiveBlocksPerMultiprocessor(&per_cu, (const void*)fwd_megakernel, 512, LDS_BYTES);
        (void)hipGetLastError();
        if (per_cu < 1) per_cu = 1;
        grid = cus * 1;
        fprintf(stderr, "kernel_launch: cus %d per_cu %d grid %d\n", cus, per_cu, grid);
    }
    if (grid < 0) return;
    if (hipMemsetAsync((char*)d_ws + WS_BAR, 0, XCD_BAR_WORDS * 4, stream) != hipSuccess) { fprintf(stderr, "kernel_launch: memset failed\n"); return; }
    Params p{};
    p.x = (const float*)d_in[0]; p.c = (const float*)d_in[1]; p.pos = (const int*)d_in[2];
    p.mla_qn = (const float*)d_in[4]; p.mla_kvn = (const float*)d_in[6]; p.hgrn_lb = (const float*)d_in[9]; p.hgrn_gn = (const float*)d_in[11];
    p.ada_w = (const float*)d_in[15]; p.ada_b = (const float*)d_in[16]; p.ln_g = (const float*)d_in[17]; p.ln_b = (const float*)d_in[18];
    p.X = (float*)d_out; p.ws = (unsigned char*)d_ws;
    p.wsrc[0] = (const float*)d_in[3]; p.wsrc[1] = (const float*)d_in[5]; p.wsrc[2] = (const float*)d_in[7]; p.wsrc[3] = (const float*)d_in[8];
    p.wsrc[4] = (const float*)d_in[10]; p.wsrc[5] = (const float*)d_in[12]; p.wsrc[6] = (const float*)d_in[13]; p.wsrc[7] = (const float*)d_in[14];
    for (int i = 0; i < 16; ++i) p.invf[i] = (float)pow(10000.0, -(double)i / 16.0);
#if MK_MULTI
    for (int ph = 0; ph < N_PHASES; ++ph) { p.ph_lo = ph; p.ph_hi = ph + 1; hipLaunchKernelGGL(fwd_megakernel, dim3(grid), dim3(512), LDS_BYTES, stream, p); }
#else
    p.ph_lo = 0; p.ph_hi = N_PHASES;
    void* args[] = {&p};
    hipError_t e = hipLaunchCooperativeKernel((const void*)fwd_megakernel, dim3(grid), dim3(512), args, LDS_BYTES, stream);
    if (e != hipSuccess) fprintf(stderr, "cooperative launch failed: %s (grid %d)\n", hipGetErrorString(e), grid);
#endif
}
```

```cpp
#include <hip/hip_runtime.h>
#include <hip/hip_cooperative_groups.h>
#include <cstdio>
#include <cstdint>
#include <cmath>
namespace cg = cooperative_groups;

__device__ __forceinline__ int mk_tid() { int t = (int)threadIdx.x; asm volatile("" : "+v"(t)); return t; }
__device__ __forceinline__ int mk_bid() { int t = (int)blockIdx.x; asm volatile("" : "+s"(t)); return t; }
__device__ __forceinline__ int mk_grid() { int t = (int)gridDim.x; asm volatile("" : "+s"(t)); return t; }
namespace pg8 {
#define PG8_LAS __attribute__((address_space(3)))
typedef unsigned short bf16_t;
typedef short bf16x8 __attribute__((ext_vector_type(8)));
typedef float f32x4 __attribute__((ext_vector_type(4)));
typedef unsigned u32x4 __attribute__((ext_vector_type(4)));
constexpr int BM = 256, BK = 64, HALF = 128, HTB = HALF * BK * 2  , STAGE_BYTES = 8 * HTB, NXCD = 8, WGM = 8;

__host__ __device__ __forceinline__ int lds_byte(int r, int c) { const int st = (r >> 4) * 2 + (c >> 5), rr = r & 15, cc = c & 31, ob = rr * 64 + cc * 2; return st * 1024 + (ob ^ (((ob >> 9) & 1) << 5)); }
__host__ __device__ __forceinline__ void stage_rc(int b, int& R, int& C) { const int st = b / 1024, sb = b % 1024, swz = sb ^ (((sb >> 9) & 1) << 5); R = (st >> 1) * 16 + swz / 64; C = (st & 1) * 32 + (swz % 64) / 2; }
__host__ __device__ __forceinline__ int perm32(int rho) { const int n = rho >> 4, i = rho & 15; return 8 * (i >> 2) + 4 * n + (i & 3); }

struct Unit { int pm, pn; };
struct Gemm { const bf16_t* A; const bf16_t* Bt; int M, N, K; };

struct StaticOrder {
    int nM, nN, nwg, G, c;
    __host__ __device__ void init(int M, int N, int G_, int c_) { nM = M / BM; nN = N / BM; nwg = nM * nN; G = G_; c = c_; }
    __host__ __device__ bool next(int i, Unit& u) const {
        const long L = (long)i * G + c; if (L >= nwg) return false;
        int wgid = (int)L; { const int q = nwg / NXCD, r = nwg % NXCD, xcd = wgid % NXCD, off = wgid / NXCD; wgid = (xcd < r ? xcd * (q + 1) : r * (q + 1) + (xcd - r) * q) + off; }
        const int nig = WGM * nN, gid = wgid / nig, fm = gid * WGM, gsz = (nM - fm) < WGM ? (nM - fm) : WGM;
        u.pm = fm + ((wgid % nig) % gsz); u.pn = (wgid % nig) / gsz; return true;
    }
    __device__ __forceinline__ void a_ready(const Unit&) const {}
    __device__ __forceinline__ void done(const Unit&) const {}
};

__device__ __forceinline__ unsigned cvt_pk_bf16(float lo, float hi) { unsigned r; asm volatile("v_cvt_pk_bf16_f32 %0, %1, %2" : "=v"(r) : "v"(lo), "v"(hi)); return r; }
template <class Epi, class Sched, bool ALIGN_EPI = false, bool SP2 = false>
__device__ __forceinline__ void gemm_phase(PG8_LAS unsigned char* lds, const Gemm g, const Sched& S, const Epi& E) {
    const int tid = mk_tid(), wid = __builtin_amdgcn_readfirstlane(tid >> 6), lane = tid & 63, wr = wid >> 2, wc = wid & 3, fr = lane & 15, fq = lane >> 4;
    const int K = g.K, nt = K / BK;
    unsigned voffA[2], voffB[2];
#pragma unroll
    for (int i = 0; i < 2; ++i) { int R, C; stage_rc(tid * 16 + i * 8192, R, C); const int Rb = Epi::PERM ? ((R & ~31) + perm32(R & 31)) : R;
        voffA[i] = (unsigned)(R * K + C) * 2u; voffB[i] = (unsigned)(Rb * K + C) * 2u; }
    const size_t kstep = (size_t)(BK * 2);
    const size_t hstep = (size_t)HALF * K * 2;
    const size_t tstep = 2 * hstep;
    const unsigned ldsw = (unsigned)wid * 1024u;
    const int aoff = lds_byte(wr * 64 + fr, fq * 8), boff = lds_byte(wc * 32 + fr, fq * 8);
#define PG8_SA(b, h) (((b) * 2 + (h)) * HTB)
#define PG8_SB(b, h) ((4 + (b) * 2 + (h)) * HTB)
#define PG8_STAGE(bufoff, gbase, voff) do { _Pragma("unroll") for (int _i = 0; _i < 2; ++_i) \
        __builtin_amdgcn_global_load_lds((const unsigned*)((const char*)(gbase) + (voff)[_i]), (PG8_LAS unsigned*)(lds + (bufoff) + ldsw + _i * 8192), 16, 0, 0); } while (0)
#define PG8_LDA(dst, b, h) do { _Pragma("unroll") for (int m = 0; m < 4; ++m) _Pragma("unroll") for (int k = 0; k < 2; ++k) dst[m][k] = *(const PG8_LAS bf16x8*)(lds + PG8_SA(b, h) + aoff + m * 2048 + k * 1024); } while (0)
#define PG8_LDB(dst, b, h) do { _Pragma("unroll") for (int n = 0; n < 2; ++n) _Pragma("unroll") for (int k = 0; k < 2; ++k) dst[n][k] = *(const PG8_LAS bf16x8*)(lds + PG8_SB(b, h) + boff + n * 2048 + k * 1024); } while (0)
#define PG8_MMA(ai, bj, At, Bt) do { __builtin_amdgcn_s_setprio(1); _Pragma("unroll") for (int m = 0; m < 4; ++m) _Pragma("unroll") for (int n = 0; n < 2; ++n) _Pragma("unroll") for (int k = 0; k < 2; ++k) \
        acc[ai][bj][m][n] = __builtin_amdgcn_mfma_f32_16x16x32_bf16(Bt[n][k], At[m][k], acc[ai][bj][m][n], 0, 0, 0); __builtin_amdgcn_s_setprio(0); } while (0)
#define PG8_WAIT_V(n) asm volatile("s_waitcnt vmcnt(" #n ")" ::: "memory")
#define PG8_WAIT_L(n) asm volatile("s_waitcnt lgkmcnt(" #n ")" ::: "memory")
#define PG8_BAR __builtin_amdgcn_s_barrier()
#define PG8_SCHED __builtin_amdgcn_sched_barrier(0)
    Unit cur, nxt; int ui = 0;
    if (!S.next(0, cur)) return;
    f32x4 acc[2][2][4][2];
#pragma unroll
    for (int a = 0; a < 2; ++a)
#pragma unroll
        for (int b = 0; b < 2; ++b)
#pragma unroll
            for (int m = 0; m < 4; ++m)
#pragma unroll
                for (int n = 0; n < 2; ++n) acc[a][b][m][n] = (f32x4){0.f, 0.f, 0.f, 0.f};
    bf16x8 At[4][2], B0[2][2], B1[2][2];
    const char* cA = (const char*)g.A + (size_t)cur.pm * tstep; const char* cB = (const char*)g.Bt + (size_t)cur.pn * tstep;
    S.a_ready(cur);
    if constexpr (SP2) {
        PG8_STAGE(PG8_SB(0, 0), cB, voffB); PG8_STAGE(PG8_SB(0, 1), cB + hstep, voffB); PG8_STAGE(PG8_SA(0, 0), cA, voffA); PG8_STAGE(PG8_SA(0, 1), cA + hstep, voffA);
        if (wr == 1) PG8_BAR;
        PG8_WAIT_V(2); PG8_BAR;
        PG8_STAGE(PG8_SB(1, 0), cB + kstep, voffB); PG8_STAGE(PG8_SA(1, 0), cA + kstep, voffA); PG8_STAGE(PG8_SB(1, 1), cB + hstep + kstep, voffB);
        PG8_WAIT_V(6); PG8_BAR;
    } else {
        PG8_STAGE(PG8_SB(0, 0), cB, voffB); PG8_STAGE(PG8_SA(0, 0), cA, voffA); PG8_STAGE(PG8_SB(0, 1), cB + hstep, voffB); PG8_STAGE(PG8_SA(0, 1), cA + hstep, voffA);
        if (wr == 1) PG8_BAR;
        PG8_WAIT_V(4); PG8_BAR;
        PG8_STAGE(PG8_SB(1, 0), cB + kstep, voffB); PG8_STAGE(PG8_SA(1, 0), cA + kstep, voffA); PG8_STAGE(PG8_SB(1, 1), cB + hstep + kstep, voffB);
        PG8_WAIT_V(6); PG8_BAR;
    }
    for (;;) {
        const bool has_next = S.next(ui + 1, nxt);
        const char* nA = has_next ? (const char*)g.A + (size_t)nxt.pm * tstep : cA; const char* nB = has_next ? (const char*)g.Bt + (size_t)nxt.pn * tstep : cB;
        for (int t = 0; t < nt; t += 2) {
            const bool last = (t == nt - 2);
            const char* a1 = cA + (size_t)(t + 1) * kstep;
            const char* a2 = last ? nA : cA + (size_t)(t + 2) * kstep; const char* b2 = last ? nB : cB + (size_t)(t + 2) * kstep;
            const char* a3 = a2 + kstep; const char* b3 = b2 + kstep;
            if (last && has_next) S.a_ready(nxt);
            if constexpr (SP2) {
            PG8_LDB(B0, 0, 0); PG8_LDB(B1, 0, 1); PG8_SCHED; PG8_LDA(At, 0, 0); PG8_STAGE(PG8_SA(1, 1), a1 + hstep, voffA);
            PG8_WAIT_V(8); PG8_WAIT_L(0); PG8_BAR; PG8_MMA(0, 0, At, B0); PG8_MMA(0, 1, At, B1); PG8_BAR; PG8_SCHED;
            PG8_LDA(At, 0, 1); PG8_STAGE(PG8_SB(0, 0), b2, voffB); PG8_STAGE(PG8_SB(0, 1), b2 + hstep, voffB); PG8_STAGE(PG8_SA(0, 0), a2, voffA);
            PG8_WAIT_V(8); PG8_WAIT_L(0); PG8_BAR; PG8_MMA(1, 0, At, B0); PG8_MMA(1, 1, At, B1); PG8_BAR; PG8_SCHED;
            PG8_LDB(B0, 1, 0); PG8_LDB(B1, 1, 1); PG8_SCHED; PG8_LDA(At, 1, 0); PG8_STAGE(PG8_SA(0, 1), a2 + hstep, voffA);
            PG8_WAIT_V(8); PG8_WAIT_L(0); PG8_BAR; PG8_MMA(0, 0, At, B0); PG8_MMA(0, 1, At, B1); PG8_BAR; PG8_SCHED;
            PG8_LDA(At, 1, 1); PG8_STAGE(PG8_SB(1, 0), b3, voffB); PG8_STAGE(PG8_SB(1, 1), b3 + hstep, voffB); PG8_STAGE(PG8_SA(1, 0), a3, voffA);
            PG8_WAIT_V(8); PG8_WAIT_L(0); PG8_BAR; PG8_MMA(1, 0, At, B0); PG8_MMA(1, 1, At, B1); PG8_BAR; PG8_SCHED;
            } else {
            PG8_LDB(B0, 0, 0); PG8_SCHED; PG8_LDA(At, 0, 0); PG8_STAGE(PG8_SA(1, 1), a1 + hstep, voffA);
            PG8_WAIT_L(8); PG8_BAR; PG8_WAIT_L(0); PG8_MMA(0, 0, At, B0); PG8_BAR; PG8_SCHED;
            PG8_LDB(B1, 0, 1); PG8_STAGE(PG8_SB(0, 0), b2, voffB);
            PG8_BAR; PG8_WAIT_L(0); PG8_MMA(0, 1, At, B1); PG8_BAR;
            PG8_LDA(At, 0, 1); PG8_STAGE(PG8_SA(0, 0), a2, voffA);
            PG8_BAR; PG8_WAIT_L(0); PG8_MMA(1, 0, At, B0); PG8_BAR; PG8_SCHED;
            PG8_STAGE(PG8_SB(0, 1), b2 + hstep, voffB);
            PG8_WAIT_V(6); PG8_BAR; PG8_MMA(1, 1, At, B1); PG8_BAR;
            PG8_LDB(B0, 1, 0); PG8_SCHED; PG8_LDA(At, 1, 0); PG8_STAGE(PG8_SA(0, 1), a2 + hstep, voffA);
            PG8_WAIT_L(8); PG8_BAR; PG8_WAIT_L(0); PG8_MMA(0, 0, At, B0); PG8_BAR; PG8_SCHED;
            PG8_LDB(B1, 1, 1); PG8_STAGE(PG8_SB(1, 0), b3, voffB);
            PG8_BAR; PG8_WAIT_L(0); PG8_MMA(0, 1, At, B1); PG8_BAR;
            PG8_LDA(At, 1, 1); PG8_STAGE(PG8_SA(1, 0), a3, voffA);
            PG8_BAR; PG8_WAIT_L(0); PG8_MMA(1, 0, At, B0); PG8_BAR; PG8_SCHED;
            PG8_STAGE(PG8_SB(1, 1), b3 + hstep, voffB);
            PG8_WAIT_V(6); PG8_BAR; PG8_MMA(1, 1, At, B1); PG8_BAR;
            }
        }
        if constexpr (ALIGN_EPI) { if (wr == 0) PG8_BAR; }
        if constexpr (!Epi::AFTER_DRAIN) { E(acc, cur, wr, wc, fr, fq); S.done(cur); }
        if (!has_next) break;
#pragma unroll
        for (int a = 0; a < 2; ++a)
#pragma unroll
            for (int b = 0; b < 2; ++b)
#pragma unroll
                for (int m = 0; m < 4; ++m)
#pragma unroll
                    for (int n = 0; n < 2; ++n) acc[a][b][m][n] = (f32x4){0.f, 0.f, 0.f, 0.f};
        cur = nxt; cA = nA; cB = nB; ++ui;
        if constexpr (ALIGN_EPI) { if (wr == 1) PG8_BAR; }
    }
    PG8_WAIT_V(0);
    if constexpr (!ALIGN_EPI) { if (wr == 0) PG8_BAR; }
    PG8_BAR;
    if constexpr (Epi::AFTER_DRAIN) { E.fused(acc, cur, wr, wc, fr, fq, lds, wid, lane); S.done(cur); }
#undef PG8_SA
#undef PG8_SB
#undef PG8_STAGE
#undef PG8_LDA
#undef PG8_LDB
#undef PG8_MMA
#undef PG8_WAIT_V
#undef PG8_WAIT_L
#undef PG8_BAR
#undef PG8_SCHED
}
}

#define LAS __attribute__((address_space(3)))
typedef unsigned short bf16_t;
typedef short bf16x8 __attribute__((ext_vector_type(8)));
typedef short bf16x4 __attribute__((ext_vector_type(4)));
typedef float f32x4 __attribute__((ext_vector_type(4)));
typedef float f32x16 __attribute__((ext_vector_type(16)));
typedef unsigned u32x4 __attribute__((ext_vector_type(4)));
typedef unsigned u32x2 __attribute__((ext_vector_type(2)));

constexpr int M_TOK = 32768, DM = 1024, SEQ = 2048, NB = 16;
constexpr int FF = 2816;
constexpr float ALPHA = 1.681792830507429f;
constexpr float LN_EPS = 1e-5f, RMS_EPS = 1e-6f;
constexpr float QSCALE = 0.10206207261596575f * 1.4426950408889634f;

constexpr size_t MiB = 1u << 20;
constexpr size_t WS_MOD = 0, WS_LB = 3 * MiB / 2, WS_TAB = 2 * MiB;
constexpr size_t W_MWIN = 6 * MiB, W_MWQB = 11 * MiB, W_MWKVB = 31 * MiB / 2, W_MWO = 35 * MiB / 2, W_HWIN = 43 * MiB / 2, W_HWO = 75 * MiB / 2,
                 W_FWIN = 83 * MiB / 2, W_FWOUT = 171 * MiB / 2;
constexpr size_t WS_SS = 215 * MiB / 2;
constexpr size_t WS_H = 108 * MiB, WS_R = 172 * MiB;
constexpr size_t R_T = WS_R, R_PROJ = WS_R, R_Q = WS_R, R_LATQ = WS_R + 132 * MiB, R_LATKV = WS_R + 180 * MiB, R_O = WS_R + 132 * MiB,
                 R_KR = WS_R + 196 * MiB, R_KN = WS_R + 198 * MiB, R_VT = WS_R + 262 * MiB;
constexpr size_t R_KP = WS_R + 64 * MiB, R_EL = WS_R + 128 * MiB;
constexpr size_t R_QS = WS_R, R_LOGF = WS_R + 64 * MiB, R_VV = WS_R + 192 * MiB, R_GS = WS_R + 256 * MiB;
constexpr size_t WS_END = WS_R + 326 * MiB;
constexpr int LDS_BYTES = 131072 + 64;
constexpr size_t WS_BAR = WS_LB + 65536;
constexpr size_t WS_RS = WS_LB + 131072;

struct Params {
    const float* x; const float* c; const int* pos;
    const float* mla_qn; const float* mla_kvn; const float* hgrn_lb; const float* hgrn_gn;
    const float* ada_w; const float* ada_b; const float* ln_g; const float* ln_b;
    float* X; unsigned char* ws;
    const float* wsrc[8];
    float invf[16];
    int ph_lo, ph_hi;
};
typedef const __attribute__((address_space(4))) Params* ParamsPtr;
struct WType { int K, N, layers, mode; size_t dst; int drows; };
constexpr WType WT[8] = {
    {1024, 1056, 2, 0, W_MWIN, 1280}, {768, 1536, 2, 0, W_MWQB, 1536}, {256, 2048, 2, 2, W_MWKVB, 2048}, {1024, 1024, 2, 0, W_MWO, 1024},
    {1024, 4096, 2, 3, W_HWIN, 4096}, {1024, 1024, 2, 0, W_HWO, 1024}, {1024, 5632, 4, 1, W_FWIN, 5632}, {2816, 1024, 4, 0, W_FWOUT, 1024} };
constexpr int wt_items(int t) { return (WT[t].K / 64) * (WT[t].N / 32); }
constexpr int wt_total() { int s = 0; for (int t = 0; t < 8; ++t) s += wt_items(t) * WT[t].layers; return s; }

__device__ __forceinline__ unsigned pk2(float lo, float hi) { unsigned r; asm volatile("v_cvt_pk_bf16_f32 %0, %1, %2" : "=v"(r) : "v"(lo), "v"(hi)); return r; }
__device__ __forceinline__ float bf2f(unsigned short h) { return __uint_as_float((unsigned)h << 16); }
__device__ __forceinline__ float wave_sum(float v) {
#pragma unroll
    for (int o = 1; o < 64; o <<= 1) v += __shfl_xor(v, o);
    return v;
}
__device__ __forceinline__ float fast_rcp(float x) { return __builtin_amdgcn_rcpf(x); }
__device__ __forceinline__ float sigmoidf_(float x) { return fast_rcp(1.f + __expf(-x)); }
__device__ __forceinline__ float siluf_(float x) { return x * sigmoidf_(x); }
__device__ __forceinline__ int crow(int r, int hi) { return (r & 3) + 8 * (r >> 2) + 4 * hi; }
__device__ __forceinline__ f32x16 mfma32(bf16x8 a, bf16x8 b, f32x16 c) { return __builtin_amdgcn_mfma_f32_32x32x16_bf16(a, b, c, 0, 0, 0); }

struct EpiLat {
    static constexpr bool PERM = false, AFTER_DRAIN = false;
    bf16_t* LATQ; bf16_t* LATKV; bf16_t* KR; float* SS; const float* tab;
    __device__ __forceinline__ void operator()(const pg8::f32x4 (&acc)[2][2][4][2], const pg8::Unit& u, int wr, int wc, int fr, int fq) const {
        const int row0 = u.pm * 256 + wr * 64 + fr;
        if (u.pn < 4) {
            const bool isq = u.pn < 3; bf16_t* base = isq ? LATQ : LATKV; const int ld = isq ? 768 : 256, col0 = (isq ? u.pn * 256 : 0) + wc * 32 + 4 * fq;
#pragma unroll
            for (int ai = 0; ai < 2; ++ai)
#pragma unroll
                for (int m = 0; m < 4; ++m) { const int row = row0 + ai * 128 + m * 16; bf16_t* rp = base + (size_t)row * ld + col0; float sq = 0.f;
#pragma unroll
                    for (int bj = 0; bj < 2; ++bj)
#pragma unroll
                        for (int n = 0; n < 2; ++n) { const f32x4 v = acc[ai][bj][m][n]; sq += (v[0] * v[0] + v[1] * v[1]) + (v[2] * v[2] + v[3] * v[3]);
                            u32x2 w; w.x = pk2(v[0], v[1]); w.y = pk2(v[2], v[3]); *(u32x2*)(rp + bj * 128 + n * 16) = w; }
                    sq += __shfl_xor(sq, 16); sq += __shfl_xor(sq, 32);
                    if (fq == 0) unsafeAtomicAdd(SS + 2 * row + (isq ? 0 : 1), sq); }
        } else if (wc == 0) {
#pragma unroll
            for (int ai = 0; ai < 2; ++ai)
#pragma unroll
                for (int m = 0; m < 4; ++m) { const int row = row0 + ai * 128 + m * 16;
                    const f32x4 x1 = acc[ai][0][m][0], x2 = acc[ai][0][m][1];
                    const f32x4 cs = *(const f32x4*)(tab + (size_t)row * 32 + 4 * fq), sn = *(const f32x4*)(tab + (size_t)row * 32 + 16 + 4 * fq);
                    const f32x4 a = x1 * cs - x2 * sn, b = x1 * sn + x2 * cs;
                    u32x2 w0, w1; w0.x = pk2(a[0], a[1]); w0.y = pk2(a[2], a[3]); w1.x = pk2(b[0], b[1]); w1.y = pk2(b[2], b[3]);
                    *(u32x2*)(KR + (size_t)row * 32 + 4 * fq) = w0; *(u32x2*)(KR + (size_t)row * 32 + 16 + 4 * fq) = w1; }
        }
    }
};
struct EpiQ {
    static constexpr bool PERM = false, AFTER_DRAIN = false;
    bf16_t* Q; const float* tab; const float* SS;
    __device__ __forceinline__ void operator()(const pg8::f32x4 (&acc)[2][2][4][2], const pg8::Unit& u, int wr, int wc, int fr, int fq) const {
        const int row0 = u.pm * 256 + wr * 64 + fr;
#pragma unroll
        for (int bj = 0; bj < 2; ++bj) {
            const int c0 = u.pn * 256 + bj * 128 + wc * 32; const bool rope = ((c0 >> 5) % 3) == 2;
#pragma unroll
            for (int ai = 0; ai < 2; ++ai)
#pragma unroll
                for (int m = 0; m < 4; ++m) { const int row = row0 + ai * 128 + m * 16;
                    const float rq = __builtin_amdgcn_rsqf(SS[2 * row] * (1.f / 768.f) + RMS_EPS) * QSCALE;
                    f32x4 v0 = acc[ai][bj][m][0], v1 = acc[ai][bj][m][1];
                    if (rope) { const f32x4 cs = *(const f32x4*)(tab + (size_t)row * 32 + 4 * fq), sn = *(const f32x4*)(tab + (size_t)row * 32 + 16 + 4 * fq);
                        const f32x4 a = v0 * cs - v1 * sn, b = v0 * sn + v1 * cs; v0 = a; v1 = b; }
                    v0 = v0 * rq; v1 = v1 * rq;
                    bf16_t* qp = Q + (size_t)row * 1536 + c0 + 4 * fq;
                    u32x2 w0, w1; w0.x = pk2(v0[0], v0[1]); w0.y = pk2(v0[2], v0[3]); w1.x = pk2(v1[0], v1[1]); w1.y = pk2(v1[2], v1[3]);
                    *(u32x2*)qp = w0; *(u32x2*)(qp + 16) = w1; }
        }
    }
};
struct EpiBf16 {
    static constexpr bool PERM = true, AFTER_DRAIN = false;
    bf16_t* O; int ldc; const float* SS;
    __device__ __forceinline__ void operator()(const pg8::f32x4 (&acc)[2][2][4][2], const pg8::Unit& u, int wr, int wc, int fr, int fq) const {
        const int row0 = u.pm * 256 + wr * 64 + fr, col0 = u.pn * 256 + wc * 32 + 8 * fq;
#pragma unroll
        for (int ai = 0; ai < 2; ++ai)
#pragma unroll
            for (int m = 0; m < 4; ++m) { bf16_t* rp = O + (size_t)(row0 + ai * 128 + m * 16) * ldc + col0;
                const float rk = __builtin_amdgcn_rsqf(SS[2 * (row0 + ai * 128 + m * 16) + 1] * (1.f / 256.f) + RMS_EPS);
#pragma unroll
                for (int bj = 0; bj < 2; ++bj) { const f32x4 a0 = acc[ai][bj][m][0] * rk, a1 = acc[ai][bj][m][1] * rk;
                    u32x4 w; w.x = pk2(a0[0], a0[1]); w.y = pk2(a0[2], a0[3]); w.z = pk2(a1[0], a1[1]); w.w = pk2(a1[2], a1[3]); *(u32x4*)(rp + bj * 128) = w; } }
    }
};
struct EpiVT {
    static constexpr bool PERM = true, AFTER_DRAIN = false;
    bf16_t* VT; const float* SS;
    __device__ __forceinline__ void operator()(const pg8::f32x4 (&acc)[2][2][4][2], const pg8::Unit& u, int wr, int wc, int fr, int fq) const {
        const int row0 = u.pm * 256 + wr * 64 + fr, tok0 = u.pn * 256 + wc * 32 + 8 * fq;
        f32x4 rk[2][2];
#pragma unroll
        for (int bj = 0; bj < 2; ++bj)
#pragma unroll
            for (int n = 0; n < 2; ++n) { const f32x4 sa = *(const f32x4*)(SS + 2 * (tok0 + bj * 128 + 4 * n)), sb = *(const f32x4*)(SS + 2 * (tok0 + bj * 128 + 4 * n) + 4);
                rk[bj][n] = (f32x4){__builtin_amdgcn_rsqf(sa[1] * (1.f / 256.f) + RMS_EPS), __builtin_amdgcn_rsqf(sa[3] * (1.f / 256.f) + RMS_EPS), __builtin_amdgcn_rsqf(sb[1] * (1.f / 256.f) + RMS_EPS), __builtin_amdgcn_rsqf(sb[3] * (1.f / 256.f) + RMS_EPS)}; }
        bf16_t* base = VT + (size_t)(tok0 >> 11) * (1024 * 2048) + (tok0 & 2047);
#pragma unroll
        for (int ai = 0; ai < 2; ++ai)
#pragma unroll
            for (int m = 0; m < 4; ++m) { bf16_t* rp = base + (size_t)(row0 + ai * 128 + m * 16) * 2048;
#pragma unroll
                for (int bj = 0; bj < 2; ++bj) { const f32x4 a0 = acc[ai][bj][m][0] * rk[bj][0], a1 = acc[ai][bj][m][1] * rk[bj][1];
                    u32x4 w; w.x = pk2(a0[0], a0[1]); w.y = pk2(a0[2], a0[3]); w.z = pk2(a1[0], a1[1]); w.w = pk2(a1[2], a1[3]); *(u32x4*)(rp + bj * 128) = w; } }
    }
};
struct EpiResid {
    static constexpr bool PERM = false, AFTER_DRAIN = false;
    const float* Xin; float* Xout; const float* modrow; const float* RS; const float* g; const float* bta; int raw;
    __device__ __forceinline__ void operator()(const pg8::f32x4 (&acc)[2][2][4][2], const pg8::Unit& u, int wr, int wc, int fr, int fq) const {
        const int row0 = u.pm * 256 + wr * 64 + fr, col0 = u.pn * 256 + wc * 32 + 4 * fq;
        const int b = (u.pm * 256) >> 11; const float* gp = modrow + (size_t)b * 3072 + 2048 + col0;
#pragma unroll
        for (int bj = 0; bj < 2; ++bj)
#pragma unroll
            for (int n = 0; n < 2; ++n) {
                const int c = col0 + bj * 128 + n * 16;
                const f32x4 gt = *(const f32x4*)(gp + bj * 128 + n * 16) + 1.0f;
                f32x4 g4 = (f32x4){1.f, 1.f, 1.f, 1.f}, b4 = (f32x4){0.f, 0.f, 0.f, 0.f};
                if (!raw) { g4 = *(const f32x4*)(g + c); b4 = *(const f32x4*)(bta + c); }
#pragma unroll
                for (int ai = 0; ai < 2; ++ai)
#pragma unroll
                    for (int m = 0; m < 4; ++m) { const int row = row0 + ai * 128 + m * 16;
                        f32x4 xo = *(const f32x4*)(Xin + (size_t)row * 1024 + c);
                        if (!raw) { const float mean = RS[2 * row], rstd = RS[2 * row + 1]; xo = (xo - mean) * rstd * g4 + b4; }
                        *(f32x4*)(Xout + (size_t)row * 1024 + c) = xo * ALPHA + gt * acc[ai][bj][m][n]; }
            }
    }
};
struct EpiSwiGLU {
    static constexpr bool PERM = true, AFTER_DRAIN = false;
    bf16_t* T;
    __device__ __forceinline__ void operator()(const pg8::f32x4 (&acc)[2][2][4][2], const pg8::Unit& u, int wr, int wc, int fr, int fq) const {
        const int row0 = u.pm * 256 + wr * 64 + fr, col0 = u.pn * 128 + wc * 32 + 8 * fq;
#pragma unroll
        for (int ai = 0; ai < 2; ++ai)
#pragma unroll
            for (int m = 0; m < 4; ++m) {
                const f32x4 g0 = acc[ai][0][m][0], g1 = acc[ai][0][m][1], u0 = acc[ai][1][m][0], u1 = acc[ai][1][m][1];
                u32x4 w;
                w.x = pk2(siluf_(g0[0]) * u0[0], siluf_(g0[1]) * u0[1]); w.y = pk2(siluf_(g0[2]) * u0[2], siluf_(g0[3]) * u0[3]);
                w.z = pk2(siluf_(g1[0]) * u1[0], siluf_(g1[1]) * u1[1]); w.w = pk2(siluf_(g1[2]) * u1[2], siluf_(g1[3]) * u1[3]);
                *(u32x4*)(T + (size_t)(row0 + ai * 128 + m * 16) * FF + col0) = w; }
    }
};
template <int N> __device__ __forceinline__ float row_shr(float x) { return __builtin_bit_cast(float, __builtin_amdgcn_update_dpp(0, __builtin_bit_cast(int, x), 0x110 | N, 0xf, 0xf, true)); }
__device__ __forceinline__ float scan16(float x) { x += row_shr<1>(x); x += row_shr<2>(x); x += row_shr<4>(x); x += row_shr<8>(x); return x; }
__device__ __forceinline__ float bcast15(float x, int lane) { return __builtin_bit_cast(float, __builtin_amdgcn_ds_bpermute(((lane | 15) << 2), __builtin_bit_cast(int, x))); }
struct EpiHgrnIn {
    static constexpr bool PERM = true, AFTER_DRAIN = false;
    bf16_t* QP; bf16_t* KP; float* EL; const float* lb;
    __device__ __forceinline__ void operator()(const pg8::f32x4 (&acc)[2][2][4][2], const pg8::Unit& u, int wr, int wc, int fr, int fq) const {
        const int row0 = u.pm * 256 + wr * 64 + fr;
        if (u.pn < 8) {
            const int c0 = u.pn * 128 + wc * 32 + 8 * fq, lane = fr + 16 * fq;
            const f32x4 l0 = *(const f32x4*)(lb + c0), l1 = *(const f32x4*)(lb + c0 + 4);
#pragma unroll
            for (int ai = 0; ai < 2; ++ai)
#pragma unroll
                for (int mp = 0; mp < 2; ++mp) {
                    const int rowA = row0 + ai * 128 + (2 * mp) * 16, rowB = rowA + 16;
                    float qa[8], ka[8], qb[8], kb[8];
#pragma unroll
                    for (int n = 0; n < 2; ++n)
#pragma unroll
                        for (int e = 0; e < 4; ++e) {
                            const float lbv = n ? l1[e] : l0[e];
                            const float fA = lbv + (1.f - lbv) * sigmoidf_(acc[ai][1][2 * mp][n][e]), fB = lbv + (1.f - lbv) * sigmoidf_(acc[ai][1][2 * mp + 1][n][e]);
                            float xA = scan16(__log2f(fA)), xB = scan16(__log2f(fB));
                            xB += bcast15(xA, lane);
                            qa[4 * n + e] = siluf_(acc[ai][0][2 * mp][n][e]) * __builtin_amdgcn_exp2f(xA); ka[4 * n + e] = (1.f - fA) * __builtin_amdgcn_exp2f(-xA);
                            const float eB = __builtin_amdgcn_exp2f(xB);
                            qb[4 * n + e] = siluf_(acc[ai][0][2 * mp + 1][n][e]) * eB; kb[4 * n + e] = (1.f - fB) * __builtin_amdgcn_exp2f(-xB);
                            if (fr == 15) EL[(size_t)(rowB >> 5) * 1024 + c0 + 4 * n + e] = eB;
                        }
                    u32x4 w;
                    w.x = pk2(qa[0], qa[1]); w.y = pk2(qa[2], qa[3]); w.z = pk2(qa[4], qa[5]); w.w = pk2(qa[6], qa[7]); *(u32x4*)(QP + (size_t)rowA * 1024 + c0) = w;
                    w.x = pk2(ka[0], ka[1]); w.y = pk2(ka[2], ka[3]); w.z = pk2(ka[4], ka[5]); w.w = pk2(ka[6], ka[7]); *(u32x4*)(KP + (size_t)rowA * 1024 + c0) = w;
                    w.x = pk2(qb[0], qb[1]); w.y = pk2(qb[2], qb[3]); w.z = pk2(qb[4], qb[5]); w.w = pk2(qb[6], qb[7]); *(u32x4*)(QP + (size_t)rowB * 1024 + c0) = w;
                    w.x = pk2(kb[0], kb[1]); w.y = pk2(kb[2], kb[3]); w.z = pk2(kb[4], kb[5]); w.w = pk2(kb[6], kb[7]); *(u32x4*)(KP + (size_t)rowB * 1024 + c0) = w;
                }
        } else {
            const bool act = u.pn >= 12; const int col0 = (u.pn & 3) * 256 + wc * 32 + 8 * fq;
            bf16_t* base = QP + (size_t)(act ? (R_GS - R_QS) / 2 : (R_VV - R_QS) / 2);
#pragma unroll
            for (int ai = 0; ai < 2; ++ai)
#pragma unroll
                for (int m = 0; m < 4; ++m)
#pragma unroll
                    for (int bj = 0; bj < 2; ++bj) { f32x4 a0 = acc[ai][bj][m][0], a1 = acc[ai][bj][m][1];
                        if (act) {
#pragma unroll
                            for (int e = 0; e < 4; ++e) { a0[e] = siluf_(a0[e]); a1[e] = siluf_(a1[e]); } }
                        u32x4 w; w.x = pk2(a0[0], a0[1]); w.y = pk2(a0[2], a0[3]); w.z = pk2(a1[0], a1[1]); w.w = pk2(a1[2], a1[3]);
                        *(u32x4*)(base + (size_t)(row0 + ai * 128 + m * 16) * 1024 + col0 + bj * 128) = w; }
        }
    }
};

#define XB_TMO      128
#define XB_XCNT(j)  (256  + 64 * (j))
#define XB_XSUB(j)  (1280 + 64 * (j))
#define XB_XGEN(j)  (2304 + 64 * (j))
#define XB_TOP      3328
#define XB_TOPGEN   3392
#define XCD_BAR_WORDS 3456
#define XB_SPIN_CAP (1u << 18)

__device__ __forceinline__ unsigned xb_ld(unsigned* p)              { return __hip_atomic_load(p, __ATOMIC_RELAXED, __HIP_MEMORY_SCOPE_AGENT); }
__device__ __forceinline__ unsigned xb_add(unsigned* p, unsigned v) { return __hip_atomic_fetch_add(p, v, __ATOMIC_RELAXED, __HIP_MEMORY_SCOPE_AGENT); }
__device__ __forceinline__ unsigned xb_xcc_id() { return (unsigned)__builtin_amdgcn_s_getreg((3 << 11) | 20) & 0xFu; }
#define XB_SPIN(cond, bar) do { unsigned _sp = 0; while (cond) { __builtin_amdgcn_s_sleep(1); \
    if ((++_sp & 255u) == 0u) { if (xb_ld(&(bar)[XB_TMO])) break; if (_sp > XB_SPIN_CAP) { atomicAdd(&(bar)[XB_TMO], 1u); break; } } } } while (0)

struct XcdBarrier {
    unsigned* bar; unsigned x;
    volatile LAS unsigned* st;
};

__device__ __forceinline__ XcdBarrier xcd_barrier_post(unsigned* bar, volatile LAS unsigned* st) {
    XcdBarrier b; b.bar = bar; b.x = xb_xcc_id(); b.st = st;
    if (mk_tid() == 0) (void)xb_add(&bar[XB_XCNT(b.x)], 1u);
    return b;
}
__device__ __forceinline__ void xcd_barrier_complete(unsigned* bar, unsigned x, unsigned& nloc, unsigned& nx) {
    const unsigned G = (unsigned)mk_grid();
    unsigned sum, cnt, mine, sp = 0u;
    for (;;) {
        sum = 0u; cnt = 0u; mine = 0u;
#pragma unroll
        for (unsigned j = 0; j < 16; ++j) { const unsigned c = xb_ld(&bar[XB_XCNT(j)]); sum += c; cnt += (c > 0u) ? 1u : 0u; mine = (j == x) ? c : mine; }
        if (sum == G) break;
        __builtin_amdgcn_s_sleep(1);
        if ((++sp & 255u) == 0u) { if (xb_ld(&bar[XB_TMO])) break; if (sp > XB_SPIN_CAP) { atomicAdd(&bar[XB_TMO], 1u); break; } }
    }
    nloc = mine > 0u ? mine : 1u; nx = cnt > 0u ? cnt : 1u;
}

__device__ __forceinline__ void xcd_barrier(const XcdBarrier& b) {
    asm volatile("s_waitcnt vmcnt(0)" ::: "memory");
    __syncthreads();
    if (mk_tid() == 0) {
        unsigned* bar = b.bar;
        __builtin_amdgcn_s_waitcnt(0);
        unsigned nloc = b.st[0], nx = b.st[1];
        if (nloc == 0u) { xcd_barrier_complete(bar, b.x, nloc, nx); b.st[0] = nloc; b.st[1] = nx; }
        const unsigned old = xb_add(&bar[XB_XSUB(b.x)], 1u);
        const unsigned gen = old / nloc;
        if (old + 1u == (gen + 1u) * nloc) {
            __builtin_amdgcn_fence(__ATOMIC_RELEASE, "agent");
            asm volatile("s_waitcnt vmcnt(0)" ::: "memory");
            const unsigned og = xb_add(&bar[XB_TOP], 1u);
            const unsigned tg = og / nx;
            if (og + 1u == (tg + 1u) * nx) xb_add(&bar[XB_TOPGEN], 1u);
            else XB_SPIN(xb_ld(&bar[XB_TOPGEN]) == tg, bar);
            __builtin_amdgcn_fence(__ATOMIC_ACQUIRE, "agent");
            xb_add(&bar[XB_XGEN(b.x)], 1u);
            asm volatile("s_waitcnt vmcnt(0)" ::: "memory");
        } else {
            XB_SPIN(xb_ld(&bar[XB_XGEN(b.x)]) == gen, bar);
            __builtin_amdgcn_fence(__ATOMIC_ACQUIRE, "agent");
            asm volatile("s_waitcnt vmcnt(0)" ::: "memory");
        }
    }
    __syncthreads();
}


__device__ __forceinline__ void transpose_item(const float* W, bf16_t* dst, int K, int N, int mode, int item, LAS float* scr, int lane, const float* kscale) {
    const int nblk = N / 32, kb = item / nblk, nb = item % nblk, k0 = 64 * kb, n0 = 32 * nb;
    int drow0 = n0;
    if (mode == 1) { const int up = n0 >= FF, j0 = up ? n0 - FF : n0; drow0 = 256 * (j0 >> 7) + (up ? 128 : 0) + (j0 & 127); }
    if (mode == 2) { const int h = n0 >> 7, r = n0 & 127; drow0 = (r < 64) ? h * 64 + r : 1024 + h * 64 + (r - 64); }
    if (mode == 3 && n0 < 2048) { const int fxh = n0 >= 1024, c = n0 & 1023; drow0 = 256 * (c >> 7) + (fxh ? 128 : 0) + (c & 127); }
    { float t[32];
#pragma unroll
      for (int i = 0; i < 32; ++i) t[i] = W[(size_t)(k0 + 2 * i + (lane >> 5)) * N + n0 + (lane & 31)];
#pragma unroll
      for (int i = 0; i < 32; ++i) scr[(2 * i + (lane >> 5)) * 33 + (lane & 31)] = kscale ? t[i] * kscale[k0 + 2 * i + (lane >> 5)] : t[i]; }
    asm volatile("s_waitcnt lgkmcnt(0)" ::: "memory");
    const int c = lane & 7;
#pragma unroll
    for (int j = 0; j < 4; ++j) { const int n = (lane >> 3) + 8 * j; const LAS float* s = scr + (8 * c) * 33 + n;
        u32x4 o; o.x = pk2(s[0 * 33], s[1 * 33]); o.y = pk2(s[2 * 33], s[3 * 33]); o.z = pk2(s[4 * 33], s[5 * 33]); o.w = pk2(s[6 * 33], s[7 * 33]);
        *(u32x4*)(dst + (size_t)(drow0 + n) * K + k0 + 8 * c) = o; }
    asm volatile("s_waitcnt lgkmcnt(0)" ::: "memory");
}

__device__ __forceinline__ void prologue_phase(ParamsPtr pp, LAS unsigned char* lds) {
    const ParamsPtr p_ = pp;
#define p (*p_)
    const int tid = mk_tid(), lane = tid & 63, wave = __builtin_amdgcn_readfirstlane(tid >> 6);
    const int G = mk_grid();
    {
        LAS float* sc = (LAS float*)lds;
        LAS float* red = (LAS float*)(lds + 65536);
        for (int i = tid; i < NB * DM; i += 512) { const int b = i >> 10, k = i & 1023; const float v = p.c[i]; sc[k * 16 + b] = v / (1.f + __expf(-v)); }
        __syncthreads();
        float* MOD = (float*)(p.ws + WS_MOD);
        for (int it = mk_bid(); it < 8 * 48; it += G) {
            const int ls = it / 48, n0 = (it % 48) * 64, col = tid & 63, kg = tid >> 6;
            const float* W = p.ada_w + (size_t)ls * 1024 * 3072 + (size_t)(kg * 128) * 3072 + n0 + col;
            float acc[16];
#pragma unroll
            for (int b = 0; b < 16; ++b) acc[b] = 0.f;
#pragma unroll 16
            for (int k = 0; k < 128; ++k) { const float w = W[(size_t)k * 3072]; const LAS f32x4* s4 = (const LAS f32x4*)(sc + (kg * 128 + k) * 16);
#pragma unroll
                for (int q = 0; q < 4; ++q) { const f32x4 s = s4[q]; acc[4 * q + 0] += s[0] * w; acc[4 * q + 1] += s[1] * w; acc[4 * q + 2] += s[2] * w; acc[4 * q + 3] += s[3] * w; } }
#pragma unroll
            for (int q = 0; q < 4; ++q) *(LAS f32x4*)(red + (kg * 64 + col) * 16 + 4 * q) = (f32x4){acc[4 * q], acc[4 * q + 1], acc[4 * q + 2], acc[4 * q + 3]};
            __syncthreads();
            { const int b0 = 2 * kg;
#pragma unroll
              for (int bb = 0; bb < 2; ++bb) { float s = 0.f;
#pragma unroll
                  for (int g = 0; g < 8; ++g) s += red[(g * 64 + col) * 16 + b0 + bb];
                  MOD[((size_t)ls * 16 + b0 + bb) * 3072 + n0 + col] = s + p.ada_b[ls * 3072 + n0 + col]; } }
            __syncthreads();
        }
    }
    if (mk_bid() == 0) {
        float* LB = (float*)(p.ws + WS_LB);
        for (int cidx = tid; cidx < 1024; cidx += 512) { const float a0 = p.hgrn_lb[cidx], a1 = p.hgrn_lb[1024 + cidx], mx = fmaxf(a0, a1);
            const float e0 = expf(a0 - mx), e1 = expf(a1 - mx), s0 = e0 / (e0 + e1), s1 = e1 / (e0 + e1);
            LB[cidx] = s0 - s0; LB[1024 + cidx] = (s0 + s1) - s0; }
    }
    {
        float* TAB = (float*)(p.ws + WS_TAB);
        for (int gi = mk_bid() * 512 + tid; gi < M_TOK * 16; gi += G * 512) {
            const int m = gi >> 4, i = gi & 15; const float ang = (float)p.pos[m] * p.invf[i];
            const double r = (double)ang, q = rint(r * 0.63661977236758134308), t = fma(-q, 1.57079632679489661923, r), t2 = t * t;
            const double s = t * (1.0 + t2 * (-1.0 / 6 + t2 * (1.0 / 120 + t2 * (-1.0 / 5040 + t2 * (1.0 / 362880 + t2 * (-1.0 / 39916800 + t2 * (1.0 / 6227020800.0)))))));
            const double c = 1.0 + t2 * (-0.5 + t2 * (1.0 / 24 + t2 * (-1.0 / 720 + t2 * (1.0 / 40320 + t2 * (-1.0 / 3628800 + t2 * (1.0 / 479001600.0))))));
            const int qi = ((int)q) & 3; double cc, ss;
            if (qi == 0) { cc = c; ss = s; } else if (qi == 1) { cc = -s; ss = c; } else if (qi == 2) { cc = -c; ss = -s; } else { cc = s; ss = -c; }
            TAB[(size_t)m * 32 + i] = (float)cc; TAB[(size_t)m * 32 + 16 + i] = (float)ss; }
    }
    {
        for (int gi = mk_bid() * 512 + tid; gi < 2 * 224 * 128; gi += G * 512) { const int l = gi / (224 * 128), r = gi % (224 * 128);
            *(u32x4*)(p.ws + W_MWIN + (size_t)l * 1280 * 1024 * 2 + (size_t)1056 * 1024 * 2 + (size_t)r * 16) = (u32x4){0u, 0u, 0u, 0u}; }
    }
    {
        for (int gi = mk_bid() * 512 + tid; gi < (int)(512 * 1024 / 16); gi += G * 512) *(u32x4*)(p.ws + WS_SS + (size_t)gi * 16) = (u32x4){0u, 0u, 0u, 0u};
    }
    __syncthreads();
    {
        LAS float* scr = (LAS float*)(lds + wave * 8448);
        const int gw = mk_bid() * 8 + wave, NGW = G * 8;
        for (int it = gw; it < wt_total(); it += NGW) {
            int r = it;
#pragma unroll
            for (int t = 0; t < 8; ++t) {
                const int ni = wt_items(t) * WT[t].layers;
                if (r >= 0 && r < ni) { const int l = r / wt_items(t), item = r % wt_items(t);
                    transpose_item(p.wsrc[t] + (size_t)l * WT[t].K * WT[t].N, (bf16_t*)(p.ws + WT[t].dst) + (size_t)l * WT[t].drows * WT[t].K, WT[t].K, WT[t].N, WT[t].mode, item, scr, lane, t == 1 ? p.mla_qn + l * 768 : (t == 2 ? p.mla_kvn + l * 256 : nullptr)); }
                r -= ni;
            }
        }
    }
}

#undef p
__device__ __forceinline__ void norm_phase(const float* src, float* dst, bool do_ln, bool write_x, const float* g, const float* bta, float* RS, bool do_h, const float* modrow, bf16_t* H) {
    const int tid_ = mk_tid(), lane = tid_ & 63, wave = __builtin_amdgcn_readfirstlane(tid_ >> 6); const int gw = mk_bid() * 8 + wave, NGW = mk_grid() * 8;
    for (int m0 = gw * 4; m0 < M_TOK; m0 += NGW * 4) {
        const int b = m0 >> 11;
        f32x4 v[4][4];
#pragma unroll
        for (int r = 0; r < 4; ++r) { const f32x4* xr = (const f32x4*)(src + (size_t)(m0 + r) * 1024) + lane;
#pragma unroll
            for (int j = 0; j < 4; ++j) v[r][j] = xr[64 * j]; }
        if (do_ln) {
            float s[4];
#pragma unroll
            for (int r = 0; r < 4; ++r) { s[r] = 0.f;
#pragma unroll
                for (int j = 0; j < 4; ++j) s[r] += (v[r][j][0] + v[r][j][1]) + (v[r][j][2] + v[r][j][3]); }
#pragma unroll
            for (int o = 1; o < 64; o <<= 1) {
#pragma unroll
                for (int r = 0; r < 4; ++r) s[r] += __shfl_xor(s[r], o); }
            float mean[4], s2[4];
#pragma unroll
            for (int r = 0; r < 4; ++r) { mean[r] = s[r] * (1.f / 1024.f); s2[r] = 0.f;
#pragma unroll
                for (int j = 0; j < 4; ++j) { v[r][j] = v[r][j] - mean[r]; s2[r] += (v[r][j][0] * v[r][j][0] + v[r][j][1] * v[r][j][1]) + (v[r][j][2] * v[r][j][2] + v[r][j][3] * v[r][j][3]); } }
#pragma unroll
            for (int o = 1; o < 64; o <<= 1) {
#pragma unroll
                for (int r = 0; r < 4; ++r) s2[r] += __shfl_xor(s2[r], o); }
#pragma unroll
            for (int r = 0; r < 4; ++r) { const float rstd = 1.0f / sqrtf(s2[r] * (1.f / 1024.f) + LN_EPS);
                if (lane == 0) { RS[2 * (m0 + r)] = mean[r]; RS[2 * (m0 + r) + 1] = rstd; }
#pragma unroll
                for (int j = 0; j < 4; ++j) v[r][j] = v[r][j] * rstd; }
#pragma unroll
            for (int j = 0; j < 4; ++j) { const f32x4 gg = *((const f32x4*)g + lane + 64 * j), bb = *((const f32x4*)bta + lane + 64 * j);
#pragma unroll
                for (int r = 0; r < 4; ++r) v[r][j] = v[r][j] * gg + bb; }
        }
        if (write_x) {
#pragma unroll
            for (int r = 0; r < 4; ++r) { f32x4* xo = (f32x4*)(dst + (size_t)(m0 + r) * 1024) + lane;
#pragma unroll
                for (int j = 0; j < 4; ++j) xo[64 * j] = v[r][j]; } }
        if (do_h) { const f32x4* sh = (const f32x4*)(modrow + (size_t)b * 3072) + lane; const f32x4* sc = (const f32x4*)(modrow + (size_t)b * 3072 + 1024) + lane;
#pragma unroll
            for (int j = 0; j < 4; ++j) { const f32x4 s1 = sc[64 * j] + 1.0f, s0 = sh[64 * j];
#pragma unroll
                for (int r = 0; r < 4; ++r) { const f32x4 h = v[r][j] * s1 + s0; u32x2 w; w.x = pk2(h[0], h[1]); w.y = pk2(h[2], h[3]); *((u32x2*)(H + (size_t)(m0 + r) * 1024) + lane + 64 * j) = w; } } }
    }
}

__device__ __forceinline__ void latnorm_phase(const float* PROJ, const float* qn, const float* kvn, const float* tab, bf16_t* LATQ, bf16_t* LATKV, bf16_t* KR) {
    const int tid_ = mk_tid(), lane = tid_ & 63, wave = __builtin_amdgcn_readfirstlane(tid_ >> 6); const int gw = mk_bid() * 8 + wave, NGW = mk_grid() * 8;
    for (int m0 = gw * 4; m0 < M_TOK; m0 += NGW * 4) {
        f32x4 v[4][3], kv[4]; float s[4], s2[4], x1[4], x2[4];
#pragma unroll
        for (int r = 0; r < 4; ++r) { const float* pr = PROJ + (size_t)(m0 + r) * 1056;
#pragma unroll
            for (int j = 0; j < 3; ++j) v[r][j] = *((const f32x4*)pr + lane + 64 * j);
            kv[r] = *((const f32x4*)(pr + 768) + lane); x1[r] = pr[1024 + (lane & 15)]; x2[r] = pr[1040 + (lane & 15)]; }
#pragma unroll
        for (int r = 0; r < 4; ++r) { s[r] = 0.f;
#pragma unroll
            for (int j = 0; j < 3; ++j) s[r] += (v[r][j][0] * v[r][j][0] + v[r][j][1] * v[r][j][1]) + (v[r][j][2] * v[r][j][2] + v[r][j][3] * v[r][j][3]);
            s2[r] = (kv[r][0] * kv[r][0] + kv[r][1] * kv[r][1]) + (kv[r][2] * kv[r][2] + kv[r][3] * kv[r][3]); }
#pragma unroll
        for (int o = 1; o < 64; o <<= 1) {
#pragma unroll
            for (int r = 0; r < 4; ++r) { s[r] += __shfl_xor(s[r], o); s2[r] += __shfl_xor(s2[r], o); } }
#pragma unroll
        for (int r = 0; r < 4; ++r) { const int m = m0 + r;
            const float rq = 1.0f / sqrtf(s[r] * (1.f / 768.f) + RMS_EPS), rkv = 1.0f / sqrtf(s2[r] * (1.f / 256.f) + RMS_EPS);
#pragma unroll
            for (int j = 0; j < 3; ++j) { const f32x4 gg = *((const f32x4*)qn + lane + 64 * j); const f32x4 o = v[r][j] * rq * gg; u32x2 w; w.x = pk2(o[0], o[1]); w.y = pk2(o[2], o[3]);
                *((u32x2*)(LATQ + (size_t)m * 768) + lane + 64 * j) = w; }
            { const f32x4 gg = *((const f32x4*)kvn + lane); const f32x4 o = kv[r] * rkv * gg; u32x2 w; w.x = pk2(o[0], o[1]); w.y = pk2(o[2], o[3]); *((u32x2*)(LATKV + (size_t)m * 256) + lane) = w; }
            if (lane < 16) { const float cs = tab[(size_t)m * 32 + lane], sn = tab[(size_t)m * 32 + 16 + lane];
                const unsigned w = pk2(x1[r] * cs - x2[r] * sn, x1[r] * sn + x2[r] * cs); KR[(size_t)m * 32 + lane] = (bf16_t)(w & 0xffff); KR[(size_t)m * 32 + 16 + lane] = (bf16_t)(w >> 16); } }
    }
}

__device__ __forceinline__ void attn_phase(LAS unsigned char* lds, const bf16_t* Q, const bf16_t* KN, const bf16_t* KR, const bf16_t* VT, bf16_t* O) {
    constexpr int KPB = 208, VPB = 144, KSB = 64 * KPB, VSB = 64 * VPB;
    const int tid = mk_tid(), lane = tid & 63, wave = __builtin_amdgcn_readfirstlane(tid >> 6), q = lane & 31, g = lane >> 5;
    const unsigned kn_dst = (tid >> 3) * KPB + (tid & 7) * 16, kr_dst = (tid >> 2) * KPB + 128 + (tid & 3) * 16, vt_dst = 2 * KSB + (tid >> 3) * VPB + (tid & 7) * 16;
    for (int bh = mk_bid(); bh < 256; bh += mk_grid()) {
        const int b = bh >> 4, h = bh & 15;
        const bf16_t* kn_src = KN + (size_t)(b * 2048 + (tid >> 3)) * 1024 + h * 64 + (tid & 7) * 8;
        const bf16_t* kr_src = KR + (size_t)(b * 2048 + (tid >> 2)) * 32 + (tid & 3) * 8;
        const bf16_t* vt_src = VT + (size_t)(bh * 64 + (tid >> 3)) * 2048 + (tid & 7) * 8;
#pragma unroll 1
        for (int qb = 7; qb >= 0; --qb) {
            __syncthreads();
            const int r0 = qb * 256 + wave * 32, ntile = 4 * (qb + 1);
            bf16x8 qf[6];
            { const bf16_t* qp = Q + (size_t)(b * 2048 + r0 + q) * 1536 + h * 96 + g * 8;
#pragma unroll
              for (int ks = 0; ks < 6; ++ks) qf[ks] = *(const bf16x8*)(qp + ks * 16); }
            f32x16 o0, o1;
#pragma unroll
            for (int i = 0; i < 16; ++i) { o0[i] = 0.f; o1[i] = 0.f; }
            float mrow = -INFINITY, lrow = 0.f;
            u32x4 rk, rr, rv;
            rk = *(const u32x4*)kn_src; rv = *(const u32x4*)vt_src; if (tid < 256) rr = *(const u32x4*)kr_src;
            *(LAS u32x4*)(lds + kn_dst) = rk; *(LAS u32x4*)(lds + vt_dst) = rv; if (tid < 256) *(LAS u32x4*)(lds + kr_dst) = rr;
            __syncthreads();
#pragma unroll 1
            for (int j = 0; j < ntile; ++j) {
                const int cur = j & 1; const bool more = (j + 1 < ntile);
                if (more) { rk = *(const u32x4*)(kn_src + (size_t)(j + 1) * 64 * 1024); rv = *(const u32x4*)(vt_src + (j + 1) * 64); if (tid < 256) rr = *(const u32x4*)(kr_src + (size_t)(j + 1) * 64 * 32); }
                if (64 * j <= r0 + 31) {
                    const LAS unsigned char* kb_ = lds + cur * KSB; const LAS unsigned char* vb_ = lds + 2 * KSB + cur * VSB;
                    f32x16 s0, s1;
#pragma unroll
                    for (int i = 0; i < 16; ++i) { s0[i] = 0.f; s1[i] = 0.f; }
#pragma unroll
                    for (int ks = 0; ks < 6; ++ks) {
                        const bf16x8 a0 = *(const LAS bf16x8*)(kb_ + q * KPB + (ks * 16 + g * 8) * 2), a1 = *(const LAS bf16x8*)(kb_ + (32 + q) * KPB + (ks * 16 + g * 8) * 2);
                        s0 = mfma32(a0, qf[ks], s0); s1 = mfma32(a1, qf[ks], s1); }
                    if (64 * j + 63 > r0) { const int qa = r0 + q, k0 = 64 * j + 4 * g;
#pragma unroll
                        for (int i = 0; i < 16; ++i) { const int key = k0 + (i & 3) + 8 * (i >> 2); if (key > qa) s0[i] = -INFINITY; if (key + 32 > qa) s1[i] = -INFINITY; } }
                    float mx = fmaxf(s0[0], s1[0]);
#pragma unroll
                    for (int i = 1; i < 16; ++i) mx = fmaxf(mx, fmaxf(s0[i], s1[i]));
                    mx = fmaxf(mx, __shfl_xor(mx, 32));
                    const float mnew = fmaxf(mrow, mx), alpha = __builtin_amdgcn_exp2f(mrow - mnew); mrow = mnew;
                    float sum = 0.f;
#pragma unroll
                    for (int i = 0; i < 16; ++i) { s0[i] = __builtin_amdgcn_exp2f(s0[i] - mnew); s1[i] = __builtin_amdgcn_exp2f(s1[i] - mnew); sum += s0[i] + s1[i]; }
                    lrow = lrow * alpha + sum;
#pragma unroll
                    for (int i = 0; i < 16; ++i) { o0[i] *= alpha; o1[i] *= alpha; }
#pragma unroll
                    for (int kb = 0; kb < 2; ++kb)
#pragma unroll
                        for (int t2 = 0; t2 < 2; ++t2) {
                            u32x4 pw;
                            if (kb == 0) { pw.x = pk2(s0[8 * t2 + 0], s0[8 * t2 + 1]); pw.y = pk2(s0[8 * t2 + 2], s0[8 * t2 + 3]); pw.z = pk2(s0[8 * t2 + 4], s0[8 * t2 + 5]); pw.w = pk2(s0[8 * t2 + 6], s0[8 * t2 + 7]); }
                            else         { pw.x = pk2(s1[8 * t2 + 0], s1[8 * t2 + 1]); pw.y = pk2(s1[8 * t2 + 2], s1[8 * t2 + 3]); pw.z = pk2(s1[8 * t2 + 4], s1[8 * t2 + 5]); pw.w = pk2(s1[8 * t2 + 6], s1[8 * t2 + 7]); }
                            const bf16x8 pb = __builtin_bit_cast(bf16x8, pw);
                            const int ko = (32 * kb + 16 * t2 + 4 * g) * 2;
                            { const u32x2 lo = *(const LAS u32x2*)(vb_ + q * VPB + ko), hi = *(const LAS u32x2*)(vb_ + q * VPB + ko + 16);
                              const u32x4 av = (u32x4){lo.x, lo.y, hi.x, hi.y}; o0 = mfma32(__builtin_bit_cast(bf16x8, av), pb, o0); }
                            { const u32x2 lo = *(const LAS u32x2*)(vb_ + (32 + q) * VPB + ko), hi = *(const LAS u32x2*)(vb_ + (32 + q) * VPB + ko + 16);
                              const u32x4 av = (u32x4){lo.x, lo.y, hi.x, hi.y}; o1 = mfma32(__builtin_bit_cast(bf16x8, av), pb, o1); }
                        }
                }
                if (more) { const unsigned bo = (cur ^ 1) * KSB, vo = (cur ^ 1) * VSB;
                    *(LAS u32x4*)(lds + bo + kn_dst) = rk; *(LAS u32x4*)(lds + vo + vt_dst) = rv; if (tid < 256) *(LAS u32x4*)(lds + bo + kr_dst) = rr; }
                __syncthreads();
            }
            const float lt = lrow + __shfl_xor(lrow, 32), inv = 1.0f / lt;
            bf16_t* op = O + (size_t)(b * 2048 + r0 + q) * 1024 + h * 64 + 4 * g;
#pragma unroll
            for (int qd = 0; qd < 4; ++qd) {
                u32x2 w0, w1; w0.x = pk2(o0[4 * qd] * inv, o0[4 * qd + 1] * inv); w0.y = pk2(o0[4 * qd + 2] * inv, o0[4 * qd + 3] * inv);
                w1.x = pk2(o1[4 * qd] * inv, o1[4 * qd + 1] * inv); w1.y = pk2(o1[4 * qd + 2] * inv, o1[4 * qd + 3] * inv);
                *(u32x2*)(op + 8 * qd) = w0; *(u32x2*)(op + 32 + 8 * qd) = w1; }
        }
    }
}

__device__ __forceinline__ void hgrn_phase(LAS unsigned char* lds, const bf16_t* QP, const bf16_t* KP, const float* EL, const bf16_t* VV, const bf16_t* GS, const float* gn, bf16_t* OG) {
    constexpr int QPO = 0, KPN = 8704, KPT = 17408, VTT = 27648, SST = 37888, OPART = 72704, ELAST = 108544;
    const int tid = mk_tid(), lane = tid & 63, wave = __builtin_amdgcn_readfirstlane(tid >> 6), q = lane & 31, g = lane >> 5;
    const int ch = tid & 127, tg = tid >> 7, vb = wave & 3, kh = wave >> 2;
    const int dt = tid >> 4, dpart = tid & 15;
    for (int bh = mk_bid(); bh < 128; bh += mk_grid()) {
        const int b = bh >> 3, hh = bh & 7;
        __syncthreads();
        f32x16 st0, st1;
#pragma unroll
        for (int i = 0; i < 16; ++i) { st0[i] = 0.f; st1[i] = 0.f; }
        const size_t ebase = (size_t)(b * 2048 + 8 * tg) * 1024 + hh * 128 + ch;
        const size_t dbase = (size_t)(b * 2048 + dt) * 1024 + hh * 128 + 8 * dpart;
        const size_t lbase = (size_t)(b * 64) * 1024 + hh * 128 + ch;
        f32x4 gn0 = *(const f32x4*)(gn + 8 * dpart), gn1 = *(const f32x4*)(gn + 8 * dpart + 4);
        unsigned short qp[8], kp[8], vv[8]; float el = 0.f;
#pragma unroll
        for (int i = 0; i < 8; ++i) { qp[i] = QP[ebase + (size_t)i * 1024]; kp[i] = KP[ebase + (size_t)i * 1024]; vv[i] = VV[ebase + (size_t)i * 1024]; }
        if (tg == 3) el = EL[lbase];
        u32x4 gsv_next = *(const u32x4*)(GS + dbase);
#pragma unroll 1
        for (int c = 0; c < 64; ++c) {
            {
                unsigned kt[4], vt[4];
#pragma unroll
                for (int i = 0; i < 8; i += 2) {
                    *(LAS unsigned short*)(lds + QPO + (8 * tg + i) * 272 + ch * 2) = qp[i];
                    *(LAS unsigned short*)(lds + QPO + (8 * tg + i + 1) * 272 + ch * 2) = qp[i + 1];
                    *(LAS unsigned short*)(lds + KPN + (8 * tg + i) * 272 + ch * 2) = kp[i];
                    *(LAS unsigned short*)(lds + KPN + (8 * tg + i + 1) * 272 + ch * 2) = kp[i + 1];
                    kt[i >> 1] = (unsigned)kp[i] | ((unsigned)kp[i + 1] << 16); vt[i >> 1] = (unsigned)vv[i] | ((unsigned)vv[i + 1] << 16);
                }
                *(LAS u32x4*)(lds + KPT + ch * 80 + tg * 16) = (u32x4){kt[0], kt[1], kt[2], kt[3]};
                *(LAS u32x4*)(lds + VTT + ch * 80 + tg * 16) = (u32x4){vt[0], vt[1], vt[2], vt[3]};
                if (tg == 3) *(LAS float*)(lds + ELAST + ch * 4) = el;
            }
#pragma unroll
            for (int qd = 0; qd < 4; ++qd) {
                u32x2 w0, w1; w0.x = pk2(st0[4 * qd], st0[4 * qd + 1]); w0.y = pk2(st0[4 * qd + 2], st0[4 * qd + 3]); w1.x = pk2(st1[4 * qd], st1[4 * qd + 1]); w1.y = pk2(st1[4 * qd + 2], st1[4 * qd + 3]);
                *(LAS u32x2*)(lds + SST + (32 * vb + q) * 272 + (32 * (2 * kh) + 8 * qd + 4 * g) * 2) = w0;
                *(LAS u32x2*)(lds + SST + (32 * vb + q) * 272 + (32 * (2 * kh + 1) + 8 * qd + 4 * g) * 2) = w1; }
            __syncthreads();
            const u32x4 gsv = gsv_next;
            if (c + 1 < 64) { const size_t e2 = ebase + (size_t)(c + 1) * 32 * 1024;
                gsv_next = *(const u32x4*)(GS + dbase + (size_t)(c + 1) * 32 * 1024);
#pragma unroll
                for (int i = 0; i < 8; ++i) { qp[i] = QP[e2 + (size_t)i * 1024]; kp[i] = KP[e2 + (size_t)i * 1024]; vv[i] = VV[e2 + (size_t)i * 1024]; }
                if (tg == 3) el = EL[lbase + (size_t)(c + 1) * 1024]; }
            {
                f32x16 oT;
#pragma unroll
                for (int i = 0; i < 16; ++i) oT[i] = 0.f;
#pragma unroll
                for (int ks = 0; ks < 4; ++ks) { const int k0 = (64 * kh + 16 * ks + 8 * g) * 2;
                    oT = mfma32(*(const LAS bf16x8*)(lds + SST + (32 * vb + q) * 272 + k0), *(const LAS bf16x8*)(lds + QPO + q * 272 + k0), oT); }
                if (kh == 0) {
                    f32x16 aT;
#pragma unroll
                    for (int i = 0; i < 16; ++i) aT[i] = 0.f;
#pragma unroll
                    for (int ks = 0; ks < 8; ++ks) { const int k0 = (16 * ks + 8 * g) * 2;
                        aT = mfma32(*(const LAS bf16x8*)(lds + KPN + q * 272 + k0), *(const LAS bf16x8*)(lds + QPO + q * 272 + k0), aT); }
#pragma unroll
                    for (int i = 0; i < 16; ++i) { const int s = (i & 3) + 8 * (i >> 2) + 4 * g; if (s > q) aT[i] = 0.f; }
#pragma unroll
                    for (int t2 = 0; t2 < 2; ++t2) {
                        u32x4 pw; pw.x = pk2(aT[8 * t2 + 0], aT[8 * t2 + 1]); pw.y = pk2(aT[8 * t2 + 2], aT[8 * t2 + 3]); pw.z = pk2(aT[8 * t2 + 4], aT[8 * t2 + 5]); pw.w = pk2(aT[8 * t2 + 6], aT[8 * t2 + 7]);
                        const int so = (16 * t2 + 4 * g) * 2;
                        const u32x2 lo = *(const LAS u32x2*)(lds + VTT + (32 * vb + q) * 80 + so), hi = *(const LAS u32x2*)(lds + VTT + (32 * vb + q) * 80 + so + 16);
                        const u32x4 av = (u32x4){lo.x, lo.y, hi.x, hi.y};
                        oT = mfma32(__builtin_bit_cast(bf16x8, av), __builtin_bit_cast(bf16x8, pw), oT); }
                }
#pragma unroll
                for (int qd = 0; qd < 4; ++qd) *(LAS f32x4*)(lds + OPART + kh * 16896 + q * 528 + (32 * vb + 8 * qd + 4 * g) * 4) = (f32x4){oT[4 * qd], oT[4 * qd + 1], oT[4 * qd + 2], oT[4 * qd + 3]};
            }
#pragma unroll
            for (int t2 = 0; t2 < 2; ++t2) { const int so = (16 * t2 + 8 * g) * 2; const bf16x8 bv = *(const LAS bf16x8*)(lds + VTT + (32 * vb + q) * 80 + so);
                st0 = mfma32(*(const LAS bf16x8*)(lds + KPT + (32 * (2 * kh) + q) * 80 + so), bv, st0);
                st1 = mfma32(*(const LAS bf16x8*)(lds + KPT + (32 * (2 * kh + 1) + q) * 80 + so), bv, st1); }
#pragma unroll
            for (int qd = 0; qd < 4; ++qd) { const f32x4 e0 = *(const LAS f32x4*)(lds + ELAST + (32 * (2 * kh) + 8 * qd + 4 * g) * 4), e1 = *(const LAS f32x4*)(lds + ELAST + (32 * (2 * kh + 1) + 8 * qd + 4 * g) * 4);
#pragma unroll
                for (int e = 0; e < 4; ++e) { st0[4 * qd + e] *= e0[e]; st1[4 * qd + e] *= e1[e]; } }
            __syncthreads();
            {
                const LAS float* o0p = (const LAS float*)(lds + OPART + dt * 528 + dpart * 32); const LAS float* o1p = (const LAS float*)(lds + OPART + 16896 + dt * 528 + dpart * 32);
                const f32x4 a0 = *(const LAS f32x4*)o0p + *(const LAS f32x4*)o1p, a1 = *(const LAS f32x4*)(o0p + 4) + *(const LAS f32x4*)(o1p + 4);
                float ss = (a0[0] * a0[0] + a0[1] * a0[1]) + (a0[2] * a0[2] + a0[3] * a0[3]) + (a1[0] * a1[0] + a1[1] * a1[1]) + (a1[2] * a1[2] + a1[3] * a1[3]);
                ss += __shfl_xor(ss, 1); ss += __shfl_xor(ss, 2); ss += __shfl_xor(ss, 4); ss += __shfl_xor(ss, 8);
                const float rstd = __builtin_amdgcn_rsqf(ss * (1.f / 128.f) + RMS_EPS);
                const f32x4 r0 = a0 * rstd * gn0, r1 = a1 * rstd * gn1;
                u32x4 w;
                w.x = pk2(r0[0] * bf2f((unsigned short)(gsv.x & 0xffff)), r0[1] * bf2f((unsigned short)(gsv.x >> 16)));
                w.y = pk2(r0[2] * bf2f((unsigned short)(gsv.y & 0xffff)), r0[3] * bf2f((unsigned short)(gsv.y >> 16)));
                w.z = pk2(r1[0] * bf2f((unsigned short)(gsv.z & 0xffff)), r1[1] * bf2f((unsigned short)(gsv.z >> 16)));
                w.w = pk2(r1[2] * bf2f((unsigned short)(gsv.w & 0xffff)), r1[3] * bf2f((unsigned short)(gsv.w >> 16)));
                *(u32x4*)(OG + dbase + (size_t)c * 32 * 1024) = w;
            }
        }
    }
}

constexpr int N_PHASES = 32;
template <class Epi>
__device__ __forceinline__ void run_gemm(LAS unsigned char* lds, const bf16_t* A, const bf16_t* Bt, int N, int K, const Epi& E) {
    asm volatile("" : "+s"(K), "+s"(N));
    pg8::Gemm g{A, Bt, M_TOK, N, K}; pg8::StaticOrder S; S.init(M_TOK, N, mk_grid(), mk_bid());
    pg8::gemm_phase<Epi, pg8::StaticOrder, true, true>((PG8_LAS unsigned char*)lds, g, S, E);
}

template <class Epi>
__device__ __forceinline__ void run_gemm_t(LAS unsigned char* lds, const bf16_t* A, const bf16_t* Bt, int K, const Epi& E) {
    asm volatile("" : "+s"(K));
    pg8::Gemm g{A, Bt, 1024, M_TOK, K}; pg8::StaticOrder S; S.init(1024, M_TOK, mk_grid(), mk_bid());
    pg8::gemm_phase<Epi, pg8::StaticOrder, true, true>((PG8_LAS unsigned char*)lds, g, S, E);
}

__global__ void __launch_bounds__(512, 2) fwd_megakernel(Params p) {
    extern __shared__ __attribute__((aligned(16))) unsigned char lds_raw[];
    LAS unsigned char* lds = (LAS unsigned char*)lds_raw;
    cg::grid_group grid = cg::this_grid();
    const int ph_lo = p.ph_lo, ph_hi = p.ph_hi;
    if (mk_tid() < 16) ((volatile LAS unsigned*)(lds + 131072))[mk_tid()] = 0u;
    __syncthreads();
    const XcdBarrier bar = xcd_barrier_post((unsigned*)(p.ws + WS_BAR), (volatile LAS unsigned*)(lds + 131072));
#if defined(PROBE_TIME_MASK)
    unsigned long long t_acc = 0;
#endif
#pragma unroll 1
    for (int ph = ph_lo; ph < ph_hi; ++ph) {
#if defined(PROBE_TIME_MASK)
        const unsigned long long t_ph0 = __builtin_amdgcn_s_memrealtime();
#endif
        unsigned long long kptr = (unsigned long long)__builtin_amdgcn_kernarg_segment_ptr(); asm volatile("" : "+s"(kptr));
        const ParamsPtr pp = (ParamsPtr)kptr;
#define p (*pp)
        unsigned char* ws = p.ws;
        float* MOD = (float*)(ws + WS_MOD); const float* TAB = (const float*)(ws + WS_TAB); const float* LB = (const float*)(ws + WS_LB);
        bf16_t* H = (bf16_t*)(ws + WS_H); float* RS = (float*)(ws + WS_RS);
        int kind, layer = 0;
        if (ph == 0) kind = 0; else if (ph == 1) kind = 1;
        else { const int qq = ph - 2, pair = qq / 15, r = qq % 15;
            if (r < 8) { layer = 2 * pair; kind = (r == 0) ? 2 : (r < 5) ? 3 + r : 8 + (r - 5); }
            else { layer = 2 * pair + 1; const int r2 = r - 8; kind = (r2 == 0) ? 11 : (r2 == 1) ? 12 : (r2 == 2) ? 6 : (r2 == 3) ? 7 : 8 + (r2 - 4); } }
        const int j = layer >> 1;
        switch (kind) {
        case 0:
#if defined(PROBE_DUP_PRO)
            prologue_phase(pp, lds); __syncthreads();
#endif
            prologue_phase(pp, lds); break;
        case 1:
#if defined(PROBE_DUP_NORM0)
            norm_phase(p.x, p.X, false, false, nullptr, nullptr, RS, true, MOD, H); norm_phase(p.x, p.X, false, false, nullptr, nullptr, RS, true, MOD, H); norm_phase(p.x, p.X, false, false, nullptr, nullptr, RS, true, MOD, H); norm_phase(p.x, p.X, false, false, nullptr, nullptr, RS, true, MOD, H);
#endif
            norm_phase(p.x, p.X, false, false, nullptr, nullptr, RS, true, MOD, H); break;
        case 2: { EpiLat E{(bf16_t*)(ws + R_LATQ), (bf16_t*)(ws + R_LATKV), (bf16_t*)(ws + R_KR), (float*)(ws + WS_SS) + (size_t)j * M_TOK * 2, TAB}; run_gemm(lds, H, (const bf16_t*)(ws + W_MWIN) + (size_t)j * 1280 * 1024, 1280, 1024, E); } break;
        case 4: { const float* SS = (const float*)(ws + WS_SS) + (size_t)j * M_TOK * 2; EpiQ Eq{(bf16_t*)(ws + R_Q), TAB, SS}; run_gemm(lds, (const bf16_t*)(ws + R_LATQ), (const bf16_t*)(ws + W_MWQB) + (size_t)j * 1536 * 768, 1536, 768, Eq);
                  const bf16_t* Wkv = (const bf16_t*)(ws + W_MWKVB) + (size_t)j * 2048 * 256;
                  EpiBf16 Ek{(bf16_t*)(ws + R_KN), 1024, SS}; run_gemm(lds, (const bf16_t*)(ws + R_LATKV), Wkv, 1024, 256, Ek);
                  EpiVT Ev{(bf16_t*)(ws + R_VT), SS}; run_gemm_t(lds, Wkv + (size_t)1024 * 256, (const bf16_t*)(ws + R_LATKV), 256, Ev); } break;
        case 5:
#if defined(PROBE_DUP_ATTN)
            attn_phase(lds, (const bf16_t*)(ws + R_Q), (const bf16_t*)(ws + R_KN), (const bf16_t*)(ws + R_KR), (const bf16_t*)(ws + R_VT), (bf16_t*)(ws + R_O));
#endif
            attn_phase(lds, (const bf16_t*)(ws + R_Q), (const bf16_t*)(ws + R_KN), (const bf16_t*)(ws + R_KR), (const bf16_t*)(ws + R_VT), (bf16_t*)(ws + R_O)); break;
        case 6: { const bool mla = (layer & 1) == 0; const int pl = layer > 0 ? 2 * layer - 1 : 0;
                  EpiResid E{layer == 0 ? p.x : (const float*)p.X, p.X, MOD + (size_t)(2 * layer) * 16 * 3072, RS, p.ln_g + (size_t)pl * 1024, p.ln_b + (size_t)pl * 1024, layer == 0 ? 1 : 0};
                  const bf16_t* A = mla ? (const bf16_t*)(ws + R_O) : (const bf16_t*)H;
                  const bf16_t* Bt = mla ? (const bf16_t*)(ws + W_MWO) + (size_t)j * 1024 * 1024 : (const bf16_t*)(ws + W_HWO) + (size_t)j * 1024 * 1024;
                  run_gemm(lds, A, Bt, 1024, 1024, E); } break;
        case 7: norm_phase(p.X, p.X, true, false, p.ln_g + (size_t)(2 * layer) * 1024, p.ln_b + (size_t)(2 * layer) * 1024, RS, true, MOD + (size_t)(2 * layer + 1) * 16 * 3072, H); break;
        case 8: { EpiSwiGLU E{(bf16_t*)(ws + R_T)};
#if defined(PROBE_DUP_G4)
            run_gemm(lds, H, (const bf16_t*)(ws + W_FWIN) + (size_t)layer * 5632 * 1024, 5632, 1024, E);
#endif
            run_gemm(lds, H, (const bf16_t*)(ws + W_FWIN) + (size_t)layer * 5632 * 1024, 5632, 1024, E); } break;
        case 9: { EpiResid E{p.X, p.X, MOD + (size_t)(2 * layer + 1) * 16 * 3072, RS, p.ln_g + (size_t)(2 * layer) * 1024, p.ln_b + (size_t)(2 * layer) * 1024, 0}; run_gemm(lds, (const bf16_t*)(ws + R_T), (const bf16_t*)(ws + W_FWOUT) + (size_t)layer * 1024 * FF, 1024, FF, E); } break;
        case 10: norm_phase(p.X, p.X, true, layer == 3, p.ln_g + (size_t)(2 * layer + 1) * 1024, p.ln_b + (size_t)(2 * layer + 1) * 1024, RS, layer < 3, MOD + (size_t)(2 * layer + 2) * 16 * 3072, H); break;
        case 11: { EpiHgrnIn E{(bf16_t*)(ws + R_QS), (bf16_t*)(ws + R_KP), (float*)(ws + R_EL), LB + j * 1024};
                   run_gemm(lds, H, (const bf16_t*)(ws + W_HWIN) + (size_t)j * 4096 * 1024, 4096, 1024, E); } break;
        case 12:
#if defined(PROBE_DUP_REC)
            hgrn_phase(lds, (const bf16_t*)(ws + R_QS), (const bf16_t*)(ws + R_KP), (const float*)(ws + R_EL), (const bf16_t*)(ws + R_VV), (const bf16_t*)(ws + R_GS), p.hgrn_gn + j * 128, H);
#endif
            hgrn_phase(lds, (const bf16_t*)(ws + R_QS), (const bf16_t*)(ws + R_KP), (const float*)(ws + R_EL), (const bf16_t*)(ws + R_VV), (const bf16_t*)(ws + R_GS), p.hgrn_gn + j * 128, H); break;
        default: break;
        }
        if (ph + 1 < ph_hi) { if (ph_hi > 4096) grid.sync(); else xcd_barrier(bar); }
#if defined(PROBE_TIME_MASK)
        if ((PROBE_TIME_MASK >> kind) & 1) t_acc += __builtin_amdgcn_s_memrealtime() - t_ph0;
#endif
#if defined(PROBE_DUP_SYNC)
        if (ph + 1 < ph_hi) { xcd_barrier(bar); xcd_barrier(bar); xcd_barrier(bar); xcd_barrier(bar); }
#endif
#undef p
    }
#if defined(PROBE_TIME_MASK)
    if (mk_bid() == 0) { const unsigned long long t_e = __builtin_amdgcn_s_memrealtime(); while (__builtin_amdgcn_s_memrealtime() - t_e < t_acc) __builtin_amdgcn_s_sleep(8); }
#endif
}

#ifndef MK_MULTI
#define MK_MULTI 0
#endif
extern "C" void kernel_launch(void* const* d_in, const int* in_sizes, int n_in, void* d_out, int out_size, void* d_ws, size_t ws_size, hipStream_t stream) {
    static int grid = 0;
    if (grid == 0) {
        if (n_in != 19 || out_size != M_TOK * DM || ws_size < WS_END) { fprintf(stderr, "kernel_launch: unexpected sizes: n_in %d out %d ws %zu (need %zu)\n", n_in, out_size, ws_size, (size_t)WS_END); grid = -1; return; }
        int dev = 0, cus = 0, per_cu = 0;
        hipGetDevice(&dev); hipDeviceGetAttribute(&cus, hipDeviceAttributeMultiprocessorCount, dev);
        if (hipFuncSetAttribute((const void*)fwd_megakernel, hipFuncAttributeMaxDynamicSharedMemorySize, LDS_BYTES) != hipSuccess) { fprintf(stderr, "kernel_launch: hipFuncSetAttribute failed\n"); grid = -1; return; }
        hipOccupancyMaxActiveBlocksPerMultiprocessor(&per_cu, (const void*)fwd_megakernel, 512, LDS_BYTES);
        (void)hipGetLastError();
        if (per_cu < 1) per_cu = 1;
        grid = cus * 1;
        fprintf(stderr, "kernel_launch: cus %d per_cu %d grid %d\n", cus, per_cu, grid);
    }
    if (grid < 0) return;
    if (hipMemsetAsync((char*)d_ws + WS_BAR, 0, XCD_BAR_WORDS * 4, stream) != hipSuccess) { fprintf(stderr, "kernel_launch: memset failed\n"); return; }
    Params p{};
    p.x = (const float*)d_in[0]; p.c = (const float*)d_in[1]; p.pos = (const int*)d_in[2];
    p.mla_qn = (const float*)d_in[4]; p.mla_kvn = (const float*)d_in[6]; p.hgrn_lb = (const float*)d_in[9]; p.hgrn_gn = (const float*)d_in[11];
    p.ada_w = (const float*)d_in[15]; p.ada_b = (const float*)d_in[16]; p.ln_g = (const float*)d_in[17]; p.ln_b = (const float*)d_in[18];
    p.X = (float*)d_out; p.ws = (unsigned char*)d_ws;
    p.wsrc[0] = (const float*)d_in[3]; p.wsrc[1] = (const float*)d_in[5]; p.wsrc[2] = (const float*)d_in[7]; p.wsrc[3] = (const float*)d_in[8];
    p.wsrc[4] = (const float*)d_in[10]; p.wsrc[5] = (const float*)d_in[12]; p.wsrc[6] = (const float*)d_in[13]; p.wsrc[7] = (const float*)d_in[14];
    for (int i = 0; i < 16; ++i) p.invf[i] = (float)pow(10000.0, -(double)i / 16.0);
#if MK_MULTI
    for (int ph = 0; ph < N_PHASES; ++ph) { p.ph_lo = ph; p.ph_hi = ph + 1; hipLaunchKernelGGL(fwd_megakernel, dim3(grid), dim3(512), LDS_BYTES, stream, p); }
#else
    p.ph_lo = 0; p.ph_hi = N_PHASES;
    void* args[] = {&p};
    hipError_t e = hipLaunchCooperativeKernel((const void*)fwd_megakernel, dim3(grid), dim3(512), args, LDS_BYTES, stream);
    if (e != hipSuccess) fprintf(stderr, "cooperative launch failed: %s (grid %d)\n", hipGetErrorString(e), grid);
#endif
}
```
